# Optimizing an MI355X kernel written in HIP

```python
import math
import jax, jax.numpy as jnp
from jax import lax
import numpy as np

D_MODEL = 2048
BATCH = 4
SEQ = 4096
DEPTH = 4

HEAD_DIM = 64
N_MIXERS = 4
HEADS_PER_MIXER = 8
GROUP_WIDTH = HEADS_PER_MIXER * HEAD_DIM
MIX_WIDTH = N_MIXERS * GROUP_WIDTH
N_HEADS_TOTAL = N_MIXERS * HEADS_PER_MIXER
SCALE = HEAD_DIM ** -0.5

REL_BUCKETS = 32
REL_MAX_DIST = 2048

DILATED_CONFIGS = ((128, 1), (512, 4), (2048, 16))

SWA_WINDOW = 128
SWA_KV_HEADS = 2

MOBA_BLOCK = 256
MOBA_TOPK = 3

NSA_KV_HEADS = 2
NSA_CMP_BLOCK = 32
NSA_CMP_STRIDE = 16
NSA_CMP_HIDDEN = 128
NSA_SLC_BLOCK = 64
NSA_SLC_TOPN = 16
NSA_WINDOW = 512

BAND_BLOCK = 128
QUERY_CHUNK = 64

N_EXPERTS = 16
N_EXPERT_GROUPS = 4
TOPK_GROUPS = 1
TOPK_EXPERTS = 2
D_EXPERT = 512

NORM_EPS = 1e-6
NEG_INF = -1e30

KV_B = SWA_KV_HEADS * HEAD_DIM
KV_D = NSA_KV_HEADS * HEAD_DIM
IN_SIZES = (GROUP_WIDTH, GROUP_WIDTH, GROUP_WIDTH,
            GROUP_WIDTH, KV_B, KV_B,
            GROUP_WIDTH, GROUP_WIDTH, GROUP_WIDTH,
            GROUP_WIDTH, KV_D, KV_D, KV_D, KV_D, KV_D, KV_D, HEADS_PER_MIXER * 3)
IN_COLS = sum(IN_SIZES)

kernel_name = "hybrid_parallel_heads_moe"


def rmsnorm(x, g):
    xf = x.astype(jnp.float32)
    ms = jnp.mean(xf * xf, axis=-1, keepdims=True)
    return (xf * lax.rsqrt(ms + NORM_EPS)).astype(x.dtype) * g


def t5_bucket(dist):
    dist = jnp.maximum(dist, 0)
    max_exact = REL_BUCKETS // 2
    large = max_exact + (jnp.log(jnp.maximum(dist, 1).astype(jnp.float32) / max_exact)
                         / math.log(REL_MAX_DIST / max_exact) * (REL_BUCKETS - max_exact)).astype(jnp.int32)
    large = jnp.minimum(large, REL_BUCKETS - 1)
    return jnp.where(dist < max_exact, dist, large)


def masked_softmax(s, mask, sink=None):
    s = jnp.where(mask, s, NEG_INF)
    m = jnp.max(s, axis=-1, keepdims=True)
    if sink is not None:
        m = jnp.maximum(m, sink)
    e = jnp.where(mask, jnp.exp(s - m), 0.0)
    den = jnp.sum(e, axis=-1, keepdims=True)
    if sink is not None:
        den = den + jnp.exp(sink - m)
    den = jnp.maximum(den, jnp.finfo(jnp.float32).tiny)
    return e / den, (m + jnp.log(den))[..., 0]


def banded_attention(q, k, v, max_dist, tab, dist_scale, sink=None):
    b, hk, g, L, hd = q.shape
    nblk = -(-L // BAND_BLOCK)
    Lp = nblk * BAND_BLOCK
    nprev = -(-max_dist // BAND_BLOCK)
    nk = (nprev + 1) * BAND_BLOCK
    q = jnp.pad(q, ((0, 0), (0, 0), (0, 0), (0, Lp - L), (0, 0)))
    pad_kv = ((0, 0), (0, 0), (nprev * BAND_BLOCK, Lp - L), (0, 0))
    k = jnp.pad(k, pad_kv)
    v = jnp.pad(v, pad_kv)
    kidx = np.arange(nblk)[:, None] * BAND_BLOCK + np.arange(nk)[None, :]
    kb = k[:, :, kidx]
    vb = v[:, :, kidx]
    qb = q.reshape(b, hk, g, nblk, BAND_BLOCK, hd)
    rel = np.arange(BAND_BLOCK)[:, None] + nprev * BAND_BLOCK - np.arange(nk)[None, :]
    kpos = np.arange(nblk)[:, None, None] * BAND_BLOCK - nprev * BAND_BLOCK + np.arange(nk)[None, None, :]
    mask = (rel >= 0) & (rel <= max_dist) & (kpos >= 0)
    bias = tab.astype(jnp.float32)[:, :, t5_bucket(jnp.asarray(rel * dist_scale))]
    s = jnp.einsum('bhgnqd,bhnkd->bhgnqk', qb, kb).astype(jnp.float32) * SCALE + bias[None, :, :, None]
    if sink is not None:
        sink = sink.astype(jnp.float32)[None, :, :, None, None, None]
    p, lse = masked_softmax(s, mask, sink)
    o = jnp.einsum('bhgnqk,bhnkd->bhgnqd', p.astype(v.dtype), vb).reshape(b, hk, g, Lp, hd)[:, :, :, :L]
    return o, lse.reshape(b, hk, g, Lp)[:, :, :, :L]


def dilated_attention(q, k, v, tab):
    b, h, s, hd = q.shape
    outs, lses = [], []
    for window, r in DILATED_CONFIGS:
        def strided(t):
            return t.reshape(b, h, s // r, r, hd).transpose(0, 3, 1, 2, 4).reshape(b * r, h, s // r, hd)
        o, lse = banded_attention(strided(q)[:, :, None], strided(k), strided(v), window // r, tab[:, None], r)
        outs.append(o[:, :, 0].reshape(b, r, h, s // r, hd).transpose(0, 2, 3, 1, 4).reshape(b, h, s, hd))
        lses.append(lse[:, :, 0].reshape(b, r, h, s // r).transpose(0, 2, 3, 1).reshape(b, h, s))
    w = jax.nn.softmax(jnp.stack(lses, axis=0), axis=0)
    o = w[0][..., None] * outs[0] + w[1][..., None] * outs[1] + w[2][..., None] * outs[2]
    return o.astype(q.dtype)


def moba_attention(q, k, v, tab):
    b, h, s, hd = q.shape
    nb = -(-s // MOBA_BLOCK)
    sp = nb * MOBA_BLOCK
    pad = ((0, 0), (0, 0), (0, sp - s), (0, 0))
    q, k, v = jnp.pad(q, pad), jnp.pad(k, pad), jnp.pad(v, pad)
    kb = k.reshape(b, h, nb, MOBA_BLOCK, hd)
    vb = v.reshape(b, h, nb, MOBA_BLOCK, hd)
    kmean = jnp.mean(kb, axis=-2)
    nch = sp // QUERY_CHUNK
    qc = jnp.moveaxis(q.reshape(b, h, nch, QUERY_CHUNK, hd), 2, 0)
    starts = jnp.arange(nch, dtype=jnp.int32) * QUERY_CHUNK
    ksel = min(MOBA_TOPK, nb)
    bi = jnp.arange(b)[:, None, None, None]
    hi = jnp.arange(h)[None, :, None, None]
    tabf = tab.astype(jnp.float32)

    def chunk(args):
        qi, start = args
        pos = start + jnp.arange(QUERY_CHUNK, dtype=jnp.int32)
        cur = start // MOBA_BLOCK
        gate = jnp.einsum('bhqd,bhnd->bhqn', qi, kmean).astype(jnp.float32)
        gate = jnp.where(jnp.arange(nb) < cur, gate, NEG_INF)
        _, sel = lax.top_k(gate, ksel)
        ks = kb[bi, hi, sel]
        vs = vb[bi, hi, sel]
        s_sel = jnp.einsum('bhqd,bhqnkd->bhqnk', qi, ks).reshape(b, h, QUERY_CHUNK, ksel * MOBA_BLOCK)
        kpos_sel = (sel[..., None] * MOBA_BLOCK + jnp.arange(MOBA_BLOCK)).reshape(b, h, QUERY_CHUNK, ksel * MOBA_BLOCK)
        mask_sel = jnp.repeat(sel < cur, MOBA_BLOCK, axis=-1)
        ko = lax.dynamic_index_in_dim(kb, cur, axis=2, keepdims=False)
        vo = lax.dynamic_index_in_dim(vb, cur, axis=2, keepdims=False)
        s_own = jnp.einsum('bhqd,bhkd->bhqk', qi, ko)
        kpos_own = cur * MOBA_BLOCK + jnp.arange(MOBA_BLOCK, dtype=jnp.int32)
        shp = (b, h, QUERY_CHUNK, MOBA_BLOCK)
        mask_own = jnp.broadcast_to(kpos_own[None, :] <= pos[:, None], shp)
        kpos = jnp.concatenate([kpos_sel, jnp.broadcast_to(kpos_own, shp)], axis=-1)
        mask = jnp.concatenate([mask_sel, mask_own], axis=-1)
        bias = tabf[hi, t5_bucket(pos[:, None] - kpos)]
        sc = jnp.concatenate([s_sel, s_own], axis=-1).astype(jnp.float32) * SCALE + bias
        p, _ = masked_softmax(sc, mask)
        p = p.astype(v.dtype)
        o = (jnp.einsum('bhqnk,bhqnkd->bhqd', p[..., :ksel * MOBA_BLOCK].reshape(b, h, QUERY_CHUNK, ksel, MOBA_BLOCK), vs)
             + jnp.einsum('bhqk,bhkd->bhqd', p[..., ksel * MOBA_BLOCK:], vo))
        return o

    o = lax.map(chunk, (qc, starts))
    return jnp.moveaxis(o, 0, 2).reshape(b, h, sp, hd)[:, :, :s]


def nsa_attention(q, k_cmp, v_cmp, k_slc, v_slc, k_win, v_win, gates, pe_k, pe_v, w1k, w2k, w1v, w2v, tab):
    b, hk, g, s, hd = q.shape
    n_cmp = (s - NSA_CMP_BLOCK) // NSA_CMP_STRIDE + 1
    cidx = np.arange(n_cmp)[:, None] * NSA_CMP_STRIDE + np.arange(NSA_CMP_BLOCK)[None, :]

    def compress(t, pe, w1, w2):
        blk = (t[:, :, cidx] + pe).reshape(b, hk, n_cmp, NSA_CMP_BLOCK * hd)
        return jax.nn.gelu(blk @ w1) @ w2

    kc = compress(k_cmp, pe_k, w1k, w2k)
    vc = compress(v_cmp, pe_v, w1v, w2v)
    pos = np.arange(s)
    mask_c = (np.arange(n_cmp) * NSA_CMP_STRIDE + NSA_CMP_BLOCK - 1)[None, :] <= pos[:, None]
    s_c = jnp.einsum('bhgqd,bhnd->bhgqn', q, kc).astype(jnp.float32) * SCALE
    p_c, _ = masked_softmax(s_c, mask_c)
    o_cmp = jnp.einsum('bhgqn,bhnd->bhgqd', p_c.astype(vc.dtype), vc)
    n_slc = s // NSA_SLC_BLOCK
    c_start = np.arange(n_cmp) * NSA_CMP_STRIDE
    j_start = np.arange(n_slc) * NSA_SLC_BLOCK
    overlap = ((c_start[:, None] < j_start[None, :] + NSA_SLC_BLOCK)
               & (c_start[:, None] + NSA_CMP_BLOCK > j_start[None, :])).astype(np.float32)
    imp = jnp.einsum('bhgqn,nj->bhqj', p_c, jnp.asarray(overlap))
    cur = pos // NSA_SLC_BLOCK
    jj = np.arange(n_slc)[None, :]
    forced = (jj == 0) | (jj == cur[:, None]) | (jj == cur[:, None] - 1)
    imp = jnp.where(forced, -NEG_INF, jnp.where(jj <= cur[:, None], imp, NEG_INF))
    n_sel = min(NSA_SLC_TOPN, n_slc)
    _, sel = lax.top_k(imp, n_sel)
    ksb = k_slc.reshape(b, hk, n_slc, NSA_SLC_BLOCK, hd)
    vsb = v_slc.reshape(b, hk, n_slc, NSA_SLC_BLOCK, hd)
    nch = s // QUERY_CHUNK
    qc = jnp.moveaxis(q.reshape(b, hk, g, nch, QUERY_CHUNK, hd), 3, 0)
    selc = jnp.moveaxis(sel.reshape(b, hk, nch, QUERY_CHUNK, n_sel), 2, 0)
    starts = jnp.arange(nch, dtype=jnp.int32) * QUERY_CHUNK
    bi = jnp.arange(b)[:, None, None, None]
    hi = jnp.arange(hk)[None, :, None, None]
    tab_t = tab.astype(jnp.float32).transpose(0, 2, 1)

    def chunk(args):
        qi, si, start = args
        pos_q = start + jnp.arange(QUERY_CHUNK, dtype=jnp.int32)
        kk = ksb[bi, hi, si]
        vv = vsb[bi, hi, si]
        nkeys = n_sel * NSA_SLC_BLOCK
        sc = jnp.einsum('bhgqd,bhqnkd->bhgqnk', qi, kk).reshape(b, hk, g, QUERY_CHUNK, nkeys).astype(jnp.float32) * SCALE
        kpos = (si[..., None] * NSA_SLC_BLOCK + jnp.arange(NSA_SLC_BLOCK)).reshape(b, hk, QUERY_CHUNK, nkeys)
        mask = (kpos <= pos_q[:, None])[:, :, None]
        bias = jnp.moveaxis(tab_t[hi, t5_bucket(pos_q[:, None] - kpos)], -1, 2)
        p, _ = masked_softmax(sc + bias, mask)
        return jnp.einsum('bhgqnk,bhqnkd->bhgqd',
                          p.reshape(b, hk, g, QUERY_CHUNK, n_sel, NSA_SLC_BLOCK).astype(vv.dtype), vv)

    o_slc = jnp.moveaxis(lax.map(chunk, (qc, selc, starts)), 0, 3).reshape(b, hk, g, s, hd)
    o_win, _ = banded_attention(q, k_win, v_win, NSA_WINDOW - 1, tab, 1)
    gates = gates.astype(q.dtype)
    return gates[..., 0:1] * o_cmp + gates[..., 1:2] * o_slc + gates[..., 2:3] * o_win


def _heads(t, n):
    b, s, _ = t.shape
    return t.reshape(b, s, n, HEAD_DIM).transpose(0, 2, 1, 3)


def _seq(o):
    b, n, s, d = o.shape
    return o.transpose(0, 2, 1, 3).reshape(b, s, n * d)


def token_mixer(h, w_in_l, rel_bias, sink_l, pe_k, pe_v, w1k, w2k, w1v, w2v, mix_g, w_out_l):
    b, s, _ = h.shape
    H = HEADS_PER_MIXER
    proj = h @ w_in_l
    offs = [int(o) for o in np.cumsum(IN_SIZES)[:-1]]
    (q_a, k_a, v_a, q_b, k_b, v_b, q_c, k_c, v_c,
     q_d, k_dc, v_dc, k_ds, v_ds, k_dw, v_dw, g_d) = jnp.split(proj, offs, axis=-1)
    tabs = [rel_bias[:, i * H:(i + 1) * H].T for i in range(N_MIXERS)]
    o_a = dilated_attention(_heads(q_a, H), _heads(k_a, H), _heads(v_a, H), tabs[0])
    gb = H // SWA_KV_HEADS
    o_b, _ = banded_attention(_heads(q_b, H).reshape(b, SWA_KV_HEADS, gb, s, HEAD_DIM),
                              _heads(k_b, SWA_KV_HEADS), _heads(v_b, SWA_KV_HEADS),
                              SWA_WINDOW - 1, tabs[1].reshape(SWA_KV_HEADS, gb, REL_BUCKETS), 1,
                              sink_l.reshape(SWA_KV_HEADS, gb))
    o_b = o_b.reshape(b, H, s, HEAD_DIM)
    o_c = moba_attention(_heads(q_c, H), _heads(k_c, H), _heads(v_c, H), tabs[2])
    gd = H // NSA_KV_HEADS
    gates = jax.nn.sigmoid(g_d.reshape(b, s, H, 3)).transpose(0, 2, 1, 3).reshape(b, NSA_KV_HEADS, gd, s, 3)
    kvh = lambda t: _heads(t, NSA_KV_HEADS)
    o_d = nsa_attention(_heads(q_d, H).reshape(b, NSA_KV_HEADS, gd, s, HEAD_DIM),
                        kvh(k_dc), kvh(v_dc), kvh(k_ds), kvh(v_ds), kvh(k_dw), kvh(v_dw), gates,
                        pe_k, pe_v, w1k, w2k, w1v, w2v, tabs[3].reshape(NSA_KV_HEADS, gd, REL_BUCKETS))
    o_d = o_d.reshape(b, H, s, HEAD_DIM)
    outs = [rmsnorm(_seq(o), mix_g[i]) for i, o in enumerate((o_a, o_b, o_c, o_d))]
    return jnp.concatenate(outs, axis=-1) @ w_out_l


def moe_ffn(h, router_w, router_bias, w_gate, w_up, w_down):
    b, s, d = h.shape
    t = h.reshape(b * s, d)
    aff = jax.nn.sigmoid((t @ router_w).astype(jnp.float32))
    score = aff + router_bias.astype(jnp.float32)
    per_group = N_EXPERTS // N_EXPERT_GROUPS
    group_score = lax.top_k(score.reshape(-1, N_EXPERT_GROUPS, per_group), 2)[0].sum(-1)
    _, gsel = lax.top_k(group_score, TOPK_GROUPS)
    gmask = jnp.any(jnp.arange(N_EXPERT_GROUPS)[None, None, :] == gsel[..., None], axis=1)
    emask = jnp.repeat(gmask, per_group, axis=-1)
    _, esel = lax.top_k(jnp.where(emask, score, NEG_INF), TOPK_EXPERTS)
    w = jnp.take_along_axis(aff, esel, axis=-1)
    w = w / jnp.sum(w, axis=-1, keepdims=True)
    combine = jnp.sum((esel[..., None] == jnp.arange(N_EXPERTS)) * w[..., None], axis=1).astype(t.dtype)
    y = jnp.zeros_like(t)
    for e in range(N_EXPERTS):
        he = jax.nn.silu(t @ w_gate[e]) * (t @ w_up[e])
        y = y + combine[:, e:e + 1] * (he @ w_down[e])
    return y.reshape(b, s, d)


def setup_inputs(seed: int = 0) -> dict:
    key = jax.random.key(seed)
    ks = jax.random.split(key, 24)
    f32 = jnp.float32

    def nrm(k, shape, sc):
        return jax.random.normal(k, shape, f32) * sc

    D, E, F = D_MODEL, N_EXPERTS, D_EXPERT
    cin = NSA_CMP_BLOCK * HEAD_DIM
    return {
        "x": nrm(ks[0], (BATCH, SEQ, D), 1.0),
        "c": nrm(ks[1], (BATCH, D), 1.0),
        "rel_bias": nrm(ks[2], (REL_BUCKETS, N_HEADS_TOTAL), 0.5),
        "router_w": nrm(ks[3], (D, E), D ** -0.5),
        "router_bias": nrm(ks[4], (E,), 0.01),
        "norm1_g": 1.0 + nrm(ks[5], (DEPTH, D), 0.02),
        "norm2_g": 1.0 + nrm(ks[6], (DEPTH, D), 0.02),
        "ada_w": nrm(ks[7], (DEPTH, D, 6 * D), 0.3 * D ** -0.5),
        "ada_b": nrm(ks[8], (DEPTH, 6 * D), 0.02),
        "w_in": nrm(ks[9], (DEPTH, D, IN_COLS), D ** -0.5),
        "nsa_pe_k": nrm(ks[10], (DEPTH, NSA_CMP_BLOCK, HEAD_DIM), 0.5),
        "nsa_pe_v": nrm(ks[11], (DEPTH, NSA_CMP_BLOCK, HEAD_DIM), 0.5),
        "nsa_cmp_w1_k": nrm(ks[12], (DEPTH, cin, NSA_CMP_HIDDEN), cin ** -0.5),
        "nsa_cmp_w2_k": nrm(ks[13], (DEPTH, NSA_CMP_HIDDEN, HEAD_DIM), NSA_CMP_HIDDEN ** -0.5),
        "nsa_cmp_w1_v": nrm(ks[14], (DEPTH, cin, NSA_CMP_HIDDEN), cin ** -0.5),
        "nsa_cmp_w2_v": nrm(ks[15], (DEPTH, NSA_CMP_HIDDEN, HEAD_DIM), NSA_CMP_HIDDEN ** -0.5),
        "sinks": nrm(ks[16], (DEPTH, HEADS_PER_MIXER), 0.5),
        "mix_norm_g": 1.0 + nrm(ks[17], (DEPTH, N_MIXERS, GROUP_WIDTH), 0.02),
        "w_out": nrm(ks[18], (DEPTH, MIX_WIDTH, D), MIX_WIDTH ** -0.5),
        "exp_w_gate": nrm(ks[19], (DEPTH, E, D, F), D ** -0.5),
        "exp_w_up": nrm(ks[20], (DEPTH, E, D, F), D ** -0.5),
        "exp_w_down": nrm(ks[21], (DEPTH, E, F, D), F ** -0.5),
        "final_g": 1.0 + nrm(ks[22], (D,), 0.02),
    }


def reference(x, c, rel_bias, router_w, router_bias, norm1_g, norm2_g, ada_w, ada_b, w_in,
              nsa_pe_k, nsa_pe_v, nsa_cmp_w1_k, nsa_cmp_w2_k, nsa_cmp_w1_v, nsa_cmp_w2_v,
              sinks, mix_norm_g, w_out, exp_w_gate, exp_w_up, exp_w_down, final_g):
    c_act = jax.nn.silu(c)
    for l in range(DEPTH):
        mod = c_act @ ada_w[l] + ada_b[l]
        sh1, sc1, g1, sh2, sc2, g2 = jnp.split(mod, 6, axis=-1)
        h = rmsnorm(x, norm1_g[l]) * (1.0 + sc1[:, None]) + sh1[:, None]
        x = x + g1[:, None] * token_mixer(h, w_in[l], rel_bias, sinks[l], nsa_pe_k[l], nsa_pe_v[l],
                                          nsa_cmp_w1_k[l], nsa_cmp_w2_k[l], nsa_cmp_w1_v[l], nsa_cmp_w2_v[l],
                                          mix_norm_g[l], w_out[l])
        h = rmsnorm(x, norm2_g[l]) * (1.0 + sc2[:, None]) + sh2[:, None]
        x = x + g2[:, None] * moe_ffn(h, router_w, router_bias, exp_w_gate[l], exp_w_up[l], exp_w_down[l])
    return rmsnorm(x, final_g)
```

```cpp
#include <hip/hip_runtime.h>
#include <stdint.h>
#include <stdio.h>

typedef unsigned short bf16_t;
#define DI __device__ __forceinline__

constexpr int D = 2048, NBATCH = 4, S = 4096, T = NBATCH * S, DEPTH = 4;
constexpr int LDP = 5144;
constexpr int NPAD_IN = 5248;
constexpr int OFF_QA = 0, OFF_KA = 512, OFF_VA = 1024, OFF_QB = 1536, OFF_KB = 2048, OFF_VB = 2176, OFF_QC = 2304, OFF_KC = 2816,
              OFF_VC = 3328, OFF_QD = 3840, OFF_KDC = 4352, OFF_VDC = 4480, OFF_KDS = 4608, OFF_VDS = 4736, OFF_KDW = 4864,
              OFF_VDW = 4992, OFF_GD = 5120;
constexpr int NCLS = 24, CLS_CAP = T, HID_ROWS = T + NCLS * 128;
constexpr float NEGF = -1e30f;
constexpr float EPS = 1e-6f;

struct P {
    const float* in[23];
    float* out;
    unsigned* ctl;
    float* mod;
    float* xres;
    bf16_t* hbuf;
    bf16_t* proj;
    bf16_t* oA;
    float* lseA;
    bf16_t* oB; bf16_t* oC; bf16_t* oD;
    float* kmean;
    bf16_t* kc; bf16_t* vc;
    int* cls_tok;
    float* tokw;
    bf16_t* hid;
    bf16_t* winT;
    bf16_t* woutT;
    bf16_t* wguT;
    bf16_t* wdT;
    bf16_t* cw1T;
    bf16_t* cw2T;
};
constexpr int CTL_CNT = 8192;

DI float bf2f(bf16_t v) { return __uint_as_float(((unsigned)v) << 16); }
DI bf16_t f2bf(float f) { unsigned u = __float_as_uint(f); u += 0x7fffu + ((u >> 16) & 1u); return (bf16_t)(u >> 16); }
DI float wave_sum(float v) { for (int o = 32; o > 0; o >>= 1) v += __shfl_xor(v, o); return v; }
DI float wave_max(float v) { for (int o = 32; o > 0; o >>= 1) v = fmaxf(v, __shfl_xor(v, o)); return v; }
DI float sigmoidf_(float x) { return 1.f / (1.f + __expf(-x)); }
DI float siluf_(float x) { return x / (1.f + __expf(-x)); }
DI float gelu_tanh(float x) { float u = 0.7978845608028654f * (x + 0.044715f * x * x * x); return 0.5f * x * (1.f + tanhf(u)); }
DI int t5_bucket(int d) {
    if (d < 16) return d < 0 ? 0 : d;
    return 16 + (d >= 22) + (d >= 30) + (d >= 40) + (d >= 54) + (d >= 73) + (d >= 99) + (d >= 134) + (d >= 182) + (d >= 246) + (d >= 332) +
           (d >= 450) + (d >= 609) + (d >= 825) + (d >= 1117) + (d >= 1513);
}

DI void phase_mod_item(const P& p, int item, float* lds) {
    const int l = item / 48, jb = item % 48, tid = threadIdx.x;
    float* cact = lds;
    float* red = lds + 8192;
    const float* c = p.in[1];
    for (int i = tid; i < 4 * 2048; i += 256) cact[i] = siluf_(c[i]);
    __syncthreads();
    const int kq = tid >> 6, lane = tid & 63;
    const float* w = p.in[7] + (size_t)l * 2048 * 12288 + jb * 256 + lane * 4;
    float acc[4][4];
#pragma unroll
    for (int b = 0; b < 4; ++b)
#pragma unroll
        for (int j = 0; j < 4; ++j) acc[b][j] = 0.f;
    for (int k = kq * 512; k < kq * 512 + 512; ++k) {
        const float4 wv = *(const float4*)(w + (size_t)k * 12288);
#pragma unroll
        for (int b = 0; b < 4; ++b) {
            const float cv = cact[b * 2048 + k];
            acc[b][0] += cv * wv.x; acc[b][1] += cv * wv.y; acc[b][2] += cv * wv.z; acc[b][3] += cv * wv.w;
        }
    }
#pragma unroll
    for (int b = 0; b < 4; ++b)
#pragma unroll
        for (int j = 0; j < 4; ++j) red[(kq * 4 + b) * 256 + lane * 4 + j] = acc[b][j];
    __syncthreads();
    for (int i = tid; i < 1024; i += 256) {
        const int b = i >> 8, col = i & 255;
        const float v = red[(0 * 4 + b) * 256 + col] + red[(1 * 4 + b) * 256 + col] + red[(2 * 4 + b) * 256 + col] + red[(3 * 4 + b) * 256 + col];
        p.mod[((size_t)l * 4 + b) * 12288 + jb * 256 + col] = v + p.in[8][(size_t)l * 12288 + jb * 256 + col];
    }
    __syncthreads();
}
constexpr int N_MOD_ITEMS = 4 * 48;

DI void transpose_tile(const float* src, int ld, int k0, int n0, int N, bf16_t* dst, int lddst, int dst_row0, int blkstride, const float* kscale, float* lds) {
    float(*tl)[65] = (float(*)[65])lds;
    const int tid = threadIdx.x;
#pragma unroll 4
    for (int i = 0; i < 16; ++i) {
        const int e = tid + i * 256, kk = e >> 6, nn = e & 63, n = n0 + nn;
        float v = (n < N) ? src[(size_t)(k0 + kk) * ld + n] : 0.f;
        if (kscale) v *= kscale[k0 + kk];
        tl[kk][nn] = v;
    }
    __syncthreads();
#pragma unroll 4
    for (int i = 0; i < 16; ++i) {
        const int e = tid + i * 256, nn = e >> 6, kk = e & 63, n = n0 + nn;
        if (n < N) dst[(size_t)(dst_row0 + (nn >> 5) * blkstride + (nn & 31)) * lddst + k0 + kk] = f2bf(tl[kk][nn]);
    }
    __syncthreads();
}
constexpr int TR0 = 4 * 32 * 81, TR1 = 4 * 32 * 32, TR2 = 4 * 16 * 32 * 8, TR3 = TR2, TR4 = 4 * 16 * 8 * 32, TR5 = 4 * 32 * 2, TR6 = TR5, TR7 = 4 * 2, TR8 = TR7;
constexpr int N_TR_ITEMS = TR0 + TR1 + TR2 + TR3 + TR4 + TR5 + TR6 + TR7 + TR8;
DI void phase_transpose_item(const P& p, int item, float* lds) {
    int i = item;
    if (i < TR0) { const int l = i / (32 * 81), r = i % (32 * 81), kt = r / 81, nt = r % 81;
        transpose_tile(p.in[9] + (size_t)l * 2048 * 5144, 5144, kt * 64, nt * 64, 5144, p.winT + (size_t)l * NPAD_IN * 2048, 2048, nt * 64, 32, nullptr, lds); return; }
    i -= TR0;
    if (i < TR1) { const int l = i / 1024, r = i % 1024, kt = r / 32, nt = r % 32;
        transpose_tile(p.in[18] + (size_t)l * 2048 * 2048, 2048, kt * 64, nt * 64, 2048, p.woutT + (size_t)l * 2048 * 2048, 2048, nt * 64, 32, p.in[17] + (size_t)l * 2048, lds); return; }
    i -= TR1;
    if (i < TR2 + TR3) { const int up = i >= TR2; if (up) i -= TR2; const int le = i / 256, r = i % 256, kt = r / 8, nt = r % 8;
        transpose_tile(p.in[up ? 20 : 19] + (size_t)le * 2048 * 512, 512, kt * 64, nt * 64, 512, p.wguT + (size_t)le * 1024 * 2048, 2048, nt * 128 + (up ? 32 : 0), 64, nullptr, lds); return; }
    i -= TR2 + TR3;
    if (i < TR4) { const int le = i / 256, r = i % 256, kt = r / 32, nt = r % 32;
        transpose_tile(p.in[21] + (size_t)le * 512 * 2048, 2048, kt * 64, nt * 64, 2048, p.wdT + (size_t)le * 2048 * 512, 512, nt * 64, 32, nullptr, lds); return; }
    i -= TR4;
    if (i < TR5 + TR6) { const int v = i >= TR5; if (v) i -= TR5; const int l = i / 64, r = i % 64, kt = r / 2, nt = r % 2;
        transpose_tile(p.in[v ? 14 : 12] + (size_t)l * 2048 * 128, 128, kt * 64, nt * 64, 128, p.cw1T + (size_t)(l * 2 + v) * 128 * 2048, 2048, nt * 64, 32, nullptr, lds); return; }
    i -= TR5 + TR6;
    { const int v = i >= TR7; if (v) i -= TR7; const int l = i / 2, kt = i % 2;
        transpose_tile(p.in[v ? 15 : 13] + (size_t)l * 128 * 64, 64, kt * 64, 0, 64, p.cw2T + (size_t)(l * 2 + v) * 64 * 128, 128, 0, 32, nullptr, lds); }
}

DI void norm_mod_row(const P& p, int l, int row, int which, float (&hv)[32]) {
    const int lane = threadIdx.x & 63, b = row / S;
    const float* x = ((l == 0 && which == 0) ? p.in[0] : p.xres) + (size_t)row * D;
    float ss = 0.f;
#pragma unroll
    for (int i = 0; i < 8; ++i) {
        const float4 v = *(const float4*)(x + i * 256 + lane * 4);
        hv[i * 4 + 0] = v.x; hv[i * 4 + 1] = v.y; hv[i * 4 + 2] = v.z; hv[i * 4 + 3] = v.w;
        ss += v.x * v.x + v.y * v.y + v.z * v.z + v.w * v.w;
    }
    ss = wave_sum(ss);
    const float r = rsqrtf(ss * (1.f / D) + EPS);
    const float* g = p.in[which ? 6 : 5] + (size_t)l * D;
    const float* sh = p.mod + ((size_t)l * 4 + b) * 12288 + (which ? 3 * D : 0);
    const float* sc = sh + D;
    bf16_t* h = p.hbuf + (size_t)row * D;
#pragma unroll
    for (int i = 0; i < 8; ++i) {
        const int col = i * 256 + lane * 4;
        const float4 gv = *(const float4*)(g + col), shv = *(const float4*)(sh + col), scv = *(const float4*)(sc + col);
        hv[i * 4 + 0] = hv[i * 4 + 0] * r * gv.x * (1.f + scv.x) + shv.x;
        hv[i * 4 + 1] = hv[i * 4 + 1] * r * gv.y * (1.f + scv.y) + shv.y;
        hv[i * 4 + 2] = hv[i * 4 + 2] * r * gv.z * (1.f + scv.z) + shv.z;
        hv[i * 4 + 3] = hv[i * 4 + 3] * r * gv.w * (1.f + scv.w) + shv.w;
        uint2 pk;
        pk.x = (unsigned)f2bf(hv[i * 4 + 0]) | ((unsigned)f2bf(hv[i * 4 + 1]) << 16);
        pk.y = (unsigned)f2bf(hv[i * 4 + 2]) | ((unsigned)f2bf(hv[i * 4 + 3]) << 16);
        *(uint2*)(h + col) = pk;
    }
}
DI void phase_norm1_wave(const P& p, int l, int row) { float hv[32]; norm_mod_row(p, l, row, 0, hv); }

DI void phase_norm2_router_wave(const P& p, int l, int row) {
    float hv[32];
    norm_mod_row(p, l, row, 1, hv);
    const int lane = threadIdx.x & 63;
    const float* rw = p.in[3];
    float lg[16];
#pragma unroll
    for (int e = 0; e < 16; ++e) lg[e] = 0.f;
#pragma unroll
    for (int i = 0; i < 8; ++i)
#pragma unroll
        for (int j = 0; j < 4; ++j) {
            const int col = i * 256 + lane * 4 + j;
            const float hvv = hv[i * 4 + j];
            const float4* w4 = (const float4*)(rw + (size_t)col * 16);
            const float4 a = w4[0], bq = w4[1], cq = w4[2], dq = w4[3];
            lg[0] += hvv * a.x; lg[1] += hvv * a.y; lg[2] += hvv * a.z; lg[3] += hvv * a.w;
            lg[4] += hvv * bq.x; lg[5] += hvv * bq.y; lg[6] += hvv * bq.z; lg[7] += hvv * bq.w;
            lg[8] += hvv * cq.x; lg[9] += hvv * cq.y; lg[10] += hvv * cq.z; lg[11] += hvv * cq.w;
            lg[12] += hvv * dq.x; lg[13] += hvv * dq.y; lg[14] += hvv * dq.z; lg[15] += hvv * dq.w;
        }
#pragma unroll
    for (int e = 0; e < 16; ++e) lg[e] = wave_sum(lg[e]);
    if (lane == 0) {
        float aff[16], sc[16];
#pragma unroll
        for (int e = 0; e < 16; ++e) { aff[e] = sigmoidf_(lg[e]); sc[e] = aff[e] + p.in[4][e]; }
        int bg = 0; float bgs = -3e38f;
#pragma unroll
        for (int g = 0; g < 4; ++g) {
            float m1 = -3e38f, m2 = -3e38f;
#pragma unroll
            for (int j = 0; j < 4; ++j) { const float v = sc[g * 4 + j]; if (v > m1) { m2 = m1; m1 = v; } else if (v > m2) m2 = v; }
            const float gs = m1 + m2;
            if (gs > bgs) { bgs = gs; bg = g; }
        }
        float s4[4], a4[4];
#pragma unroll
        for (int g = 0; g < 4; ++g)
#pragma unroll
            for (int j = 0; j < 4; ++j) if (g == bg) { s4[j] = sc[g * 4 + j]; a4[j] = aff[g * 4 + j]; }
        int i1 = 0; float b1 = s4[0];
#pragma unroll
        for (int j = 1; j < 4; ++j) if (s4[j] > b1) { b1 = s4[j]; i1 = j; }
        int i2 = -1; float b2 = -3e38f;
#pragma unroll
        for (int j = 0; j < 4; ++j) if (j != i1 && s4[j] > b2) { b2 = s4[j]; i2 = j; }
        float w1 = 0.f, w2 = 0.f;
#pragma unroll
        for (int j = 0; j < 4; ++j) { if (j == i1) w1 = a4[j]; if (j == i2) w2 = a4[j]; }
        const float inv = 1.f / (w1 + w2);
        w1 *= inv; w2 *= inv;
        const int a = i1 < i2 ? i1 : i2, bb = i1 < i2 ? i2 : i1;
        const float wa = i1 < i2 ? w1 : w2, wb = i1 < i2 ? w2 : w1;
        const int pidx = (a == 0) ? (bb - 1) : (a == 1 ? (bb + 1) : 5);
        const int cls = bg * 6 + pidx;
        const unsigned pos = atomicAdd(p.ctl + CTL_CNT + l * 32 + cls, 1u);
        p.cls_tok[(size_t)cls * CLS_CAP + pos] = row;
        p.tokw[(size_t)row * 2 + 0] = wa; p.tokw[(size_t)row * 2 + 1] = wb;
    }
}

template <class AF, class BF, class EF>
DI void gemm_naive_tile(int K, AF af, BF bfn, EF ef, float* lds) {
    float(*sA)[65] = (float(*)[65])lds;
    float(*sB)[65] = (float(*)[65])(lds + 32 * 65);
    const int tid = threadIdx.x, tx = tid & 15, ty = tid >> 4;
    const int lr = tid >> 2, lk = (tid & 3) * 8;
    float acc[4][4];
#pragma unroll
    for (int i = 0; i < 4; ++i)
#pragma unroll
        for (int j = 0; j < 4; ++j) acc[i][j] = 0.f;
    const bf16_t* arow = af(lr);
    for (int k0 = 0; k0 < K; k0 += 32) {
        const uint4 av = *(const uint4*)(arow + k0 + lk);
        const uint4 bv = *(const uint4*)(bfn(lr, k0) + lk);
        const unsigned au[4] = {av.x, av.y, av.z, av.w}, bu[4] = {bv.x, bv.y, bv.z, bv.w};
#pragma unroll
        for (int j = 0; j < 4; ++j) {
            sA[lk + 2 * j][lr] = __uint_as_float(au[j] << 16); sA[lk + 2 * j + 1][lr] = __uint_as_float(au[j] & 0xffff0000u);
            sB[lk + 2 * j][lr] = __uint_as_float(bu[j] << 16); sB[lk + 2 * j + 1][lr] = __uint_as_float(bu[j] & 0xffff0000u);
        }
        __syncthreads();
#pragma unroll 8
        for (int kk = 0; kk < 32; ++kk) {
            float a[4], b[4];
#pragma unroll
            for (int i = 0; i < 4; ++i) { a[i] = sA[kk][ty * 4 + i]; b[i] = sB[kk][tx + 16 * i]; }
#pragma unroll
            for (int i = 0; i < 4; ++i)
#pragma unroll
                for (int j = 0; j < 4; ++j) acc[i][j] += a[i] * b[j];
        }
        __syncthreads();
    }
    ef(acc, ty * 4, tx);
}

constexpr int N_GIN_TILES = (T / 64) * 81;
DI void phase_gemm_in_item(const P& p, int l, int item, float* lds) {
    const int tm = item / 81, tn = item % 81;
    const bf16_t* A = p.hbuf + (size_t)tm * 64 * D;
    const bf16_t* B = p.winT + ((size_t)l * NPAD_IN + tn * 64) * 2048;
    bf16_t* C = p.proj + (size_t)tm * 64 * LDP + tn * 64;
    const int nvalid = (tn == 80) ? (LDP - 80 * 64) : 64;
    gemm_naive_tile(2048,
        [&](int r) { return A + (size_t)r * D; },
        [&](int c, int k0) { return B + (size_t)c * 2048 + k0; },
        [&](float (&acc)[4][4], int r0, int c0) {
#pragma unroll
            for (int i = 0; i < 4; ++i)
#pragma unroll
                for (int j = 0; j < 4; ++j) { const int c = c0 + 16 * j; if (c < nvalid) C[(size_t)(r0 + i) * LDP + c] = f2bf(acc[i][j]); }
        }, lds);
}
constexpr int N_GOUT_TILES = (T / 64) * 32;
DI void phase_gemm_out_item(const P& p, int l, int item, float* lds) {
    const int tm = item / 32, tn = item % 32;
    const bf16_t* A = p.hbuf + (size_t)tm * 64 * D;
    const bf16_t* B = p.woutT + ((size_t)l * 2048 + tn * 64) * 2048;
    const float* xs = (l == 0 ? p.in[0] : p.xres) + (size_t)tm * 64 * D + tn * 64;
    float* xd = p.xres + (size_t)tm * 64 * D + tn * 64;
    const int b = (tm * 64) / S;
    const float* g1 = p.mod + ((size_t)l * 4 + b) * 12288 + 2 * D + tn * 64;
    gemm_naive_tile(2048,
        [&](int r) { return A + (size_t)r * D; },
        [&](int c, int k0) { return B + (size_t)c * 2048 + k0; },
        [&](float (&acc)[4][4], int r0, int c0) {
#pragma unroll
            for (int i = 0; i < 4; ++i)
#pragma unroll
                for (int j = 0; j < 4; ++j) { const int c = c0 + 16 * j; xd[(size_t)(r0 + i) * D + c] = xs[(size_t)(r0 + i) * D + c] + g1[c] * acc[i][j]; }
        }, lds);
}

DI void cls_experts(int cls, int& ea, int& eb) {
    const int g = cls / 6, pi = cls % 6;
    const int a = pi < 3 ? 0 : (pi < 5 ? 1 : 2);
    const int b = pi < 3 ? pi + 1 : (pi < 5 ? pi - 1 : 3);
    ea = g * 4 + a; eb = g * 4 + b;
}
DI bool cls_find(const unsigned* cnt, int ft, int& cls, int& mt, int& slot_base) {
    int base = 0;
    for (int c = 0; c < NCLS; ++c) {
        const int nt = ((int)cnt[c] + 127) >> 7;
        if (ft < base + nt) { cls = c; mt = ft - base; slot_base = base * 128; return true; }
        base += nt;
    }
    return false;
}
DI int cls_total_tiles(const unsigned* cnt) { int base = 0; for (int c = 0; c < NCLS; ++c) base += ((int)cnt[c] + 127) >> 7; return base; }

DI void phase_moe1(const P& p, int l, int bid, int nblk, float* lds) {
    const unsigned* cnt = p.ctl + CTL_CNT + l * 32;
    const int ntiles = cls_total_tiles(cnt);
    for (int item = bid; item < ntiles * 2 * 32; item += nblk) {
        const int ft = item / 64, r = item % 64, half = r / 32, tn = r % 32;
        int cls, mt, sb; cls_find(cnt, ft, cls, mt, sb);
        int ea, eb; cls_experts(cls, ea, eb);
        const int n = (int)cnt[cls];
        const int row0 = mt * 128 + half * 64;
        const int* toks = p.cls_tok + (size_t)cls * CLS_CAP;
        const int which = tn >= 16;
        const int e = which ? eb : ea;
        const bf16_t* B = p.wguT + (((size_t)l * 16 + e) * 1024 + (tn & 15) * 64) * 2048;
        bf16_t* Hd = p.hid + (size_t)(sb + row0) * 1024 + tn * 32;
        gemm_naive_tile(2048,
            [&](int rr) { const int ri = row0 + rr; const int tok = ri < n ? toks[ri] : toks[0]; return p.hbuf + (size_t)tok * D; },
            [&](int c, int k0) { return B + (size_t)c * 2048 + k0; },
            [&](float (&acc)[4][4], int r0, int c0) {
#pragma unroll
                for (int i = 0; i < 4; ++i) {
                    const int ri = row0 + r0 + i;
                    if (ri < n) {
                        const float w = p.tokw[(size_t)toks[ri] * 2 + which];
                        Hd[(size_t)(r0 + i) * 1024 + c0] = f2bf(siluf_(acc[i][0]) * acc[i][2] * w);
                        Hd[(size_t)(r0 + i) * 1024 + c0 + 16] = f2bf(siluf_(acc[i][1]) * acc[i][3] * w);
                    }
                }
            }, lds);
    }
}
DI void phase_moe2(const P& p, int l, int bid, int nblk, float* lds) {
    const unsigned* cnt = p.ctl + CTL_CNT + l * 32;
    const int ntiles = cls_total_tiles(cnt);
    for (int item = bid; item < ntiles * 2 * 32; item += nblk) {
        const int ft = item / 64, r = item % 64, half = r / 32, tn = r % 32;
        int cls, mt, sb; cls_find(cnt, ft, cls, mt, sb);
        int ea, eb; cls_experts(cls, ea, eb);
        const int n = (int)cnt[cls];
        const int row0 = mt * 128 + half * 64;
        const int* toks = p.cls_tok + (size_t)cls * CLS_CAP;
        const bf16_t* A = p.hid + (size_t)(sb + row0) * 1024;
        const bf16_t* Ba = p.wdT + (((size_t)l * 16 + ea) * 2048 + tn * 64) * 512;
        const bf16_t* Bb = p.wdT + (((size_t)l * 16 + eb) * 2048 + tn * 64) * 512;
        gemm_naive_tile(1024,
            [&](int rr) { return A + (size_t)rr * 1024; },
            [&](int c, int k0) { return k0 < 512 ? (Ba + (size_t)c * 512 + k0) : (Bb + (size_t)c * 512 + (k0 - 512)); },
            [&](float (&acc)[4][4], int r0, int c0) {
#pragma unroll
                for (int i = 0; i < 4; ++i) {
                    const int ri = row0 + r0 + i;
                    if (ri < n) {
                        const int tok = toks[ri];
                        const int b = tok / S;
                        const float* g2 = p.mod + ((size_t)l * 4 + b) * 12288 + 5 * D + tn * 64;
                        float* xr = p.xres + (size_t)tok * D + tn * 64;
#pragma unroll
                        for (int j = 0; j < 4; ++j) { const int c = c0 + 16 * j; xr[c] += g2[c] * acc[i][j]; }
                    }
                }
            }, lds);
    }
}

constexpr int N_KMEAN_ITEMS = 4 * 8 * 16;
DI void phase_kmean_item(const P& p, int item, float* lds) {
    const int b = item / 128, h = (item / 16) % 8, blk = item % 16, tid = threadIdx.x, d = tid & 63, part = tid >> 6;
    const bf16_t* k = p.proj + ((size_t)b * S + blk * 256 + part * 64) * LDP + OFF_KC + h * 64 + d;
    float s = 0.f;
    for (int i = 0; i < 64; ++i) s += bf2f(k[(size_t)i * LDP]);
    lds[tid] = s;
    __syncthreads();
    if (tid < 64) p.kmean[(size_t)item * 64 + tid] = (lds[tid] + lds[tid + 64] + lds[tid + 128] + lds[tid + 192]) * (1.f / 256.f);
    __syncthreads();
}
constexpr int N_CMP_ITEMS = 2 * 4 * 2 * 255;
DI void phase_cmp_item(const P& p, int l, int item, float* lds) {
    const int v = item / (4 * 2 * 255), r = item % (4 * 2 * 255), b = r / 510, hk = (r / 255) % 2, n = r % 255, tid = threadIdx.x;
    float* in = lds;
    float* part = lds + 2048;
    float* hd = lds + 2304;
    const float* pe = p.in[v ? 11 : 10] + (size_t)l * 2048;
    const bf16_t* src = p.proj + ((size_t)b * S + 16 * n) * LDP + (v ? OFF_VDC : OFF_KDC) + hk * 64;
    for (int i = tid; i < 2048; i += 256) in[i] = bf2f(src[(size_t)(i >> 6) * LDP + (i & 63)]) + pe[i];
    __syncthreads();
    const float* w1 = p.in[v ? 14 : 12] + (size_t)l * 2048 * 128;
    { const int j = tid & 127, half = tid >> 7; float s = 0.f;
      for (int i = half * 1024; i < half * 1024 + 1024; ++i) s += in[i] * w1[(size_t)i * 128 + j];
      part[tid] = s; }
    __syncthreads();
    if (tid < 128) hd[tid] = gelu_tanh(part[tid] + part[tid + 128]);
    __syncthreads();
    const float* w2 = p.in[v ? 15 : 13] + (size_t)l * 128 * 64;
    { const int d = tid & 63, q = tid >> 6; float s = 0.f;
      for (int j = q * 32; j < q * 32 + 32; ++j) s += hd[j] * w2[j * 64 + d];
      part[tid] = s; }
    __syncthreads();
    if (tid < 64) (v ? p.vc : p.kc)[(((size_t)b * 2 + hk) * 256 + n) * 64 + tid] = f2bf(part[tid] + part[tid + 64] + part[tid + 128] + part[tid + 192]);
    __syncthreads();
}

DI void wave_lds_sync() { asm volatile("s_waitcnt lgkmcnt(0)" ::: "memory"); __builtin_amdgcn_wave_barrier(); }

template <class C>
DI float attn_wave(const bf16_t* qrow, const C& cand, int ncand, bool has_sink, float sink, float* sl, float& lse_out) {
    const int lane = threadIdx.x & 63;
    float q[64];
#pragma unroll
    for (int i = 0; i < 8; ++i) {
        const uint4 v = *(const uint4*)(qrow + i * 8);
        const unsigned u[4] = {v.x, v.y, v.z, v.w};
#pragma unroll
        for (int j = 0; j < 4; ++j) { q[i * 8 + 2 * j] = __uint_as_float(u[j] << 16); q[i * 8 + 2 * j + 1] = __uint_as_float(u[j] & 0xffff0000u); }
    }
    float mx = NEGF;
    for (int c0 = 0; c0 < ncand; c0 += 64) {
        const int c = c0 + lane;
        float s = NEGF;
        if (c < ncand) {
            const bf16_t *kr, *vr; float bias;
            if (cand.get(c, kr, vr, bias)) {
                float dot = 0.f;
#pragma unroll
                for (int i = 0; i < 8; ++i) {
                    const uint4 v = *(const uint4*)(kr + i * 8);
                    const unsigned u[4] = {v.x, v.y, v.z, v.w};
#pragma unroll
                    for (int j = 0; j < 4; ++j) { dot += q[i * 8 + 2 * j] * __uint_as_float(u[j] << 16); dot += q[i * 8 + 2 * j + 1] * __uint_as_float(u[j] & 0xffff0000u); }
                }
                s = dot * 0.125f + bias;
            }
            sl[c] = s;
        }
        mx = fmaxf(mx, s);
    }
    mx = wave_max(mx);
    if (has_sink) mx = fmaxf(mx, sink);
    float sum = 0.f;
    for (int c0 = 0; c0 < ncand; c0 += 64) {
        const int c = c0 + lane;
        if (c < ncand) { const float s = sl[c]; const float e = (s > -1e29f) ? __expf(s - mx) : 0.f; sl[c] = e; sum += e; }
    }
    sum = wave_sum(sum);
    if (has_sink) sum += __expf(sink - mx);
    sum = fmaxf(sum, 1.17549435e-38f);
    lse_out = mx + logf(sum);
    const float inv = 1.f / sum;
    for (int c0 = 0; c0 < ncand; c0 += 64) { const int c = c0 + lane; if (c < ncand) sl[c] *= inv; }
    wave_lds_sync();
    float o = 0.f;
    for (int c = 0; c < ncand; ++c) {
        const float pr = sl[c];
        if (pr != 0.f) { const bf16_t *kr, *vr; float bias; cand.get(c, kr, vr, bias); o += pr * bf2f(vr[lane]); }
    }
    return o;
}

struct BandCand {
    const bf16_t *kb, *vb; int t, r; const float* tab;
    DI bool get(int c, const bf16_t*& kr, const bf16_t*& vr, float& bias) const {
        const int kp = t - c * r; if (kp < 0) return false;
        kr = kb + (size_t)kp * LDP; vr = vb + (size_t)kp * LDP; bias = tab[t5_bucket(c * r) * 32]; return true;
    }
};
struct MobaCand {
    const bf16_t *kb, *vb; int t; const int* sel; const float* tab;
    DI bool get(int c, const bf16_t*& kr, const bf16_t*& vr, float& bias) const {
        const int blk = sel[c >> 8], j = c & 255;
        if (blk < 0) return false;
        const int kp = blk * 256 + j; if (kp > t) return false;
        kr = kb + (size_t)kp * LDP; vr = vb + (size_t)kp * LDP; bias = tab[t5_bucket(t - kp) * 32]; return true;
    }
};
struct CmpCand {
    const bf16_t *kc, *vc; int t;
    DI bool get(int c, const bf16_t*& kr, const bf16_t*& vr, float& bias) const {
        if (16 * c + 31 > t) return false;
        kr = kc + (size_t)c * 64; vr = vc + (size_t)c * 64; bias = 0.f; return true;
    }
};
struct SlcCand {
    const bf16_t *kb, *vb; int t; const int* sel; const float* tab;
    DI bool get(int c, const bf16_t*& kr, const bf16_t*& vr, float& bias) const {
        const int blk = sel[c >> 6]; if (blk < 0) return false;
        const int kp = blk * 64 + (c & 63); if (kp > t) return false;
        kr = kb + (size_t)kp * LDP; vr = vb + (size_t)kp * LDP; bias = tab[t5_bucket(t - kp) * 32]; return true;
    }
};

constexpr int N_ATT_WAVE_ITEMS = 3 * T * 8 + T * 8 + T * 8;
DI void phase_attn_wave_item(const P& p, int l, int item, float* sl) {
    const int lane = threadIdx.x & 63;
    const float* relb = p.in[2];
    if (item < 3 * T * 8) {
        const int cfg = item / (T * 8), rem = item % (T * 8), row = rem >> 3, h = rem & 7, b = row / S, t = row % S;
        const int r = cfg == 0 ? 1 : (cfg == 1 ? 4 : 16);
        BandCand cd{p.proj + (size_t)b * S * LDP + OFF_KA + h * 64, p.proj + (size_t)b * S * LDP + OFF_VA + h * 64, t, r, relb + 0 + h};
        float lse;
        const float o = attn_wave(p.proj + (size_t)row * LDP + OFF_QA + h * 64, cd, 129, false, 0.f, sl, lse);
        p.oA[((size_t)cfg * T + row) * 512 + h * 64 + lane] = f2bf(o);
        if (lane == 0) p.lseA[((size_t)cfg * T + row) * 8 + h] = lse;
        return;
    }
    item -= 3 * T * 8;
    if (item < T * 8) {
        const int row = item >> 3, hq = item & 7, kvh = hq >> 2, b = row / S, t = row % S;
        BandCand cd{p.proj + (size_t)b * S * LDP + OFF_KB + kvh * 64, p.proj + (size_t)b * S * LDP + OFF_VB + kvh * 64, t, 1, relb + 8 + hq};
        float lse;
        const float o = attn_wave(p.proj + (size_t)row * LDP + OFF_QB + hq * 64, cd, 128, true, p.in[16][l * 8 + hq], sl, lse);
        p.oB[(size_t)row * 512 + hq * 64 + lane] = f2bf(o);
        return;
    }
    item -= T * 8;
    {
        const int row = item >> 3, h = item & 7, b = row / S, t = row % S, cur = t >> 8;
        const bf16_t* qrow = p.proj + (size_t)row * LDP + OFF_QC + h * 64;
        float gate = NEGF;
        if (lane < cur) {
            const float* km = p.kmean + (((size_t)b * 8 + h) * 16 + lane) * 64;
            float dot = 0.f;
            for (int d = 0; d < 64; ++d) dot += bf2f(qrow[d]) * km[d];
            gate = dot;
        }
        int s0, s1, s2;
        { float v = gate; int idx = lane;
          for (int o = 32; o > 0; o >>= 1) { const float ov = __shfl_xor(v, o); const int oi = __shfl_xor(idx, o); if (ov > v || (ov == v && oi < idx)) { v = ov; idx = oi; } }
          s0 = (v > -1e29f) ? idx : -1; if (lane == idx) gate = -3e38f; }
        { float v = gate; int idx = lane;
          for (int o = 32; o > 0; o >>= 1) { const float ov = __shfl_xor(v, o); const int oi = __shfl_xor(idx, o); if (ov > v || (ov == v && oi < idx)) { v = ov; idx = oi; } }
          s1 = (v > -1e29f) ? idx : -1; if (lane == idx) gate = -3e38f; }
        { float v = gate; int idx = lane;
          for (int o = 32; o > 0; o >>= 1) { const float ov = __shfl_xor(v, o); const int oi = __shfl_xor(idx, o); if (ov > v || (ov == v && oi < idx)) { v = ov; idx = oi; } }
          s2 = (v > -1e29f) ? idx : -1; if (lane == idx) gate = -3e38f; }
        int* selw = (int*)(sl + 1024 * (4 - (int)(threadIdx.x >> 6))) + 16 + 4 * (threadIdx.x >> 6);
        if (lane == 0) { selw[0] = s0; selw[1] = s1; selw[2] = s2; selw[3] = cur; }
        wave_lds_sync();
        MobaCand cd{p.proj + (size_t)b * S * LDP + OFF_KC + h * 64, p.proj + (size_t)b * S * LDP + OFF_VC + h * 64, t, selw, relb + 16 + h};
        float lse;
        const float o = attn_wave(qrow, cd, 1024, false, 0.f, sl, lse);
        p.oC[(size_t)row * 512 + h * 64 + lane] = f2bf(o);
    }
}
constexpr int N_NSA_ITEMS = 4 * 2 * S;
DI void phase_nsa_item(const P& p, int l, int item, float* lds) {
    const int b = item / (2 * S), hk = (item / S) % 2, t = item % S, tid = threadIdx.x, g = tid >> 6, lane = tid & 63, hq = hk * 4 + g;
    const int row = b * S + t, cur = t >> 6;
    float* sl = lds + g * 1024;
    int* sel = (int*)(lds + 4096);
    const bf16_t* qrow = p.proj + (size_t)row * LDP + OFF_QD + hq * 64;
    const float* relb = p.in[2];
    float lse;
    CmpCand cc{p.kc + ((size_t)b * 2 + hk) * 256 * 64, p.vc + ((size_t)b * 2 + hk) * 256 * 64, t};
    const float o_cmp = attn_wave(qrow, cc, 255, false, 0.f, sl, lse);
    __syncthreads();
    if (g == 0) {
        const int j = lane;
        float imp = 0.f;
        for (int n = 4 * j - 1; n <= 4 * j + 3; ++n)
            if (n >= 0 && n < 255) imp += lds[n] + lds[1024 + n] + lds[2048 + n] + lds[3072 + n];
        float val = (j == 0 || j == cur || j == cur - 1) ? 1e30f : (j <= cur ? imp : NEGF);
        for (int k = 0; k < 16; ++k) {
            float v = val; int idx = lane;
            for (int o = 32; o > 0; o >>= 1) { const float ov = __shfl_xor(v, o); const int oi = __shfl_xor(idx, o); if (ov > v || (ov == v && oi < idx)) { v = ov; idx = oi; } }
            if (lane == 0) sel[k] = (v > -1e29f) ? idx : -1;
            if (lane == idx) val = -3e38f;
        }
    }
    __syncthreads();
    SlcCand sc{p.proj + (size_t)b * S * LDP + OFF_KDS + hk * 64, p.proj + (size_t)b * S * LDP + OFF_VDS + hk * 64, t, sel, relb + 24 + hq};
    const float o_slc = attn_wave(qrow, sc, 1024, false, 0.f, sl, lse);
    BandCand wc{p.proj + (size_t)b * S * LDP + OFF_KDW + hk * 64, p.proj + (size_t)b * S * LDP + OFF_VDW + hk * 64, t, 1, relb + 24 + hq};
    const float o_win = attn_wave(qrow, wc, 512, false, 0.f, sl, lse);
    const bf16_t* gd = p.proj + (size_t)row * LDP + OFF_GD + hq * 3;
    const float g0 = sigmoidf_(bf2f(gd[0])), g1 = sigmoidf_(bf2f(gd[1])), g2 = sigmoidf_(bf2f(gd[2]));
    p.oD[(size_t)row * 512 + hq * 64 + lane] = f2bf(g0 * o_cmp + g1 * o_slc + g2 * o_win);
    __syncthreads();
}

constexpr int N_MIXN_WAVE_ITEMS = T * 4;
DI void phase_mixnorm_wave(const P& p, int item) {
    const int row = item >> 2, grp = item & 3, lane = threadIdx.x & 63, h = lane >> 3;
    float v[8];
    if (grp == 0) {
        const float l0 = p.lseA[((size_t)0 * T + row) * 8 + h], l1 = p.lseA[((size_t)1 * T + row) * 8 + h], l2 = p.lseA[((size_t)2 * T + row) * 8 + h];
        const float m = fmaxf(l0, fmaxf(l1, l2));
        float w0 = __expf(l0 - m), w1 = __expf(l1 - m), w2 = __expf(l2 - m);
        const float inv = 1.f / (w0 + w1 + w2); w0 *= inv; w1 *= inv; w2 *= inv;
        const uint4 a = *(const uint4*)(p.oA + ((size_t)0 * T + row) * 512 + lane * 8);
        const uint4 bq = *(const uint4*)(p.oA + ((size_t)1 * T + row) * 512 + lane * 8);
        const uint4 c = *(const uint4*)(p.oA + ((size_t)2 * T + row) * 512 + lane * 8);
        const unsigned au[4] = {a.x, a.y, a.z, a.w}, bu[4] = {bq.x, bq.y, bq.z, bq.w}, cu[4] = {c.x, c.y, c.z, c.w};
#pragma unroll
        for (int j = 0; j < 4; ++j) {
            v[2 * j] = w0 * __uint_as_float(au[j] << 16) + w1 * __uint_as_float(bu[j] << 16) + w2 * __uint_as_float(cu[j] << 16);
            v[2 * j + 1] = w0 * __uint_as_float(au[j] & 0xffff0000u) + w1 * __uint_as_float(bu[j] & 0xffff0000u) + w2 * __uint_as_float(cu[j] & 0xffff0000u);
        }
    } else {
        const bf16_t* src = (grp == 1 ? p.oB : (grp == 2 ? p.oC : p.oD)) + (size_t)row * 512 + lane * 8;
        const uint4 a = *(const uint4*)src;
        const unsigned au[4] = {a.x, a.y, a.z, a.w};
#pragma unroll
        for (int j = 0; j < 4; ++j) { v[2 * j] = __uint_as_float(au[j] << 16); v[2 * j + 1] = __uint_as_float(au[j] & 0xffff0000u); }
    }
    float ss = 0.f;
#pragma unroll
    for (int j = 0; j < 8; ++j) ss += v[j] * v[j];
    ss = wave_sum(ss);
    const float r = rsqrtf(ss * (1.f / 512.f) + EPS);
    uint4 o;
    o.x = (unsigned)f2bf(v[0] * r) | ((unsigned)f2bf(v[1] * r) << 16);
    o.y = (unsigned)f2bf(v[2] * r) | ((unsigned)f2bf(v[3] * r) << 16);
    o.z = (unsigned)f2bf(v[4] * r) | ((unsigned)f2bf(v[5] * r) << 16);
    o.w = (unsigned)f2bf(v[6] * r) | ((unsigned)f2bf(v[7] * r) << 16);
    *(uint4*)(p.hbuf + (size_t)row * D + grp * 512 + lane * 8) = o;
}

DI void phase_final_wave(const P& p, int row) {
    const int lane = threadIdx.x & 63;
    const float* x = p.xres + (size_t)row * D;
    float4 v[8]; float ss = 0.f;
#pragma unroll
    for (int i = 0; i < 8; ++i) { v[i] = *(const float4*)(x + i * 256 + lane * 4); ss += v[i].x * v[i].x + v[i].y * v[i].y + v[i].z * v[i].z + v[i].w * v[i].w; }
    ss = wave_sum(ss);
    const float r = rsqrtf(ss * (1.f / D) + EPS);
#pragma unroll
    for (int i = 0; i < 8; ++i) {
        const float4 g = *(const float4*)(p.in[22] + i * 256 + lane * 4);
        float4 o; o.x = v[i].x * r * g.x; o.y = v[i].y * r * g.y; o.z = v[i].z * r * g.z; o.w = v[i].w * r * g.w;
        *(float4*)(p.out + (size_t)row * D + i * 256 + lane * 4) = o;
    }
}

constexpr int LDS_FLOATS = 12288 + 64;
#define KWRAP_HEAD extern __shared__ __attribute__((aligned(16))) float lds[];
__global__ void __launch_bounds__(256) k_prep(P p) { KWRAP_HEAD
    for (int it = blockIdx.x; it < N_MOD_ITEMS + N_TR_ITEMS; it += gridDim.x) { if (it < N_MOD_ITEMS) phase_mod_item(p, it, lds); else phase_transpose_item(p, it - N_MOD_ITEMS, lds); } }
__global__ void __launch_bounds__(256) k_norm1(P p, int l) {
    const int w = threadIdx.x >> 6;
    for (int it = blockIdx.x * 4 + w; it < T; it += gridDim.x * 4) phase_norm1_wave(p, l, it); }
__global__ void __launch_bounds__(256) k_gemm_in(P p, int l) { KWRAP_HEAD
    for (int it = blockIdx.x; it < N_GIN_TILES; it += gridDim.x) phase_gemm_in_item(p, l, it, lds); }
__global__ void __launch_bounds__(256) k_preattn(P p, int l) { KWRAP_HEAD
    for (int it = blockIdx.x; it < N_KMEAN_ITEMS + N_CMP_ITEMS; it += gridDim.x) { if (it < N_KMEAN_ITEMS) phase_kmean_item(p, it, lds); else phase_cmp_item(p, l, it - N_KMEAN_ITEMS, lds); } }
__global__ void __launch_bounds__(256) k_attn(P p, int l) { KWRAP_HEAD
    const int w = threadIdx.x >> 6;
    for (int it = blockIdx.x; it < N_NSA_ITEMS; it += gridDim.x) phase_nsa_item(p, l, it, lds);
    for (int it = blockIdx.x * 4 + w; it < N_ATT_WAVE_ITEMS; it += gridDim.x * 4) phase_attn_wave_item(p, l, it, lds + w * 1024); }
__global__ void __launch_bounds__(256) k_mixnorm(P p) {
    const int w = threadIdx.x >> 6;
    for (int it = blockIdx.x * 4 + w; it < N_MIXN_WAVE_ITEMS; it += gridDim.x * 4) phase_mixnorm_wave(p, it); }
__global__ void __launch_bounds__(256) k_gemm_out(P p, int l) { KWRAP_HEAD
    for (int it = blockIdx.x; it < N_GOUT_TILES; it += gridDim.x) phase_gemm_out_item(p, l, it, lds); }
__global__ void __launch_bounds__(256) k_norm2(P p, int l) {
    const int w = threadIdx.x >> 6;
    for (int it = blockIdx.x * 4 + w; it < T; it += gridDim.x * 4) phase_norm2_router_wave(p, l, it); }
__global__ void __launch_bounds__(256) k_moe1(P p, int l) { KWRAP_HEAD phase_moe1(p, l, blockIdx.x, gridDim.x, lds); }
__global__ void __launch_bounds__(256) k_moe2(P p, int l) { KWRAP_HEAD phase_moe2(p, l, blockIdx.x, gridDim.x, lds); }
__global__ void __launch_bounds__(256) k_final(P p) {
    const int w = threadIdx.x >> 6;
    for (int it = blockIdx.x * 4 + w; it < T; it += gridDim.x * 4) phase_final_wave(p, it); }

extern "C" void kernel_launch(void* const* d_in, const int* in_sizes, int n_in, void* d_out, int out_size, void* d_ws, size_t ws_size, hipStream_t stream) {
    P p{};
    for (int i = 0; i < 23; ++i) p.in[i] = (const float*)d_in[i];
    p.out = (float*)d_out;
    unsigned char* w = (unsigned char*)d_ws;
    size_t off = 0;
    auto take = [&](size_t bytes) { unsigned char* r = w + off; off += (bytes + 255) & ~(size_t)255; return r; };
    p.ctl = (unsigned*)take(1 << 20);
    p.mod = (float*)take((size_t)4 * 4 * 12288 * 4);
    p.xres = (float*)take((size_t)T * D * 4);
    p.hbuf = (bf16_t*)take((size_t)T * D * 2);
    p.proj = (bf16_t*)take((size_t)T * LDP * 2);
    p.oA = (bf16_t*)take((size_t)3 * T * 512 * 2);
    p.lseA = (float*)take((size_t)3 * T * 8 * 4);
    p.oB = (bf16_t*)take((size_t)T * 512 * 2);
    p.oC = (bf16_t*)take((size_t)T * 512 * 2);
    p.oD = (bf16_t*)take((size_t)T * 512 * 2);
    p.kmean = (float*)take((size_t)4 * 8 * 16 * 64 * 4);
    p.kc = (bf16_t*)take((size_t)4 * 2 * 256 * 64 * 2);
    p.vc = (bf16_t*)take((size_t)4 * 2 * 256 * 64 * 2);
    p.cls_tok = (int*)take((size_t)NCLS * CLS_CAP * 4);
    p.tokw = (float*)take((size_t)T * 2 * 4);
    p.hid = (bf16_t*)take((size_t)HID_ROWS * 1024 * 2);
    p.winT = (bf16_t*)take((size_t)4 * NPAD_IN * 2048 * 2);
    p.woutT = (bf16_t*)take((size_t)4 * 2048 * 2048 * 2);
    p.wguT = (bf16_t*)take((size_t)4 * 16 * 1024 * 2048 * 2);
    p.wdT = (bf16_t*)take((size_t)4 * 16 * 2048 * 512 * 2);
    p.cw1T = (bf16_t*)take((size_t)4 * 2 * 128 * 2048 * 2);
    p.cw2T = (bf16_t*)take((size_t)4 * 2 * 64 * 128 * 2);
    if (off > ws_size) { fprintf(stderr, "workspace too small: need %zu have %zu\n", off, ws_size); return; }
    hipMemsetAsync(p.ctl, 0, 1 << 20, stream);
    const int G = 2048;
    const size_t LB = LDS_FLOATS * 4;
    k_prep<<<G, 256, LB, stream>>>(p);
    for (int l = 0; l < DEPTH; ++l) {
        k_norm1<<<G, 256, 0, stream>>>(p, l);
        k_gemm_in<<<G, 256, LB, stream>>>(p, l);
        k_preattn<<<G, 256, LB, stream>>>(p, l);
        k_attn<<<G, 256, LB, stream>>>(p, l);
        k_mixnorm<<<G, 256, 0, stream>>>(p);
        k_gemm_out<<<G, 256, LB, stream>>>(p, l);
        k_norm2<<<G, 256, 0, stream>>>(p, l);
        k_moe1<<<G, 256, LB, stream>>>(p, l);
        k_moe2<<<G, 256, LB, stream>>>(p, l);
    }
    k_final<<<G, 256, 0, stream>>>(p);
}
```

```cpp
#include <hip/hip_runtime.h>
#include <stdint.h>
#include <stdio.h>

typedef unsigned short bf16_t;
#define DI __device__ __forceinline__

constexpr int D = 2048, NBATCH = 4, S = 4096, T = NBATCH * S, DEPTH = 4;
constexpr int LDP = 5144;
constexpr int NPAD_IN = 5248;
constexpr int OFF_QA = 0, OFF_KA = 512, OFF_VA = 1024, OFF_QB = 1536, OFF_KB = 2048, OFF_VB = 2176, OFF_QC = 2304, OFF_KC = 2816,
              OFF_VC = 3328, OFF_QD = 3840, OFF_KDC = 4352, OFF_VDC = 4480, OFF_KDS = 4608, OFF_VDS = 4736, OFF_KDW = 4864,
              OFF_VDW = 4992, OFF_GD = 5120;
constexpr int NCLS = 24, CLS_CAP = T, HID_ROWS = T + NCLS * 128;
constexpr float NEGF = -1e30f;
constexpr float EPS = 1e-6f;

struct P {
    const float* in[23];
    float* out;
    unsigned* ctl;
    float* mod;
    float* xres;
    bf16_t* hbuf;
    bf16_t* proj;
    bf16_t* oA;
    float* lseA;
    bf16_t* oB; bf16_t* oC; bf16_t* oD;
    float* kmean;
    bf16_t* kc; bf16_t* vc;
    int* cls_tok;
    float* tokw;
    bf16_t* hid;
    bf16_t* winT;
    bf16_t* woutT;
    bf16_t* wguT;
    bf16_t* wdT;
    bf16_t* cw1T;
    bf16_t* cw2T;
};
constexpr size_t al256(size_t x) { return (x + 255) & ~(size_t)255; }
constexpr size_t O_CTL = 0;
constexpr size_t O_MOD = O_CTL + al256((size_t)1 << 20);
constexpr size_t O_XRES = O_MOD + al256((size_t)4 * 4 * 12288 * 4);
constexpr size_t O_HBUF = O_XRES + al256((size_t)T * D * 4);
constexpr size_t O_PROJ = O_HBUF + al256((size_t)T * D * 2);
constexpr size_t O_OA = O_PROJ + al256((size_t)T * LDP * 2);
constexpr size_t O_LSEA = O_OA + al256((size_t)3 * T * 512 * 2);
constexpr size_t O_OB = O_LSEA + al256((size_t)3 * T * 8 * 4);
constexpr size_t O_OC = O_OB + al256((size_t)T * 512 * 2);
constexpr size_t O_OD = O_OC + al256((size_t)T * 512 * 2);
constexpr size_t O_KMEAN = O_OD + al256((size_t)T * 512 * 2);
constexpr size_t O_KC = O_KMEAN + al256((size_t)4 * 8 * 16 * 64 * 4);
constexpr size_t O_VC = O_KC + al256((size_t)4 * 2 * 256 * 64 * 2);
constexpr size_t O_CLSTOK = O_VC + al256((size_t)4 * 2 * 256 * 64 * 2);
constexpr size_t O_TOKW = O_CLSTOK + al256((size_t)NCLS * CLS_CAP * 4);
constexpr size_t O_HID = O_TOKW + al256((size_t)T * 2 * 4);
constexpr size_t O_WINT = O_HID + al256((size_t)HID_ROWS * 1024 * 2);
constexpr size_t O_WOUTT = O_WINT + al256((size_t)4 * NPAD_IN * 2048 * 2);
constexpr size_t O_WGUT = O_WOUTT + al256((size_t)4 * 2048 * 2048 * 2);
constexpr size_t O_WDT = O_WGUT + al256((size_t)4 * 16 * 1024 * 2048 * 2);
constexpr size_t O_CW1T = O_WDT + al256((size_t)4 * 16 * 2048 * 512 * 2);
constexpr size_t O_CW2T = O_CW1T + al256((size_t)4 * 2 * 128 * 2048 * 2);
constexpr size_t WS_NEED = O_CW2T + al256((size_t)4 * 2 * 64 * 128 * 2);
struct KArgs { const float* in[23]; float* out; unsigned char* ws; };
constexpr int CTL_CNT = 8192;

DI int tidx() { int t = threadIdx.x; asm volatile("" : "+v"(t)); return t; }
DI float bf2f(bf16_t v) { return __uint_as_float(((unsigned)v) << 16); }
DI bf16_t f2bf(float f) { unsigned u = __float_as_uint(f); u += 0x7fffu + ((u >> 16) & 1u); return (bf16_t)(u >> 16); }
DI float wave_sum(float v) { for (int o = 32; o > 0; o >>= 1) v += __shfl_xor(v, o); return v; }
DI float wave_max(float v) { for (int o = 32; o > 0; o >>= 1) v = fmaxf(v, __shfl_xor(v, o)); return v; }
DI void wave_lds_sync() { asm volatile("s_waitcnt lgkmcnt(0)" ::: "memory"); __builtin_amdgcn_wave_barrier(); }
DI float sigmoidf_(float x) { return 1.f / (1.f + __expf(-x)); }
DI float siluf_(float x) { return x / (1.f + __expf(-x)); }
DI float gelu_tanh(float x) { float u = 0.7978845608028654f * (x + 0.044715f * x * x * x); return 0.5f * x * (1.f + tanhf(u)); }
DI int t5_bucket(int d) {
    if (d < 16) return d < 0 ? 0 : d;
    return 16 + (d >= 22) + (d >= 30) + (d >= 40) + (d >= 54) + (d >= 73) + (d >= 99) + (d >= 134) + (d >= 182) + (d >= 246) + (d >= 332) +
           (d >= 450) + (d >= 609) + (d >= 825) + (d >= 1117) + (d >= 1513);
}

DI void phase_mod_item(const P& p, int item, float* lds) {
    const int l = item / 48, jb = item % 48, tid = tidx();
    float* cact = lds;
    float* red = lds + 8192;
    const float* c = p.in[1];
    for (int i = tid; i < 4 * 2048; i += 256) cact[i] = siluf_(c[i]);
    __syncthreads();
    const int kq = tid >> 6, lane = tid & 63;
    const float* w = p.in[7] + (size_t)l * 2048 * 12288 + jb * 256 + lane * 4;
    float acc[4][4];
#pragma unroll
    for (int b = 0; b < 4; ++b)
#pragma unroll
        for (int j = 0; j < 4; ++j) acc[b][j] = 0.f;
    for (int k = kq * 512; k < kq * 512 + 512; ++k) {
        const float4 wv = *(const float4*)(w + (size_t)k * 12288);
#pragma unroll
        for (int b = 0; b < 4; ++b) {
            const float cv = cact[b * 2048 + k];
            acc[b][0] += cv * wv.x; acc[b][1] += cv * wv.y; acc[b][2] += cv * wv.z; acc[b][3] += cv * wv.w;
        }
    }
#pragma unroll
    for (int b = 0; b < 4; ++b)
#pragma unroll
        for (int j = 0; j < 4; ++j) red[(kq * 4 + b) * 256 + lane * 4 + j] = acc[b][j];
    __syncthreads();
    for (int i = tid; i < 1024; i += 256) {
        const int b = i >> 8, col = i & 255;
        const float v = red[(0 * 4 + b) * 256 + col] + red[(1 * 4 + b) * 256 + col] + red[(2 * 4 + b) * 256 + col] + red[(3 * 4 + b) * 256 + col];
        p.mod[((size_t)l * 4 + b) * 12288 + jb * 256 + col] = v + p.in[8][(size_t)l * 12288 + jb * 256 + col];
    }
    __syncthreads();
}
constexpr int N_MOD_ITEMS = 4 * 48;

DI void transpose_tile(const float* src, int ld, int k0, int n0, int N, bf16_t* dst, int lddst, int dst_row0, int blkstride, const float* kscale, float* lds) {
    float(*tl)[65] = (float(*)[65])lds;
    const int tid = tidx();
#pragma unroll 4
    for (int i = 0; i < 16; ++i) {
        const int e = tid + i * 256, kk = e >> 6, nn = e & 63, n = n0 + nn;
        float v = (n < N) ? src[(size_t)(k0 + kk) * ld + n] : 0.f;
        if (kscale) v *= kscale[k0 + kk];
        tl[kk][nn] = v;
    }
    __syncthreads();
#pragma unroll 4
    for (int i = 0; i < 16; ++i) {
        const int e = tid + i * 256, nn = e >> 6, kk = e & 63, n = n0 + nn;
        if (n < N) dst[(size_t)(dst_row0 + (nn >> 5) * blkstride + (nn & 31)) * lddst + k0 + kk] = f2bf(tl[kk][nn]);
    }
    __syncthreads();
}
constexpr int TR0 = 4 * 32 * 81, TR1 = 4 * 32 * 32, TR2 = 4 * 16 * 32 * 8, TR3 = TR2, TR4 = 4 * 16 * 8 * 32, TR5 = 4 * 32 * 2, TR6 = TR5, TR7 = 4 * 2, TR8 = TR7;
constexpr int N_TR_ITEMS = TR0 + TR1 + TR2 + TR3 + TR4 + TR5 + TR6 + TR7 + TR8;
DI void phase_transpose_item(const P& p, int item, float* lds) {
    int i = item;
    if (i < TR0) { const int l = i / (32 * 81), r = i % (32 * 81), kt = r / 81, nt = r % 81;
        transpose_tile(p.in[9] + (size_t)l * 2048 * 5144, 5144, kt * 64, nt * 64, 5144, p.winT + (size_t)l * NPAD_IN * 2048, 2048, nt * 64, 32, nullptr, lds); return; }
    i -= TR0;
    if (i < TR1) { const int l = i / 1024, r = i % 1024, kt = r / 32, nt = r % 32;
        transpose_tile(p.in[18] + (size_t)l * 2048 * 2048, 2048, kt * 64, nt * 64, 2048, p.woutT + (size_t)l * 2048 * 2048, 2048, nt * 64, 32, p.in[17] + (size_t)l * 2048, lds); return; }
    i -= TR1;
    if (i < TR2 + TR3) { const int up = i >= TR2; if (up) i -= TR2; const int le = i / 256, r = i % 256, kt = r / 8, nt = r % 8;
        transpose_tile(p.in[up ? 20 : 19] + (size_t)le * 2048 * 512, 512, kt * 64, nt * 64, 512, p.wguT + (size_t)le * 1024 * 2048, 2048, nt * 128 + (up ? 32 : 0), 64, nullptr, lds); return; }
    i -= TR2 + TR3;
    if (i < TR4) { const int le = i / 256, r = i % 256, kt = r / 32, nt = r % 32;
        transpose_tile(p.in[21] + (size_t)le * 512 * 2048, 2048, kt * 64, nt * 64, 2048, p.wdT + (size_t)le * 2048 * 512, 512, nt * 64, 32, nullptr, lds); return; }
    i -= TR4;
    if (i < TR5 + TR6) { const int v = i >= TR5; if (v) i -= TR5; const int l = i / 64, r = i % 64, kt = r / 2, nt = r % 2;
        transpose_tile(p.in[v ? 14 : 12] + (size_t)l * 2048 * 128, 128, kt * 64, nt * 64, 128, p.cw1T + (size_t)(l * 2 + v) * 128 * 2048, 2048, nt * 64, 32, nullptr, lds); return; }
    i -= TR5 + TR6;
    { const int v = i >= TR7; if (v) i -= TR7; const int l = i / 2, kt = i % 2;
        transpose_tile(p.in[v ? 15 : 13] + (size_t)l * 128 * 64, 64, kt * 64, 0, 64, p.cw2T + (size_t)(l * 2 + v) * 64 * 128, 128, 0, 32, nullptr, lds); }
}

DI void norm_mod_row(const P& p, int l, int row, int which, float (&hv)[32]) {
    const int lane = tidx() & 63, b = row / S;
    const float* x = ((l == 0 && which == 0) ? p.in[0] : p.xres) + (size_t)row * D;
    float ss = 0.f;
#pragma unroll
    for (int i = 0; i < 8; ++i) {
        const float4 v = *(const float4*)(x + i * 256 + lane * 4);
        hv[i * 4 + 0] = v.x; hv[i * 4 + 1] = v.y; hv[i * 4 + 2] = v.z; hv[i * 4 + 3] = v.w;
        ss += v.x * v.x + v.y * v.y + v.z * v.z + v.w * v.w;
    }
    ss = wave_sum(ss);
    const float r = rsqrtf(ss * (1.f / D) + EPS);
    const float* g = p.in[which ? 6 : 5] + (size_t)l * D;
    const float* sh = p.mod + ((size_t)l * 4 + b) * 12288 + (which ? 3 * D : 0);
    const float* sc = sh + D;
    bf16_t* h = p.hbuf + (size_t)row * D;
#pragma unroll
    for (int i = 0; i < 8; ++i) {
        const int col = i * 256 + lane * 4;
        const float4 gv = *(const float4*)(g + col), shv = *(const float4*)(sh + col), scv = *(const float4*)(sc + col);
        hv[i * 4 + 0] = hv[i * 4 + 0] * r * gv.x * (1.f + scv.x) + shv.x;
        hv[i * 4 + 1] = hv[i * 4 + 1] * r * gv.y * (1.f + scv.y) + shv.y;
        hv[i * 4 + 2] = hv[i * 4 + 2] * r * gv.z * (1.f + scv.z) + shv.z;
        hv[i * 4 + 3] = hv[i * 4 + 3] * r * gv.w * (1.f + scv.w) + shv.w;
        uint2 pk;
        pk.x = (unsigned)f2bf(hv[i * 4 + 0]) | ((unsigned)f2bf(hv[i * 4 + 1]) << 16);
        pk.y = (unsigned)f2bf(hv[i * 4 + 2]) | ((unsigned)f2bf(hv[i * 4 + 3]) << 16);
        *(uint2*)(h + col) = pk;
    }
}
DI void phase_norm1_wave(const P& p, int l, int row) { float hv[32]; norm_mod_row(p, l, row, 0, hv); }

DI void phase_norm2_router_wave(const P& p, int l, int row, float* hrow  ) {
    float hv[32];
    norm_mod_row(p, l, row, 1, hv);
    const int lane = tidx() & 63;
    const float* rw = p.in[3];
    wave_lds_sync();
#pragma unroll
    for (int i = 0; i < 8; ++i) { float4 v; v.x = hv[i * 4]; v.y = hv[i * 4 + 1]; v.z = hv[i * 4 + 2]; v.w = hv[i * 4 + 3]; *(float4*)(hrow + i * 256 + lane * 4) = v; }
    wave_lds_sync();
    float lg[16];
    {
        const int e = lane & 15, part = lane >> 4;
        float a0 = 0.f, a1 = 0.f, a2 = 0.f, a3 = 0.f;
        const float* wp = rw + (size_t)part * 512 * 16 + e;
        const float* hp = hrow + part * 512;
#pragma unroll 2
        for (int c = 0; c < 512; c += 4) {
            a0 += hp[c] * wp[(c + 0) * 16]; a1 += hp[c + 1] * wp[(c + 1) * 16]; a2 += hp[c + 2] * wp[(c + 2) * 16]; a3 += hp[c + 3] * wp[(c + 3) * 16];
        }
        float acc = (a0 + a1) + (a2 + a3);
        acc += __shfl_xor(acc, 16); acc += __shfl_xor(acc, 32);
#pragma unroll
        for (int k = 0; k < 16; ++k) lg[k] = __shfl(acc, k);
    }
    if (lane == 0) {
        float aff[16], sc[16];
#pragma unroll
        for (int e = 0; e < 16; ++e) { aff[e] = sigmoidf_(lg[e]); sc[e] = aff[e] + p.in[4][e]; }
        int bg = 0; float bgs = -3e38f;
#pragma unroll
        for (int g = 0; g < 4; ++g) {
            float m1 = -3e38f, m2 = -3e38f;
#pragma unroll
            for (int j = 0; j < 4; ++j) { const float v = sc[g * 4 + j]; if (v > m1) { m2 = m1; m1 = v; } else if (v > m2) m2 = v; }
            const float gs = m1 + m2;
            if (gs > bgs) { bgs = gs; bg = g; }
        }
        float s4[4], a4[4];
#pragma unroll
        for (int g = 0; g < 4; ++g)
#pragma unroll
            for (int j = 0; j < 4; ++j) if (g == bg) { s4[j] = sc[g * 4 + j]; a4[j] = aff[g * 4 + j]; }
        int i1 = 0; float b1 = s4[0];
#pragma unroll
        for (int j = 1; j < 4; ++j) if (s4[j] > b1) { b1 = s4[j]; i1 = j; }
        int i2 = -1; float b2 = -3e38f;
#pragma unroll
        for (int j = 0; j < 4; ++j) if (j != i1 && s4[j] > b2) { b2 = s4[j]; i2 = j; }
        float w1 = 0.f, w2 = 0.f;
#pragma unroll
        for (int j = 0; j < 4; ++j) { if (j == i1) w1 = a4[j]; if (j == i2) w2 = a4[j]; }
        const float inv = 1.f / (w1 + w2);
        w1 *= inv; w2 *= inv;
        const int a = i1 < i2 ? i1 : i2, bb = i1 < i2 ? i2 : i1;
        const float wa = i1 < i2 ? w1 : w2, wb = i1 < i2 ? w2 : w1;
        const int pidx = (a == 0) ? (bb - 1) : (a == 1 ? (bb + 1) : 5);
        const int cls = bg * 6 + pidx;
        const unsigned pos = atomicAdd(p.ctl + CTL_CNT + l * 32 + cls, 1u);
        p.cls_tok[(size_t)cls * CLS_CAP + pos] = row;
        p.tokw[(size_t)row * 2 + 0] = wa; p.tokw[(size_t)row * 2 + 1] = wb;
    }
}

template <class AF, class BF, class EF>
DI void gemm_naive_tile(int K, AF af, BF bfn, EF ef, float* lds) {
    float(*sA)[65] = (float(*)[65])lds;
    float(*sB)[65] = (float(*)[65])(lds + 32 * 65);
    const int tid = tidx(), tx = tid & 15, ty = tid >> 4;
    const int lr = tid >> 2, lk = (tid & 3) * 8;
    float acc[4][4];
#pragma unroll
    for (int i = 0; i < 4; ++i)
#pragma unroll
        for (int j = 0; j < 4; ++j) acc[i][j] = 0.f;
    const bf16_t* arow = af(lr);
    for (int k0 = 0; k0 < K; k0 += 32) {
        const uint4 av = *(const uint4*)(arow + k0 + lk);
        const uint4 bv = *(const uint4*)(bfn(lr, k0) + lk);
        const unsigned au[4] = {av.x, av.y, av.z, av.w}, bu[4] = {bv.x, bv.y, bv.z, bv.w};
#pragma unroll
        for (int j = 0; j < 4; ++j) {
            sA[lk + 2 * j][lr] = __uint_as_float(au[j] << 16); sA[lk + 2 * j + 1][lr] = __uint_as_float(au[j] & 0xffff0000u);
            sB[lk + 2 * j][lr] = __uint_as_float(bu[j] << 16); sB[lk + 2 * j + 1][lr] = __uint_as_float(bu[j] & 0xffff0000u);
        }
        __syncthreads();
#pragma unroll 8
        for (int kk = 0; kk < 32; ++kk) {
            float a[4], b[4];
#pragma unroll
            for (int i = 0; i < 4; ++i) { a[i] = sA[kk][ty * 4 + i]; b[i] = sB[kk][tx + 16 * i]; }
#pragma unroll
            for (int i = 0; i < 4; ++i)
#pragma unroll
                for (int j = 0; j < 4; ++j) acc[i][j] += a[i] * b[j];
        }
        __syncthreads();
    }
    ef(acc, ty * 4, tx);
}

constexpr int N_GIN_TILES = (T / 64) * 81;
DI void phase_gemm_in_item(const P& p, int l, int item, float* lds) {
    const int tm = item / 81, tn = item % 81;
    const bf16_t* A = p.hbuf + (size_t)tm * 64 * D;
    const bf16_t* B = p.winT + ((size_t)l * NPAD_IN + tn * 64) * 2048;
    bf16_t* C = p.proj + (size_t)tm * 64 * LDP + tn * 64;
    const int nvalid = (tn == 80) ? (LDP - 80 * 64) : 64;
    gemm_naive_tile(2048,
        [&](int r) { return A + (size_t)r * D; },
        [&](int c, int k0) { return B + (size_t)c * 2048 + k0; },
        [&](float (&acc)[4][4], int r0, int c0) {
#pragma unroll
            for (int i = 0; i < 4; ++i)
#pragma unroll
                for (int j = 0; j < 4; ++j) { const int c = c0 + 16 * j; if (c < nvalid) C[(size_t)(r0 + i) * LDP + c] = f2bf(acc[i][j]); }
        }, lds);
}
constexpr int N_GOUT_TILES = (T / 64) * 32;
DI void phase_gemm_out_item(const P& p, int l, int item, float* lds) {
    const int tm = item / 32, tn = item % 32;
    const bf16_t* A = p.hbuf + (size_t)tm * 64 * D;
    const bf16_t* B = p.woutT + ((size_t)l * 2048 + tn * 64) * 2048;
    const float* xs = (l == 0 ? p.in[0] : p.xres) + (size_t)tm * 64 * D + tn * 64;
    float* xd = p.xres + (size_t)tm * 64 * D + tn * 64;
    const int b = (tm * 64) / S;
    const float* g1 = p.mod + ((size_t)l * 4 + b) * 12288 + 2 * D + tn * 64;
    gemm_naive_tile(2048,
        [&](int r) { return A + (size_t)r * D; },
        [&](int c, int k0) { return B + (size_t)c * 2048 + k0; },
        [&](float (&acc)[4][4], int r0, int c0) {
#pragma unroll
            for (int i = 0; i < 4; ++i)
#pragma unroll
                for (int j = 0; j < 4; ++j) { const int c = c0 + 16 * j; xd[(size_t)(r0 + i) * D + c] = xs[(size_t)(r0 + i) * D + c] + g1[c] * acc[i][j]; }
        }, lds);
}

DI void cls_experts(int cls, int& ea, int& eb) {
    const int g = cls / 6, pi = cls % 6;
    const int a = pi < 3 ? 0 : (pi < 5 ? 1 : 2);
    const int b = pi < 3 ? pi + 1 : (pi < 5 ? pi - 1 : 3);
    ea = g * 4 + a; eb = g * 4 + b;
}
DI bool cls_find(unsigned* cnt, int ft, int& cls, int& mt, int& slot_base) {
    int base = 0;
    for (int c = 0; c < NCLS; ++c) {
        const int nt = ((int)__hip_atomic_load(cnt + c, __ATOMIC_RELAXED, __HIP_MEMORY_SCOPE_AGENT) + 127) >> 7;
        if (ft < base + nt) { cls = c; mt = ft - base; slot_base = base * 128; return true; }
        base += nt;
    }
    return false;
}
DI int cls_total_tiles(unsigned* cnt) { int base = 0; for (int c = 0; c < NCLS; ++c) base += ((int)__hip_atomic_load(cnt + c, __ATOMIC_RELAXED, __HIP_MEMORY_SCOPE_AGENT) + 127) >> 7; return base; }

DI void phase_moe1(const P& p, int l, int bid, int nblk, float* lds) {
    unsigned* cnt = p.ctl + CTL_CNT + l * 32;
    const int ntiles = cls_total_tiles(cnt);
    for (int item = bid; item < ntiles * 2 * 32; item += nblk) {
        const int ft = item / 64, r = item % 64, half = r / 32, tn = r % 32;
        int cls, mt, sb; cls_find(cnt, ft, cls, mt, sb);
        int ea, eb; cls_experts(cls, ea, eb);
        const int n = (int)__hip_atomic_load(cnt + cls, __ATOMIC_RELAXED, __HIP_MEMORY_SCOPE_AGENT);
        const int row0 = mt * 128 + half * 64;
        const int* toks = p.cls_tok + (size_t)cls * CLS_CAP;
        const int which = tn >= 16;
        const int e = which ? eb : ea;
        const bf16_t* B = p.wguT + (((size_t)l * 16 + e) * 1024 + (tn & 15) * 64) * 2048;
        bf16_t* Hd = p.hid + (size_t)(sb + row0) * 1024 + tn * 32;
        gemm_naive_tile(2048,
            [&](int rr) { const int ri = row0 + rr; const int tok = ri < n ? toks[ri] : toks[0]; return p.hbuf + (size_t)tok * D; },
            [&](int c, int k0) { return B + (size_t)c * 2048 + k0; },
            [&](float (&acc)[4][4], int r0, int c0) {
#pragma unroll
                for (int i = 0; i < 4; ++i) {
                    const int ri = row0 + r0 + i;
                    if (ri < n) {
                        const float w = p.tokw[(size_t)toks[ri] * 2 + which];
                        Hd[(size_t)(r0 + i) * 1024 + c0] = f2bf(siluf_(acc[i][0]) * acc[i][2] * w);
                        Hd[(size_t)(r0 + i) * 1024 + c0 + 16] = f2bf(siluf_(acc[i][1]) * acc[i][3] * w);
                    }
                }
            }, lds);
    }
}
DI void phase_moe2(const P& p, int l, int bid, int nblk, float* lds) {
    unsigned* cnt = p.ctl + CTL_CNT + l * 32;
    const int ntiles = cls_total_tiles(cnt);
    for (int item = bid; item < ntiles * 2 * 32; item += nblk) {
        const int ft = item / 64, r = item % 64, half = r / 32, tn = r % 32;
        int cls, mt, sb; cls_find(cnt, ft, cls, mt, sb);
        int ea, eb; cls_experts(cls, ea, eb);
        const int n = (int)__hip_atomic_load(cnt + cls, __ATOMIC_RELAXED, __HIP_MEMORY_SCOPE_AGENT);
        const int row0 = mt * 128 + half * 64;
        const int* toks = p.cls_tok + (size_t)cls * CLS_CAP;
        const bf16_t* A = p.hid + (size_t)(sb + row0) * 1024;
        const bf16_t* Ba = p.wdT + (((size_t)l * 16 + ea) * 2048 + tn * 64) * 512;
        const bf16_t* Bb = p.wdT + (((size_t)l * 16 + eb) * 2048 + tn * 64) * 512;
        gemm_naive_tile(1024,
            [&](int rr) { return A + (size_t)rr * 1024; },
            [&](int c, int k0) { return k0 < 512 ? (Ba + (size_t)c * 512 + k0) : (Bb + (size_t)c * 512 + (k0 - 512)); },
            [&](float (&acc)[4][4], int r0, int c0) {
#pragma unroll
                for (int i = 0; i < 4; ++i) {
                    const int ri = row0 + r0 + i;
                    if (ri < n) {
                        const int tok = toks[ri];
                        const int b = tok / S;
                        const float* g2 = p.mod + ((size_t)l * 4 + b) * 12288 + 5 * D + tn * 64;
                        float* xr = p.xres + (size_t)tok * D + tn * 64;
#pragma unroll
                        for (int j = 0; j < 4; ++j) { const int c = c0 + 16 * j; xr[c] += g2[c] * acc[i][j]; }
                    }
                }
            }, lds);
    }
}

constexpr int N_KMEAN_ITEMS = 4 * 8 * 16;
DI void phase_kmean_item(const P& p, int item, float* lds) {
    const int b = item / 128, h = (item / 16) % 8, blk = item % 16, tid = tidx(), d = tid & 63, part = tid >> 6;
    const bf16_t* k = p.proj + ((size_t)b * S + blk * 256 + part * 64) * LDP + OFF_KC + h * 64 + d;
    float s = 0.f;
    for (int i = 0; i < 64; ++i) s += bf2f(k[(size_t)i * LDP]);
    lds[tid] = s;
    __syncthreads();
    if (tid < 64) p.kmean[(size_t)item * 64 + tid] = (lds[tid] + lds[tid + 64] + lds[tid + 128] + lds[tid + 192]) * (1.f / 256.f);
    __syncthreads();
}
constexpr int N_CMP_ITEMS = 2 * 4 * 2 * 255;
DI void phase_cmp_item(const P& p, int l, int item, float* lds) {
    const int v = item / (4 * 2 * 255), r = item % (4 * 2 * 255), b = r / 510, hk = (r / 255) % 2, n = r % 255, tid = tidx();
    float* in = lds;
    float* part = lds + 2048;
    float* hd = lds + 2304;
    const float* pe = p.in[v ? 11 : 10] + (size_t)l * 2048;
    const bf16_t* src = p.proj + ((size_t)b * S + 16 * n) * LDP + (v ? OFF_VDC : OFF_KDC) + hk * 64;
    for (int i = tid; i < 2048; i += 256) in[i] = bf2f(src[(size_t)(i >> 6) * LDP + (i & 63)]) + pe[i];
    __syncthreads();
    const float* w1 = p.in[v ? 14 : 12] + (size_t)l * 2048 * 128;
    { const int j = tid & 127, half = tid >> 7; float s = 0.f;
      for (int i = half * 1024; i < half * 1024 + 1024; ++i) s += in[i] * w1[(size_t)i * 128 + j];
      part[tid] = s; }
    __syncthreads();
    if (tid < 128) hd[tid] = gelu_tanh(part[tid] + part[tid + 128]);
    __syncthreads();
    const float* w2 = p.in[v ? 15 : 13] + (size_t)l * 128 * 64;
    { const int d = tid & 63, q = tid >> 6; float s = 0.f;
      for (int j = q * 32; j < q * 32 + 32; ++j) s += hd[j] * w2[j * 64 + d];
      part[tid] = s; }
    __syncthreads();
    if (tid < 64) (v ? p.vc : p.kc)[(((size_t)b * 2 + hk) * 256 + n) * 64 + tid] = f2bf(part[tid] + part[tid + 64] + part[tid + 128] + part[tid + 192]);
    __syncthreads();
}


template <class C>
DI float attn_wave(const bf16_t* qrow, const C& cand, int ncand, bool has_sink, float sink, float* sl, float& lse_out) {
    const int lane = tidx() & 63;
    float q[64];
#pragma unroll
    for (int i = 0; i < 8; ++i) {
        const uint4 v = *(const uint4*)(qrow + i * 8);
        const unsigned u[4] = {v.x, v.y, v.z, v.w};
#pragma unroll
        for (int j = 0; j < 4; ++j) { q[i * 8 + 2 * j] = __uint_as_float(u[j] << 16); q[i * 8 + 2 * j + 1] = __uint_as_float(u[j] & 0xffff0000u); }
    }
    float mx = NEGF;
    for (int c0 = 0; c0 < ncand; c0 += 64) {
        const int c = c0 + lane;
        float s = NEGF;
        if (c < ncand) {
            const bf16_t *kr, *vr; float bias;
            if (cand.get(c, kr, vr, bias)) {
                float dot = 0.f;
#pragma unroll
                for (int i = 0; i < 8; ++i) {
                    const uint4 v = *(const uint4*)(kr + i * 8);
                    const unsigned u[4] = {v.x, v.y, v.z, v.w};
#pragma unroll
                    for (int j = 0; j < 4; ++j) { dot += q[i * 8 + 2 * j] * __uint_as_float(u[j] << 16); dot += q[i * 8 + 2 * j + 1] * __uint_as_float(u[j] & 0xffff0000u); }
                }
                s = dot * 0.125f + bias;
            }
            sl[c] = s;
        }
        mx = fmaxf(mx, s);
    }
    mx = wave_max(mx);
    if (has_sink) mx = fmaxf(mx, sink);
    float sum = 0.f;
    for (int c0 = 0; c0 < ncand; c0 += 64) {
        const int c = c0 + lane;
        if (c < ncand) { const float s = sl[c]; const float e = (s > -1e29f) ? __expf(s - mx) : 0.f; sl[c] = e; sum += e; }
    }
    sum = wave_sum(sum);
    if (has_sink) sum += __expf(sink - mx);
    sum = fmaxf(sum, 1.17549435e-38f);
    lse_out = mx + logf(sum);
    const float inv = 1.f / sum;
    for (int c0 = 0; c0 < ncand; c0 += 64) { const int c = c0 + lane; if (c < ncand) sl[c] *= inv; }
    wave_lds_sync();
    float o = 0.f;
    for (int c = 0; c < ncand; ++c) {
        const float pr = sl[c];
        if (pr != 0.f) { const bf16_t *kr, *vr; float bias; cand.get(c, kr, vr, bias); o += pr * bf2f(vr[lane]); }
    }
    return o;
}

struct BandCand {
    const bf16_t *kb, *vb; int t, r; const float* tab;
    DI bool get(int c, const bf16_t*& kr, const bf16_t*& vr, float& bias) const {
        const int kp = t - c * r; if (kp < 0) return false;
        kr = kb + (size_t)kp * LDP; vr = vb + (size_t)kp * LDP; bias = tab[t5_bucket(c * r) * 32]; return true;
    }
};
struct MobaCand {
    const bf16_t *kb, *vb; int t; const int* sel; const float* tab;
    DI bool get(int c, const bf16_t*& kr, const bf16_t*& vr, float& bias) const {
        const int blk = sel[c >> 8], j = c & 255;
        if (blk < 0) return false;
        const int kp = blk * 256 + j; if (kp > t) return false;
        kr = kb + (size_t)kp * LDP; vr = vb + (size_t)kp * LDP; bias = tab[t5_bucket(t - kp) * 32]; return true;
    }
};
struct CmpCand {
    const bf16_t *kc, *vc; int t;
    DI bool get(int c, const bf16_t*& kr, const bf16_t*& vr, float& bias) const {
        if (16 * c + 31 > t) return false;
        kr = kc + (size_t)c * 64; vr = vc + (size_t)c * 64; bias = 0.f; return true;
    }
};
struct SlcCand {
    const bf16_t *kb, *vb; int t; const int* sel; const float* tab;
    DI bool get(int c, const bf16_t*& kr, const bf16_t*& vr, float& bias) const {
        const int blk = sel[c >> 6]; if (blk < 0) return false;
        const int kp = blk * 64 + (c & 63); if (kp > t) return false;
        kr = kb + (size_t)kp * LDP; vr = vb + (size_t)kp * LDP; bias = tab[t5_bucket(t - kp) * 32]; return true;
    }
};

constexpr int N_ATT_WAVE_ITEMS = 3 * T * 8 + T * 8 + T * 8;
DI void phase_attn_wave_item(const P& p, int l, int item, float* sl) {
    const int lane = tidx() & 63;
    const float* relb = p.in[2];
    if (item < 3 * T * 8) {
        const int cfg = item / (T * 8), rem = item % (T * 8), row = rem >> 3, h = rem & 7, b = row / S, t = row % S;
        const int r = cfg == 0 ? 1 : (cfg == 1 ? 4 : 16);
        BandCand cd{p.proj + (size_t)b * S * LDP + OFF_KA + h * 64, p.proj + (size_t)b * S * LDP + OFF_VA + h * 64, t, r, relb + 0 + h};
        float lse;
        const float o = attn_wave(p.proj + (size_t)row * LDP + OFF_QA + h * 64, cd, 129, false, 0.f, sl, lse);
        p.oA[((size_t)cfg * T + row) * 512 + h * 64 + lane] = f2bf(o);
        if (lane == 0) p.lseA[((size_t)cfg * T + row) * 8 + h] = lse;
        return;
    }
    item -= 3 * T * 8;
    if (item < T * 8) {
        const int row = item >> 3, hq = item & 7, kvh = hq >> 2, b = row / S, t = row % S;
        BandCand cd{p.proj + (size_t)b * S * LDP + OFF_KB + kvh * 64, p.proj + (size_t)b * S * LDP + OFF_VB + kvh * 64, t, 1, relb + 8 + hq};
        float lse;
        const float o = attn_wave(p.proj + (size_t)row * LDP + OFF_QB + hq * 64, cd, 128, true, p.in[16][l * 8 + hq], sl, lse);
        p.oB[(size_t)row * 512 + hq * 64 + lane] = f2bf(o);
        return;
    }
    item -= T * 8;
    {
        const int row = item >> 3, h = item & 7, b = row / S, t = row % S, cur = t >> 8;
        const bf16_t* qrow = p.proj + (size_t)row * LDP + OFF_QC + h * 64;
        float gate = NEGF;
        if (lane < cur) {
            const float* km = p.kmean + (((size_t)b * 8 + h) * 16 + lane) * 64;
            float dot = 0.f;
            for (int d = 0; d < 64; ++d) dot += bf2f(qrow[d]) * km[d];
            gate = dot;
        }
        int s0, s1, s2;
        { float v = gate; int idx = lane;
          for (int o = 32; o > 0; o >>= 1) { const float ov = __shfl_xor(v, o); const int oi = __shfl_xor(idx, o); if (ov > v || (ov == v && oi < idx)) { v = ov; idx = oi; } }
          s0 = (v > -1e29f) ? idx : -1; if (lane == idx) gate = -3e38f; }
        { float v = gate; int idx = lane;
          for (int o = 32; o > 0; o >>= 1) { const float ov = __shfl_xor(v, o); const int oi = __shfl_xor(idx, o); if (ov > v || (ov == v && oi < idx)) { v = ov; idx = oi; } }
          s1 = (v > -1e29f) ? idx : -1; if (lane == idx) gate = -3e38f; }
        { float v = gate; int idx = lane;
          for (int o = 32; o > 0; o >>= 1) { const float ov = __shfl_xor(v, o); const int oi = __shfl_xor(idx, o); if (ov > v || (ov == v && oi < idx)) { v = ov; idx = oi; } }
          s2 = (v > -1e29f) ? idx : -1; if (lane == idx) gate = -3e38f; }
        int* selw = (int*)(sl + 1024 * (4 - (int)(tidx() >> 6))) + 16 + 4 * (tidx() >> 6);
        if (lane == 0) { selw[0] = s0; selw[1] = s1; selw[2] = s2; selw[3] = cur; }
        wave_lds_sync();
        MobaCand cd{p.proj + (size_t)b * S * LDP + OFF_KC + h * 64, p.proj + (size_t)b * S * LDP + OFF_VC + h * 64, t, selw, relb + 16 + h};
        float lse;
        const float o = attn_wave(qrow, cd, 1024, false, 0.f, sl, lse);
        p.oC[(size_t)row * 512 + h * 64 + lane] = f2bf(o);
    }
}
constexpr int N_NSA_ITEMS = 4 * 2 * S;
DI void phase_nsa_item(const P& p, int l, int item, float* lds) {
    const int b = item / (2 * S), hk = (item / S) % 2, t = item % S, tid = tidx(), g = tid >> 6, lane = tid & 63, hq = hk * 4 + g;
    const int row = b * S + t, cur = t >> 6;
    float* sl = lds + g * 1024;
    int* sel = (int*)(lds + 4096);
    const bf16_t* qrow = p.proj + (size_t)row * LDP + OFF_QD + hq * 64;
    const float* relb = p.in[2];
    float lse;
    CmpCand cc{p.kc + ((size_t)b * 2 + hk) * 256 * 64, p.vc + ((size_t)b * 2 + hk) * 256 * 64, t};
    const float o_cmp = attn_wave(qrow, cc, 255, false, 0.f, sl, lse);
    __syncthreads();
    if (g == 0) {
        const int j = lane;
        float imp = 0.f;
        for (int n = 4 * j - 1; n <= 4 * j + 3; ++n)
            if (n >= 0 && n < 255) imp += lds[n] + lds[1024 + n] + lds[2048 + n] + lds[3072 + n];
        float val = (j == 0 || j == cur || j == cur - 1) ? 1e30f : (j <= cur ? imp : NEGF);
        for (int k = 0; k < 16; ++k) {
            float v = val; int idx = lane;
            for (int o = 32; o > 0; o >>= 1) { const float ov = __shfl_xor(v, o); const int oi = __shfl_xor(idx, o); if (ov > v || (ov == v && oi < idx)) { v = ov; idx = oi; } }
            if (lane == 0) sel[k] = (v > -1e29f) ? idx : -1;
            if (lane == idx) val = -3e38f;
        }
    }
    __syncthreads();
    SlcCand sc{p.proj + (size_t)b * S * LDP + OFF_KDS + hk * 64, p.proj + (size_t)b * S * LDP + OFF_VDS + hk * 64, t, sel, relb + 24 + hq};
    const float o_slc = attn_wave(qrow, sc, 1024, false, 0.f, sl, lse);
    BandCand wc{p.proj + (size_t)b * S * LDP + OFF_KDW + hk * 64, p.proj + (size_t)b * S * LDP + OFF_VDW + hk * 64, t, 1, relb + 24 + hq};
    const float o_win = attn_wave(qrow, wc, 512, false, 0.f, sl, lse);
    const bf16_t* gd = p.proj + (size_t)row * LDP + OFF_GD + hq * 3;
    const float g0 = sigmoidf_(bf2f(gd[0])), g1 = sigmoidf_(bf2f(gd[1])), g2 = sigmoidf_(bf2f(gd[2]));
    p.oD[(size_t)row * 512 + hq * 64 + lane] = f2bf(g0 * o_cmp + g1 * o_slc + g2 * o_win);
    __syncthreads();
}

constexpr int N_MIXN_WAVE_ITEMS = T * 4;
DI void phase_mixnorm_wave(const P& p, int item) {
    const int row = item >> 2, grp = item & 3, lane = tidx() & 63, h = lane >> 3;
    float v[8];
    if (grp == 0) {
        const float l0 = p.lseA[((size_t)0 * T + row) * 8 + h], l1 = p.lseA[((size_t)1 * T + row) * 8 + h], l2 = p.lseA[((size_t)2 * T + row) * 8 + h];
        const float m = fmaxf(l0, fmaxf(l1, l2));
        float w0 = __expf(l0 - m), w1 = __expf(l1 - m), w2 = __expf(l2 - m);
        const float inv = 1.f / (w0 + w1 + w2); w0 *= inv; w1 *= inv; w2 *= inv;
        const uint4 a = *(const uint4*)(p.oA + ((size_t)0 * T + row) * 512 + lane * 8);
        const uint4 bq = *(const uint4*)(p.oA + ((size_t)1 * T + row) * 512 + lane * 8);
        const uint4 c = *(const uint4*)(p.oA + ((size_t)2 * T + row) * 512 + lane * 8);
        const unsigned au[4] = {a.x, a.y, a.z, a.w}, bu[4] = {bq.x, bq.y, bq.z, bq.w}, cu[4] = {c.x, c.y, c.z, c.w};
#pragma unroll
        for (int j = 0; j < 4; ++j) {
            v[2 * j] = w0 * __uint_as_float(au[j] << 16) + w1 * __uint_as_float(bu[j] << 16) + w2 * __uint_as_float(cu[j] << 16);
            v[2 * j + 1] = w0 * __uint_as_float(au[j] & 0xffff0000u) + w1 * __uint_as_float(bu[j] & 0xffff0000u) + w2 * __uint_as_float(cu[j] & 0xffff0000u);
        }
    } else {
        const bf16_t* src = (grp == 1 ? p.oB : (grp == 2 ? p.oC : p.oD)) + (size_t)row * 512 + lane * 8;
        const uint4 a = *(const uint4*)src;
        const unsigned au[4] = {a.x, a.y, a.z, a.w};
#pragma unroll
        for (int j = 0; j < 4; ++j) { v[2 * j] = __uint_as_float(au[j] << 16); v[2 * j + 1] = __uint_as_float(au[j] & 0xffff0000u); }
    }
    float ss = 0.f;
#pragma unroll
    for (int j = 0; j < 8; ++j) ss += v[j] * v[j];
    ss = wave_sum(ss);
    const float r = rsqrtf(ss * (1.f / 512.f) + EPS);
    uint4 o;
    o.x = (unsigned)f2bf(v[0] * r) | ((unsigned)f2bf(v[1] * r) << 16);
    o.y = (unsigned)f2bf(v[2] * r) | ((unsigned)f2bf(v[3] * r) << 16);
    o.z = (unsigned)f2bf(v[4] * r) | ((unsigned)f2bf(v[5] * r) << 16);
    o.w = (unsigned)f2bf(v[6] * r) | ((unsigned)f2bf(v[7] * r) << 16);
    *(uint4*)(p.hbuf + (size_t)row * D + grp * 512 + lane * 8) = o;
}

DI void phase_final_wave(const P& p, int row, bool poison) {
    const int lane = tidx() & 63;
    const float* x = p.xres + (size_t)row * D;
    float4 v[8]; float ss = 0.f;
#pragma unroll
    for (int i = 0; i < 8; ++i) { v[i] = *(const float4*)(x + i * 256 + lane * 4); ss += v[i].x * v[i].x + v[i].y * v[i].y + v[i].z * v[i].z + v[i].w * v[i].w; }
    ss = wave_sum(ss);
    const float r = rsqrtf(ss * (1.f / D) + EPS);
#pragma unroll
    for (int i = 0; i < 8; ++i) {
        const float4 g = *(const float4*)(p.in[22] + i * 256 + lane * 4);
        float4 o; o.x = v[i].x * r * g.x; o.y = v[i].y * r * g.y; o.z = v[i].z * r * g.z; o.w = v[i].w * r * g.w;
        if (poison) { o.x = o.y = o.z = o.w = __uint_as_float(0x7fc00000u); }
        *(float4*)(p.out + (size_t)row * D + i * 256 + lane * 4) = o;
    }
}

#define XB_TMO      128
#define XB_XCNT(j)  (256  + 64 * (j))
#define XB_XSUB(j)  (1280 + 64 * (j))
#define XB_XGEN(j)  (2304 + 64 * (j))
#define XB_TOP      3328
#define XB_TOPGEN   3392
#define XCD_BAR_WORDS 3456
#define XB_SPIN_CAP (1u << 21)
#define LAS __attribute__((address_space(3)))

__device__ __forceinline__ unsigned xb_ld(unsigned* p)              { return __hip_atomic_load(p, __ATOMIC_RELAXED, __HIP_MEMORY_SCOPE_AGENT); }
__device__ __forceinline__ unsigned xb_add(unsigned* p, unsigned v) { return __hip_atomic_fetch_add(p, v, __ATOMIC_RELAXED, __HIP_MEMORY_SCOPE_AGENT); }
__device__ __forceinline__ unsigned xb_xcc_id() { return (unsigned)__builtin_amdgcn_s_getreg((3 << 11) | 20) & 0xFu; }
#define XB_SPIN(cond, bar) do { unsigned _sp = 0; while (cond) { __builtin_amdgcn_s_sleep(1); \
    if ((++_sp & 255u) == 0u) { if (xb_ld(&(bar)[XB_TMO])) break; if (_sp > XB_SPIN_CAP) { atomicAdd(&(bar)[XB_TMO], 1u); break; } } } } while (0)

struct XcdBarrier { unsigned* bar; unsigned x; volatile LAS unsigned* st; };

__device__ __forceinline__ XcdBarrier xcd_barrier_post(unsigned* bar, volatile LAS unsigned* st) {
    XcdBarrier b; b.bar = bar; b.x = xb_xcc_id(); b.st = st;
    if (threadIdx.x == 0) (void)xb_add(&bar[XB_XCNT(b.x)], 1u);
    return b;
}
__device__ __forceinline__ void xcd_barrier_complete(unsigned* bar, unsigned x, unsigned& nloc, unsigned& nx) {
    const unsigned G = gridDim.x * gridDim.y * gridDim.z;
    unsigned sum, cnt, mine, sp = 0u;
    for (;;) {
        sum = 0u; cnt = 0u; mine = 0u;
#pragma unroll
        for (unsigned j = 0; j < 16; ++j) { const unsigned c = xb_ld(&bar[XB_XCNT(j)]); sum += c; cnt += (c > 0u) ? 1u : 0u; mine = (j == x) ? c : mine; }
        if (sum == G) break;
        __builtin_amdgcn_s_sleep(1);
        if ((++sp & 255u) == 0u) { if (xb_ld(&bar[XB_TMO])) break; if (sp > XB_SPIN_CAP) { atomicAdd(&bar[XB_TMO], 1u); break; } }
    }
    nloc = mine > 0u ? mine : 1u; nx = cnt > 0u ? cnt : 1u;
}
__device__ __forceinline__ void xcd_barrier(const XcdBarrier& b) {
    asm volatile("s_waitcnt vmcnt(0)" ::: "memory");
    __syncthreads();
    if (threadIdx.x == 0) {
        unsigned* bar = b.bar;
        __builtin_amdgcn_s_waitcnt(0);
        unsigned nloc = b.st[0], nx = b.st[1];
        if (nloc == 0u) { xcd_barrier_complete(bar, b.x, nloc, nx); b.st[0] = nloc; b.st[1] = nx; }
        const unsigned old = xb_add(&bar[XB_XSUB(b.x)], 1u);
        const unsigned gen = old / nloc;
        if (old + 1u == (gen + 1u) * nloc) {
            __builtin_amdgcn_fence(__ATOMIC_RELEASE, "agent");
            asm volatile("s_waitcnt vmcnt(0)" ::: "memory");
            const unsigned og = xb_add(&bar[XB_TOP], 1u);
            const unsigned tg = og / nx;
            if (og + 1u == (tg + 1u) * nx) xb_add(&bar[XB_TOPGEN], 1u);
            else XB_SPIN(xb_ld(&bar[XB_TOPGEN]) == tg, bar);
            __builtin_amdgcn_fence(__ATOMIC_ACQUIRE, "agent");
            xb_add(&bar[XB_XGEN(b.x)], 1u);
            asm volatile("s_waitcnt vmcnt(0)" ::: "memory");
        } else {
            XB_SPIN(xb_ld(&bar[XB_XGEN(b.x)]) == gen, bar);
            __builtin_amdgcn_fence(__ATOMIC_ACQUIRE, "agent");
            asm volatile("s_waitcnt vmcnt(0)" ::: "memory");
        }
    }
    __syncthreads();
}

constexpr int LDS_FLOATS = 12288 + 64 + 128;
constexpr int LDS_MISC = 12288, LDS_TAB = 12288 + 64;
constexpr int NTHR = 256;
DI unsigned long long ld_tab(const float* lds, int i) {
    const unsigned lo = __builtin_amdgcn_readfirstlane(__float_as_uint(lds[LDS_TAB + 2 * i])), hi = __builtin_amdgcn_readfirstlane(__float_as_uint(lds[LDS_TAB + 2 * i + 1]));
    return ((unsigned long long)hi << 32) | lo;
}
DI P load_P(const float* lds) {
    asm volatile("" ::: "memory");
    P p;
#pragma unroll
    for (int i = 0; i < 23; ++i) p.in[i] = (const float*)ld_tab(lds, i);
    p.out = (float*)ld_tab(lds, 23);
    unsigned char* ws = (unsigned char*)ld_tab(lds, 24);
    p.ctl = (unsigned*)(ws + O_CTL); p.mod = (float*)(ws + O_MOD); p.xres = (float*)(ws + O_XRES); p.hbuf = (bf16_t*)(ws + O_HBUF); p.proj = (bf16_t*)(ws + O_PROJ);
    p.oA = (bf16_t*)(ws + O_OA); p.lseA = (float*)(ws + O_LSEA); p.oB = (bf16_t*)(ws + O_OB); p.oC = (bf16_t*)(ws + O_OC); p.oD = (bf16_t*)(ws + O_OD);
    p.kmean = (float*)(ws + O_KMEAN); p.kc = (bf16_t*)(ws + O_KC); p.vc = (bf16_t*)(ws + O_VC); p.cls_tok = (int*)(ws + O_CLSTOK); p.tokw = (float*)(ws + O_TOKW);
    p.hid = (bf16_t*)(ws + O_HID); p.winT = (bf16_t*)(ws + O_WINT); p.woutT = (bf16_t*)(ws + O_WOUTT); p.wguT = (bf16_t*)(ws + O_WGUT); p.wdT = (bf16_t*)(ws + O_WDT);
    p.cw1T = (bf16_t*)(ws + O_CW1T); p.cw2T = (bf16_t*)(ws + O_CW2T);
    return p;
}
__global__ void __launch_bounds__(NTHR, 2) mk_fwd(KArgs ka) {
    extern __shared__ __attribute__((aligned(16))) float lds[];
    const int w = threadIdx.x >> 6, bid = blockIdx.x, nb = gridDim.x;
    volatile LAS unsigned* xbw = (volatile LAS unsigned*)(lds + LDS_MISC + 60);
    if (threadIdx.x == 0) { xbw[0] = 0u; xbw[1] = 0u; xbw[2] = 0u; xbw[3] = 0u; }
    if (threadIdx.x < 25) {
        const unsigned long long v = (threadIdx.x < 23) ? (unsigned long long)ka.in[threadIdx.x < 23 ? threadIdx.x : 0] : (threadIdx.x == 23 ? (unsigned long long)ka.out : (unsigned long long)ka.ws);
        lds[LDS_TAB + 2 * threadIdx.x] = __uint_as_float((unsigned)v); lds[LDS_TAB + 2 * threadIdx.x + 1] = __uint_as_float((unsigned)(v >> 32));
    }
    __syncthreads();
    XcdBarrier bar = xcd_barrier_post((unsigned*)(ka.ws + O_CTL), xbw);

    { const P p = load_P(lds);
      for (int it = bid; it < N_MOD_ITEMS + N_TR_ITEMS; it += nb) { if (it < N_MOD_ITEMS) phase_mod_item(p, it, lds); else phase_transpose_item(p, it - N_MOD_ITEMS, lds); } }
    xcd_barrier(bar);
    for (int l = 0; l < DEPTH; ++l) {
        { const P p = load_P(lds); for (int it = bid * 4 + w; it < T; it += nb * 4) phase_norm1_wave(p, l, it); }
        xcd_barrier(bar);
        { const P p = load_P(lds); for (int it = bid; it < N_GIN_TILES; it += nb) phase_gemm_in_item(p, l, it, lds); }
        xcd_barrier(bar);
        { const P p = load_P(lds); for (int it = bid; it < N_KMEAN_ITEMS + N_CMP_ITEMS; it += nb) { if (it < N_KMEAN_ITEMS) phase_kmean_item(p, it, lds); else phase_cmp_item(p, l, it - N_KMEAN_ITEMS, lds); } }
        xcd_barrier(bar);
        { const P p = load_P(lds); for (int it = bid; it < N_NSA_ITEMS; it += nb) phase_nsa_item(p, l, it, lds); }
        { const P p = load_P(lds); for (int it = bid * 4 + w; it < N_ATT_WAVE_ITEMS; it += nb * 4) phase_attn_wave_item(p, l, it, lds + w * 1024); }
        xcd_barrier(bar);
        { const P p = load_P(lds); for (int it = bid * 4 + w; it < N_MIXN_WAVE_ITEMS; it += nb * 4) phase_mixnorm_wave(p, it); }
        xcd_barrier(bar);
        { const P p = load_P(lds); for (int it = bid; it < N_GOUT_TILES; it += nb) phase_gemm_out_item(p, l, it, lds); }
        xcd_barrier(bar);
        { const P p = load_P(lds); for (int it = bid * 4 + w; it < T; it += nb * 4) phase_norm2_router_wave(p, l, it, lds + w * 2048); }
        xcd_barrier(bar);
        { const P p = load_P(lds); phase_moe1(p, l, bid, nb, lds); }
        xcd_barrier(bar);
        { const P p = load_P(lds); phase_moe2(p, l, bid, nb, lds); }
        xcd_barrier(bar);
    }
    { const P p = load_P(lds);
      const bool tmo = xb_ld(p.ctl + XB_TMO) != 0u;
      for (int it = bid * 4 + w; it < T; it += nb * 4) phase_final_wave(p, it, tmo); }
}

extern "C" void kernel_launch(void* const* d_in, const int* in_sizes, int n_in, void* d_out, int out_size, void* d_ws, size_t ws_size, hipStream_t stream) {
    KArgs ka{};
    for (int i = 0; i < 23; ++i) ka.in[i] = (const float*)d_in[i];
    ka.out = (float*)d_out;
    ka.ws = (unsigned char*)d_ws;
    if (WS_NEED > ws_size) { fprintf(stderr, "workspace too small: need %zu have %zu\n", (size_t)WS_NEED, ws_size); return; }
    constexpr size_t LB = LDS_FLOATS * 4;
    constexpr int kBlocksPerCu = 2;
    static int grid = 0;
    if (!grid) {
        int dev = 0, cus = 0, per_cu = 0;
        (void)hipGetDevice(&dev);
        (void)hipDeviceGetAttribute(&cus, hipDeviceAttributeMultiprocessorCount, dev);
        (void)hipOccupancyMaxActiveBlocksPerMultiprocessor(&per_cu, mk_fwd, NTHR, LB);
        if (per_cu < 1) per_cu = 1;
        grid = cus * (per_cu < kBlocksPerCu ? per_cu : kBlocksPerCu);
    }
    (void)hipMemsetAsync(ka.ws + O_CTL, 0, 1 << 20, stream);
    mk_fwd<<<grid, NTHR, LB, stream>>>(ka);
}
```

```cpp
#include <hip/hip_runtime.h>
#include <stdint.h>
#include <stdio.h>

typedef unsigned short bf16_t;
#define DI __device__ __forceinline__

constexpr int D = 2048, NBATCH = 4, S = 4096, T = NBATCH * S, DEPTH = 4;
constexpr int NTHR = 512;
constexpr int LDP = 5144;
constexpr int NPAD_IN = 5120;
constexpr int OFF_QA = 0, OFF_KA = 512, OFF_VA = 1024, OFF_QB = 1536, OFF_KB = 2048, OFF_VB = 2176, OFF_QC = 2304, OFF_KC = 2816,
              OFF_VC = 3328, OFF_QD = 3840, OFF_KDC = 4352, OFF_VDC = 4480, OFF_KDS = 4608, OFF_VDS = 4736, OFF_KDW = 4864,
              OFF_VDW = 4992, OFF_GD = 5120;
constexpr int NCLS = 24, CLS_CAP = T, HID_ROWS = T + NCLS * 256;
constexpr float NEGF = -1e30f;
constexpr float EPS = 1e-6f;

struct P {
    const float* in[23];
    float* out;
    unsigned* ctl;
    float* mod;
    float* xres;
    bf16_t* hbuf;
    bf16_t* proj;
    bf16_t* oA;
    float* lseA;
    bf16_t* oB; bf16_t* oC; bf16_t* oD;
    float* kmean;
    bf16_t* kc; bf16_t* vc;
    int* cls_tok;
    float* tokw;
    bf16_t* hid;
    bf16_t* winT;
    bf16_t* woutT;
    bf16_t* wguT;
    bf16_t* wdT;
    bf16_t* cw1T;
    bf16_t* cw2T;
};
constexpr size_t al256(size_t x) { return (x + 255) & ~(size_t)255; }
constexpr size_t O_CTL = 0;
constexpr size_t O_MOD = O_CTL + al256((size_t)1 << 20);
constexpr size_t O_XRES = O_MOD + al256((size_t)4 * 4 * 12288 * 4);
constexpr size_t O_HBUF = O_XRES + al256((size_t)T * D * 4);
constexpr size_t O_PROJ = O_HBUF + al256((size_t)T * D * 2);
constexpr size_t O_OA = O_PROJ + al256((size_t)T * LDP * 2);
constexpr size_t O_LSEA = O_OA + al256((size_t)3 * T * 512 * 2);
constexpr size_t O_OB = O_LSEA + al256((size_t)3 * T * 8 * 4);
constexpr size_t O_OC = O_OB + al256((size_t)T * 512 * 2);
constexpr size_t O_OD = O_OC + al256((size_t)T * 512 * 2);
constexpr size_t O_KMEAN = O_OD + al256((size_t)T * 512 * 2);
constexpr size_t O_KC = O_KMEAN + al256((size_t)4 * 8 * 16 * 64 * 4);
constexpr size_t O_VC = O_KC + al256((size_t)4 * 2 * 256 * 64 * 2);
constexpr size_t O_CLSTOK = O_VC + al256((size_t)4 * 2 * 256 * 64 * 2);
constexpr size_t O_TOKW = O_CLSTOK + al256((size_t)NCLS * CLS_CAP * 4);
constexpr size_t O_HID = O_TOKW + al256((size_t)T * 2 * 4);
constexpr size_t O_WINT = O_HID + al256((size_t)HID_ROWS * 1024 * 2);
constexpr size_t O_WOUTT = O_WINT + al256((size_t)4 * NPAD_IN * 2048 * 2);
constexpr size_t O_WGUT = O_WOUTT + al256((size_t)4 * 2048 * 2048 * 2);
constexpr size_t O_WDT = O_WGUT + al256((size_t)4 * 16 * 1024 * 2048 * 2);
constexpr size_t O_CW1T = O_WDT + al256((size_t)4 * 16 * 2048 * 512 * 2);
constexpr size_t O_CW2T = O_CW1T + al256((size_t)4 * 2 * 128 * 2048 * 2);
constexpr size_t WS_NEED = O_CW2T + al256((size_t)4 * 2 * 64 * 128 * 2);
struct KArgs { const float* in[23]; float* out; unsigned char* ws; };
constexpr int CTL_CNT = 8192;

DI int tidx() { int t = threadIdx.x; asm volatile("" : "+v"(t)); return t; }
DI float bf2f(bf16_t v) { return __uint_as_float(((unsigned)v) << 16); }
DI bf16_t f2bf(float f) { unsigned u = __float_as_uint(f); u += 0x7fffu + ((u >> 16) & 1u); return (bf16_t)(u >> 16); }
DI float wave_sum(float v) { for (int o = 32; o > 0; o >>= 1) v += __shfl_xor(v, o); return v; }
DI float wave_max(float v) { for (int o = 32; o > 0; o >>= 1) v = fmaxf(v, __shfl_xor(v, o)); return v; }
DI void wave_lds_sync() { asm volatile("s_waitcnt lgkmcnt(0)" ::: "memory"); __builtin_amdgcn_wave_barrier(); }
DI float sigmoidf_(float x) { return 1.f / (1.f + __expf(-x)); }
DI float siluf_(float x) { return x / (1.f + __expf(-x)); }
DI float gelu_tanh(float x) { float u = 0.7978845608028654f * (x + 0.044715f * x * x * x); return 0.5f * x * (1.f + tanhf(u)); }
DI int t5_bucket(int d) {
    if (d < 16) return d < 0 ? 0 : d;
    return 16 + (d >= 22) + (d >= 30) + (d >= 40) + (d >= 54) + (d >= 73) + (d >= 99) + (d >= 134) + (d >= 182) + (d >= 246) + (d >= 332) +
           (d >= 450) + (d >= 609) + (d >= 825) + (d >= 1117) + (d >= 1513);
}

DI void phase_mod_item(const P& p, int item, float* lds) {
    const int l = item / 48, jb = item % 48, tid = tidx();
    float* cact = lds;
    float* red = lds + 8192;
    const float* c = p.in[1];
    for (int i = tid; i < 4 * 2048; i += NTHR) cact[i] = siluf_(c[i]);
    __syncthreads();
    const int kq = tid >> 6, lane = tid & 63;
    const float* w = p.in[7] + (size_t)l * 2048 * 12288 + jb * 256 + lane * 4;
    float acc[4][4];
#pragma unroll
    for (int b = 0; b < 4; ++b)
#pragma unroll
        for (int j = 0; j < 4; ++j) acc[b][j] = 0.f;
#pragma unroll 4
    for (int k = kq * 256; k < kq * 256 + 256; ++k) {
        const float4 wv = *(const float4*)(w + (size_t)k * 12288);
#pragma unroll
        for (int b = 0; b < 4; ++b) {
            const float cv = cact[b * 2048 + k];
            acc[b][0] += cv * wv.x; acc[b][1] += cv * wv.y; acc[b][2] += cv * wv.z; acc[b][3] += cv * wv.w;
        }
    }
#pragma unroll
    for (int b = 0; b < 4; ++b)
#pragma unroll
        for (int j = 0; j < 4; ++j) red[(kq * 4 + b) * 256 + lane * 4 + j] = acc[b][j];
    __syncthreads();
    for (int i = tid; i < 1024; i += NTHR) {
        const int b = i >> 8, col = i & 255;
        float v = 0.f;
#pragma unroll
        for (int q = 0; q < 8; ++q) v += red[(q * 4 + b) * 256 + col];
        p.mod[((size_t)l * 4 + b) * 12288 + jb * 256 + col] = v + p.in[8][(size_t)l * 12288 + jb * 256 + col];
    }
    __syncthreads();
}
constexpr int N_MOD_ITEMS = 4 * 48;

DI void transpose_tile(const float* src, int ld, int k0, int n0, int N, bf16_t* dst, int lddst, int dst_row0, int blkstride, const float* kscale, float* lds) {
    float(*tl)[65] = (float(*)[65])lds;
    const int tid = tidx();
#pragma unroll 4
    for (int i = 0; i < 8; ++i) {
        const int e = tid + i * NTHR, kk = e >> 6, nn = e & 63, n = n0 + nn;
        float v = (n < N) ? src[(size_t)(k0 + kk) * ld + n] : 0.f;
        if (kscale) v *= kscale[k0 + kk];
        tl[kk][nn] = v;
    }
    __syncthreads();
#pragma unroll 4
    for (int i = 0; i < 8; ++i) {
        const int e = tid + i * NTHR, nn = e >> 6, kk = e & 63, n = n0 + nn;
        if (n < N) dst[(size_t)(dst_row0 + (nn >> 5) * blkstride + (nn & 31)) * lddst + k0 + kk] = f2bf(tl[kk][nn]);
    }
    __syncthreads();
}
constexpr int TR0 = 4 * 32 * 80, TR1 = 4 * 32 * 32, TR2 = 4 * 16 * 32 * 8, TR3 = TR2, TR4 = 4 * 16 * 8 * 32, TR5 = 4 * 32 * 2, TR6 = TR5, TR7 = 4 * 2, TR8 = TR7;
constexpr int N_TR_ITEMS = TR0 + TR1 + TR2 + TR3 + TR4 + TR5 + TR6 + TR7 + TR8;
DI void phase_transpose_item(const P& p, int item, float* lds) {
    int i = item;
    if (i < TR0) { const int l = i / (32 * 80), r = i % (32 * 80), kt = r / 80, nt = r % 80;
        transpose_tile(p.in[9] + (size_t)l * 2048 * 5144, 5144, kt * 64, nt * 64, 5144, p.winT + (size_t)l * NPAD_IN * 2048, 2048, nt * 64, 32, nullptr, lds); return; }
    i -= TR0;
    if (i < TR1) { const int l = i / 1024, r = i % 1024, kt = r / 32, nt = r % 32;
        transpose_tile(p.in[18] + (size_t)l * 2048 * 2048, 2048, kt * 64, nt * 64, 2048, p.woutT + (size_t)l * 2048 * 2048, 2048, nt * 64, 32, p.in[17] + (size_t)l * 2048, lds); return; }
    i -= TR1;
    if (i < TR2 + TR3) { const int up = i >= TR2; if (up) i -= TR2; const int le = i / 256, r = i % 256, kt = r / 8, nt = r % 8;
        transpose_tile(p.in[up ? 20 : 19] + (size_t)le * 2048 * 512, 512, kt * 64, nt * 64, 512, p.wguT + (size_t)le * 1024 * 2048, 2048, (nt >> 1) * 256 + (nt & 1) * 64 + (up ? 128 : 0), 32, nullptr, lds); return; }
    i -= TR2 + TR3;
    if (i < TR4) { const int le = i / 256, r = i % 256, kt = r / 32, nt = r % 32;
        transpose_tile(p.in[21] + (size_t)le * 512 * 2048, 2048, kt * 64, nt * 64, 2048, p.wdT + (size_t)le * 2048 * 512, 512, nt * 64, 32, nullptr, lds); return; }
    i -= TR4;
    if (i < TR5 + TR6) { const int v = i >= TR5; if (v) i -= TR5; const int l = i / 64, r = i % 64, kt = r / 2, nt = r % 2;
        transpose_tile(p.in[v ? 14 : 12] + (size_t)l * 2048 * 128, 128, kt * 64, nt * 64, 128, p.cw1T + (size_t)(l * 2 + v) * 128 * 2048, 2048, nt * 64, 32, nullptr, lds); return; }
    i -= TR5 + TR6;
    { const int v = i >= TR7; if (v) i -= TR7; const int l = i / 2, kt = i % 2;
        transpose_tile(p.in[v ? 15 : 13] + (size_t)l * 128 * 64, 64, kt * 64, 0, 64, p.cw2T + (size_t)(l * 2 + v) * 64 * 128, 128, 0, 32, nullptr, lds); }
}

DI void norm_mod_row(const P& p, int l, int row, int which, float (&hv)[32]) {
    const int lane = tidx() & 63, b = row / S;
    const float* x = ((l == 0 && which == 0) ? p.in[0] : p.xres) + (size_t)row * D;
    float ss = 0.f;
#pragma unroll
    for (int i = 0; i < 8; ++i) {
        const float4 v = *(const float4*)(x + i * 256 + lane * 4);
        hv[i * 4 + 0] = v.x; hv[i * 4 + 1] = v.y; hv[i * 4 + 2] = v.z; hv[i * 4 + 3] = v.w;
        ss += v.x * v.x + v.y * v.y + v.z * v.z + v.w * v.w;
    }
    ss = wave_sum(ss);
    const float r = rsqrtf(ss * (1.f / D) + EPS);
    const float* g = p.in[which ? 6 : 5] + (size_t)l * D;
    const float* sh = p.mod + ((size_t)l * 4 + b) * 12288 + (which ? 3 * D : 0);
    const float* sc = sh + D;
    bf16_t* h = p.hbuf + (size_t)row * D;
#pragma unroll
    for (int i = 0; i < 8; ++i) {
        const int col = i * 256 + lane * 4;
        const float4 gv = *(const float4*)(g + col), shv = *(const float4*)(sh + col), scv = *(const float4*)(sc + col);
        hv[i * 4 + 0] = hv[i * 4 + 0] * r * gv.x * (1.f + scv.x) + shv.x;
        hv[i * 4 + 1] = hv[i * 4 + 1] * r * gv.y * (1.f + scv.y) + shv.y;
        hv[i * 4 + 2] = hv[i * 4 + 2] * r * gv.z * (1.f + scv.z) + shv.z;
        hv[i * 4 + 3] = hv[i * 4 + 3] * r * gv.w * (1.f + scv.w) + shv.w;
        uint2 pk;
        pk.x = (unsigned)f2bf(hv[i * 4 + 0]) | ((unsigned)f2bf(hv[i * 4 + 1]) << 16);
        pk.y = (unsigned)f2bf(hv[i * 4 + 2]) | ((unsigned)f2bf(hv[i * 4 + 3]) << 16);
        *(uint2*)(h + col) = pk;
    }
}
DI void phase_norm1_wave(const P& p, int l, int row, float* hrow  ) {
    float hv[32];
    norm_mod_row(p, l, row, 0, hv);
    const int lane = tidx() & 63;
    wave_lds_sync();
#pragma unroll
    for (int i = 0; i < 8; ++i) { float4 v; v.x = hv[i * 4]; v.y = hv[i * 4 + 1]; v.z = hv[i * 4 + 2]; v.w = hv[i * 4 + 3]; *(float4*)(hrow + i * 256 + lane * 4) = v; }
    wave_lds_sync();
    const int e = lane & 31, half = lane >> 5;
    const float* wp = p.in[9] + (size_t)l * 2048 * 5144 + (size_t)half * 1024 * 5144 + 5120 + (e < 24 ? e : 0);
    const float* hp = hrow + half * 1024;
    float a0 = 0.f, a1 = 0.f, a2 = 0.f, a3 = 0.f;
#pragma unroll 2
    for (int c = 0; c < 1024; c += 4) {
        a0 += hp[c] * wp[(size_t)(c + 0) * 5144]; a1 += hp[c + 1] * wp[(size_t)(c + 1) * 5144]; a2 += hp[c + 2] * wp[(size_t)(c + 2) * 5144]; a3 += hp[c + 3] * wp[(size_t)(c + 3) * 5144];
    }
    float acc = (a0 + a1) + (a2 + a3);
    acc += __shfl_xor(acc, 32);
    if (lane < 24) p.proj[(size_t)row * LDP + OFF_GD + lane] = f2bf(acc);
}

DI void phase_norm2_router_wave(const P& p, int l, int row, float* hrow  ) {
    float hv[32];
    norm_mod_row(p, l, row, 1, hv);
    const int lane = tidx() & 63;
    const float* rw = p.in[3];
    wave_lds_sync();
#pragma unroll
    for (int i = 0; i < 8; ++i) { float4 v; v.x = hv[i * 4]; v.y = hv[i * 4 + 1]; v.z = hv[i * 4 + 2]; v.w = hv[i * 4 + 3]; *(float4*)(hrow + i * 256 + lane * 4) = v; }
    wave_lds_sync();
    float lg[16];
    {
        const int e = lane & 15, part = lane >> 4;
        float a0 = 0.f, a1 = 0.f, a2 = 0.f, a3 = 0.f;
        const float* wp = rw + (size_t)part * 512 * 16 + e;
        const float* hp = hrow + part * 512;
#pragma unroll 2
        for (int c = 0; c < 512; c += 4) {
            a0 += hp[c] * wp[(c + 0) * 16]; a1 += hp[c + 1] * wp[(c + 1) * 16]; a2 += hp[c + 2] * wp[(c + 2) * 16]; a3 += hp[c + 3] * wp[(c + 3) * 16];
        }
        float acc = (a0 + a1) + (a2 + a3);
        acc += __shfl_xor(acc, 16); acc += __shfl_xor(acc, 32);
#pragma unroll
        for (int k = 0; k < 16; ++k) lg[k] = __shfl(acc, k);
    }
    if (lane == 0) {
        float aff[16], sc[16];
#pragma unroll
        for (int e = 0; e < 16; ++e) { aff[e] = sigmoidf_(lg[e]); sc[e] = aff[e] + p.in[4][e]; }
        int bg = 0; float bgs = -3e38f;
#pragma unroll
        for (int g = 0; g < 4; ++g) {
            float m1 = -3e38f, m2 = -3e38f;
#pragma unroll
            for (int j = 0; j < 4; ++j) { const float v = sc[g * 4 + j]; if (v > m1) { m2 = m1; m1 = v; } else if (v > m2) m2 = v; }
            const float gs = m1 + m2;
            if (gs > bgs) { bgs = gs; bg = g; }
        }
        float s4[4], a4[4];
#pragma unroll
        for (int g = 0; g < 4; ++g)
#pragma unroll
            for (int j = 0; j < 4; ++j) if (g == bg) { s4[j] = sc[g * 4 + j]; a4[j] = aff[g * 4 + j]; }
        int i1 = 0; float b1 = s4[0];
#pragma unroll
        for (int j = 1; j < 4; ++j) if (s4[j] > b1) { b1 = s4[j]; i1 = j; }
        int i2 = -1; float b2 = -3e38f;
#pragma unroll
        for (int j = 0; j < 4; ++j) if (j != i1 && s4[j] > b2) { b2 = s4[j]; i2 = j; }
        float w1 = 0.f, w2 = 0.f;
#pragma unroll
        for (int j = 0; j < 4; ++j) { if (j == i1) w1 = a4[j]; if (j == i2) w2 = a4[j]; }
        const float inv = 1.f / (w1 + w2);
        w1 *= inv; w2 *= inv;
        const int a = i1 < i2 ? i1 : i2, bb = i1 < i2 ? i2 : i1;
        const float wa = i1 < i2 ? w1 : w2, wb = i1 < i2 ? w2 : w1;
        const int pidx = (a == 0) ? (bb - 1) : (a == 1 ? (bb + 1) : 5);
        const int cls = bg * 6 + pidx;
        const unsigned pos = atomicAdd(p.ctl + CTL_CNT + l * 32 + cls, 1u);
        p.cls_tok[(size_t)cls * CLS_CAP + pos] = row;
        p.tokw[(size_t)row * 2 + 0] = wa; p.tokw[(size_t)row * 2 + 1] = wb;
    }
}

template <class AF, class BF, class EF>
DI void gemm_naive_tile(int K, AF af, BF bfn, EF ef, float* lds) {
    float(*sA)[129] = (float(*)[129])lds;
    float(*sB)[65] = (float(*)[65])(lds + 32 * 129);
    const int tid = tidx(), tx = tid & 15, ty = tid >> 4;
    const int lr = tid >> 2, lk = (tid & 3) * 8;
    float acc[4][4];
#pragma unroll
    for (int i = 0; i < 4; ++i)
#pragma unroll
        for (int j = 0; j < 4; ++j) acc[i][j] = 0.f;
    const bf16_t* arow = af(lr);
    for (int k0 = 0; k0 < K; k0 += 32) {
        const uint4 av = *(const uint4*)(arow + k0 + lk);
        const unsigned au[4] = {av.x, av.y, av.z, av.w};
#pragma unroll
        for (int j = 0; j < 4; ++j) { sA[lk + 2 * j][lr] = __uint_as_float(au[j] << 16); sA[lk + 2 * j + 1][lr] = __uint_as_float(au[j] & 0xffff0000u); }
        if (tid < 256) {
            const uint4 bv = *(const uint4*)(bfn(lr, k0) + lk);
            const unsigned bu[4] = {bv.x, bv.y, bv.z, bv.w};
#pragma unroll
            for (int j = 0; j < 4; ++j) { sB[lk + 2 * j][lr] = __uint_as_float(bu[j] << 16); sB[lk + 2 * j + 1][lr] = __uint_as_float(bu[j] & 0xffff0000u); }
        }
        __syncthreads();
#pragma unroll 8
        for (int kk = 0; kk < 32; ++kk) {
            float a[4], b[4];
#pragma unroll
            for (int i = 0; i < 4; ++i) { a[i] = sA[kk][ty * 4 + i]; b[i] = sB[kk][tx + 16 * i]; }
#pragma unroll
            for (int i = 0; i < 4; ++i)
#pragma unroll
                for (int j = 0; j < 4; ++j) acc[i][j] += a[i] * b[j];
        }
        __syncthreads();
    }
    ef(acc, ty * 4, tx);
}

DI void cls_experts(int cls, int& ea, int& eb) {
    const int g = cls / 6, pi = cls % 6;
    const int a = pi < 3 ? 0 : (pi < 5 ? 1 : 2);
    const int b = pi < 3 ? pi + 1 : (pi < 5 ? pi - 1 : 3);
    ea = g * 4 + a; eb = g * 4 + b;
}
DI bool cls_find(unsigned* cnt, int ft, int& cls, int& mt, int& slot_base) {
    int base = 0;
    for (int c = 0; c < NCLS; ++c) {
        const int nt = ((int)__hip_atomic_load(cnt + c, __ATOMIC_RELAXED, __HIP_MEMORY_SCOPE_AGENT) + 255) >> 8;
        if (ft < base + nt) { cls = c; mt = ft - base; slot_base = base * 256; return true; }
        base += nt;
    }
    return false;
}
DI int cls_total_tiles(unsigned* cnt) { int base = 0; for (int c = 0; c < NCLS; ++c) base += ((int)__hip_atomic_load(cnt + c, __ATOMIC_RELAXED, __HIP_MEMORY_SCOPE_AGENT) + 255) >> 8; return base; }

DI void phase_moe1(const P& p, int l, int bid, int nblk, float* lds) {
    unsigned* cnt = p.ctl + CTL_CNT + l * 32;
    const int ntiles = cls_total_tiles(cnt);
    for (int item = bid; item < ntiles * 2 * 32; item += nblk) {
        const int ft = item / 64, r = item % 64, half = r / 32, tn = r % 32;
        int cls, mt, sb; cls_find(cnt, ft, cls, mt, sb);
        int ea, eb; cls_experts(cls, ea, eb);
        const int n = (int)__hip_atomic_load(cnt + cls, __ATOMIC_RELAXED, __HIP_MEMORY_SCOPE_AGENT);
        const int row0 = mt * 256 + half * 128;
        const int* toks = p.cls_tok + (size_t)cls * CLS_CAP;
        const int which = tn >= 16;
        const int e = which ? eb : ea;
        const int hc0 = (tn & 15) * 32;
        const bf16_t* Bg = p.wguT + (((size_t)l * 16 + e) * 1024 + (hc0 >> 7) * 256 + (hc0 & 127)) * 2048;
        bf16_t* Hd = p.hid + (size_t)(sb + row0) * 1024 + which * 512 + hc0;
        gemm_naive_tile(2048,
            [&](int rr) { const int ri = row0 + rr; const int tok = ri < n ? toks[ri] : toks[0]; return p.hbuf + (size_t)tok * D; },
            [&](int c, int k0) { return Bg + (size_t)((c & 31) + (c >> 5) * 128) * 2048 + k0; },
            [&](float (&acc)[4][4], int r0, int c0) {
#pragma unroll
                for (int i = 0; i < 4; ++i) {
                    const int ri = row0 + r0 + i;
                    if (ri < n) {
                        const float w = p.tokw[(size_t)toks[ri] * 2 + which];
                        Hd[(size_t)(r0 + i) * 1024 + c0] = f2bf(siluf_(acc[i][0]) * acc[i][2] * w);
                        Hd[(size_t)(r0 + i) * 1024 + c0 + 16] = f2bf(siluf_(acc[i][1]) * acc[i][3] * w);
                    }
                }
            }, lds);
    }
}
DI void phase_moe2(const P& p, int l, int bid, int nblk, float* lds) {
    unsigned* cnt = p.ctl + CTL_CNT + l * 32;
    const int ntiles = cls_total_tiles(cnt);
    for (int item = bid; item < ntiles * 2 * 32; item += nblk) {
        const int ft = item / 64, r = item % 64, half = r / 32, tn = r % 32;
        int cls, mt, sb; cls_find(cnt, ft, cls, mt, sb);
        int ea, eb; cls_experts(cls, ea, eb);
        const int n = (int)__hip_atomic_load(cnt + cls, __ATOMIC_RELAXED, __HIP_MEMORY_SCOPE_AGENT);
        const int row0 = mt * 256 + half * 128;
        const int* toks = p.cls_tok + (size_t)cls * CLS_CAP;
        const bf16_t* A = p.hid + (size_t)(sb + row0) * 1024;
        const bf16_t* Ba = p.wdT + (((size_t)l * 16 + ea) * 2048 + tn * 64) * 512;
        const bf16_t* Bb = p.wdT + (((size_t)l * 16 + eb) * 2048 + tn * 64) * 512;
        gemm_naive_tile(1024,
            [&](int rr) { return A + (size_t)rr * 1024; },
            [&](int c, int k0) { return k0 < 512 ? (Ba + (size_t)c * 512 + k0) : (Bb + (size_t)c * 512 + (k0 - 512)); },
            [&](float (&acc)[4][4], int r0, int c0) {
#pragma unroll
                for (int i = 0; i < 4; ++i) {
                    const int ri = row0 + r0 + i;
                    if (ri < n) {
                        const int tok = toks[ri];
                        const int b = tok / S;
                        const float* g2 = p.mod + ((size_t)l * 4 + b) * 12288 + 5 * D + tn * 64;
                        float* xr = p.xres + (size_t)tok * D + tn * 64;
#pragma unroll
                        for (int j = 0; j < 4; ++j) { const int c = c0 + 16 * j; xr[c] += g2[c] * acc[i][j]; }
                    }
                }
            }, lds);
    }
}

constexpr int N_KMEAN_ITEMS = 4 * 8 * 16;
DI void phase_kmean_item(const P& p, int item, float* lds) {
    const int b = item / 128, h = (item / 16) % 8, blk = item % 16, tid = tidx(), d = tid & 63, part = tid >> 6;
    const bf16_t* k = p.proj + ((size_t)b * S + blk * 256 + part * 32) * LDP + OFF_KC + h * 64 + d;
    float s = 0.f;
    for (int i = 0; i < 32; ++i) s += bf2f(k[(size_t)i * LDP]);
    lds[tid] = s;
    __syncthreads();
    if (tid < 64) { float v = 0.f; for (int q = 0; q < 8; ++q) v += lds[tid + 64 * q]; p.kmean[(size_t)item * 64 + tid] = v * (1.f / 256.f); }
    __syncthreads();
}
constexpr int N_CMP_ITEMS = 2 * 4 * 2 * 255;
DI void phase_cmp_item(const P& p, int l, int item, float* lds) {
    const int v = item / (4 * 2 * 255), r = item % (4 * 2 * 255), b = r / 510, hk = (r / 255) % 2, n = r % 255, tid = tidx();
    float* in = lds;
    float* part = lds + 2048;
    float* hd = lds + 2560;
    const float* pe = p.in[v ? 11 : 10] + (size_t)l * 2048;
    const bf16_t* src = p.proj + ((size_t)b * S + 16 * n) * LDP + (v ? OFF_VDC : OFF_KDC) + hk * 64;
    for (int i = tid; i < 2048; i += NTHR) in[i] = bf2f(src[(size_t)(i >> 6) * LDP + (i & 63)]) + pe[i];
    __syncthreads();
    const float* w1 = p.in[v ? 14 : 12] + (size_t)l * 2048 * 128;
    { const int j = tid & 127, q = tid >> 7; float s = 0.f;
      for (int i = q * 512; i < q * 512 + 512; ++i) s += in[i] * w1[(size_t)i * 128 + j];
      part[tid] = s; }
    __syncthreads();
    if (tid < 128) hd[tid] = gelu_tanh(part[tid] + part[tid + 128] + part[tid + 256] + part[tid + 384]);
    __syncthreads();
    const float* w2 = p.in[v ? 15 : 13] + (size_t)l * 128 * 64;
    { const int d = tid & 63, q = tid >> 6; float s = 0.f;
      for (int j = q * 16; j < q * 16 + 16; ++j) s += hd[j] * w2[j * 64 + d];
      part[tid] = s; }
    __syncthreads();
    if (tid < 64) { float o = 0.f; for (int q = 0; q < 8; ++q) o += part[tid + 64 * q]; (v ? p.vc : p.kc)[(((size_t)b * 2 + hk) * 256 + n) * 64 + tid] = f2bf(o); }
    __syncthreads();
}


template <class C>
DI float attn_wave(const bf16_t* qrow, const C& cand, int ncand, bool has_sink, float sink, float* sl, float& lse_out) {
    const int lane = tidx() & 63;
    float q[64];
#pragma unroll
    for (int i = 0; i < 8; ++i) {
        const uint4 v = *(const uint4*)(qrow + i * 8);
        const unsigned u[4] = {v.x, v.y, v.z, v.w};
#pragma unroll
        for (int j = 0; j < 4; ++j) { q[i * 8 + 2 * j] = __uint_as_float(u[j] << 16); q[i * 8 + 2 * j + 1] = __uint_as_float(u[j] & 0xffff0000u); }
    }
    float mx = NEGF;
    for (int c0 = 0; c0 < ncand; c0 += 64) {
        const int c = c0 + lane;
        float s = NEGF;
        if (c < ncand) {
            const bf16_t *kr, *vr; float bias;
            if (cand.get(c, kr, vr, bias)) {
                float dot = 0.f;
#pragma unroll
                for (int i = 0; i < 8; ++i) {
                    const uint4 v = *(const uint4*)(kr + i * 8);
                    const unsigned u[4] = {v.x, v.y, v.z, v.w};
#pragma unroll
                    for (int j = 0; j < 4; ++j) { dot += q[i * 8 + 2 * j] * __uint_as_float(u[j] << 16); dot += q[i * 8 + 2 * j + 1] * __uint_as_float(u[j] & 0xffff0000u); }
                }
                s = dot * 0.125f + bias;
            }
            sl[c] = s;
        }
        mx = fmaxf(mx, s);
    }
    mx = wave_max(mx);
    if (has_sink) mx = fmaxf(mx, sink);
    float sum = 0.f;
    for (int c0 = 0; c0 < ncand; c0 += 64) {
        const int c = c0 + lane;
        if (c < ncand) { const float s = sl[c]; const float e = (s > -1e29f) ? __expf(s - mx) : 0.f; sl[c] = e; sum += e; }
    }
    sum = wave_sum(sum);
    if (has_sink) sum += __expf(sink - mx);
    sum = fmaxf(sum, 1.17549435e-38f);
    lse_out = mx + logf(sum);
    const float inv = 1.f / sum;
    for (int c0 = 0; c0 < ncand; c0 += 64) { const int c = c0 + lane; if (c < ncand) sl[c] *= inv; }
    wave_lds_sync();
    float o = 0.f;
    for (int c = 0; c < ncand; ++c) {
        const float pr = sl[c];
        if (pr != 0.f) { const bf16_t *kr, *vr; float bias; cand.get(c, kr, vr, bias); o += pr * bf2f(vr[lane]); }
    }
    return o;
}

struct BandCand {
    const bf16_t *kb, *vb; int t, r; const float* tab;
    DI bool get(int c, const bf16_t*& kr, const bf16_t*& vr, float& bias) const {
        const int kp = t - c * r; if (kp < 0) return false;
        kr = kb + (size_t)kp * LDP; vr = vb + (size_t)kp * LDP; bias = tab[t5_bucket(c * r) * 32]; return true;
    }
};
struct MobaCand {
    const bf16_t *kb, *vb; int t; const int* sel; const float* tab;
    DI bool get(int c, const bf16_t*& kr, const bf16_t*& vr, float& bias) const {
        const int blk = sel[c >> 8], j = c & 255;
        if (blk < 0) return false;
        const int kp = blk * 256 + j; if (kp > t) return false;
        kr = kb + (size_t)kp * LDP; vr = vb + (size_t)kp * LDP; bias = tab[t5_bucket(t - kp) * 32]; return true;
    }
};
struct CmpCand {
    const bf16_t *kc, *vc; int t;
    DI bool get(int c, const bf16_t*& kr, const bf16_t*& vr, float& bias) const {
        if (16 * c + 31 > t) return false;
        kr = kc + (size_t)c * 64; vr = vc + (size_t)c * 64; bias = 0.f; return true;
    }
};
struct SlcCand {
    const bf16_t *kb, *vb; int t; const int* sel; const float* tab;
    DI bool get(int c, const bf16_t*& kr, const bf16_t*& vr, float& bias) const {
        const int blk = sel[c >> 6]; if (blk < 0) return false;
        const int kp = blk * 64 + (c & 63); if (kp > t) return false;
        kr = kb + (size_t)kp * LDP; vr = vb + (size_t)kp * LDP; bias = tab[t5_bucket(t - kp) * 32]; return true;
    }
};

constexpr int N_ATT_WAVE_ITEMS = 3 * T * 8 + T * 8 + T * 8;
DI void phase_attn_wave_item(const P& p, int l, int item, float* sl, int* selw) {
    const int lane = tidx() & 63;
    const float* relb = p.in[2];
    if (item < 3 * T * 8) {
        const int cfg = item / (T * 8), rem = item % (T * 8), row = rem >> 3, h = rem & 7, b = row / S, t = row % S;
        const int r = cfg == 0 ? 1 : (cfg == 1 ? 4 : 16);
        BandCand cd{p.proj + (size_t)b * S * LDP + OFF_KA + h * 64, p.proj + (size_t)b * S * LDP + OFF_VA + h * 64, t, r, relb + 0 + h};
        float lse;
        const float o = attn_wave(p.proj + (size_t)row * LDP + OFF_QA + h * 64, cd, 129, false, 0.f, sl, lse);
        p.oA[((size_t)cfg * T + row) * 512 + h * 64 + lane] = f2bf(o);
        if (lane == 0) p.lseA[((size_t)cfg * T + row) * 8 + h] = lse;
        return;
    }
    item -= 3 * T * 8;
    if (item < T * 8) {
        const int row = item >> 3, hq = item & 7, kvh = hq >> 2, b = row / S, t = row % S;
        BandCand cd{p.proj + (size_t)b * S * LDP + OFF_KB + kvh * 64, p.proj + (size_t)b * S * LDP + OFF_VB + kvh * 64, t, 1, relb + 8 + hq};
        float lse;
        const float o = attn_wave(p.proj + (size_t)row * LDP + OFF_QB + hq * 64, cd, 128, true, p.in[16][l * 8 + hq], sl, lse);
        p.oB[(size_t)row * 512 + hq * 64 + lane] = f2bf(o);
        return;
    }
    item -= T * 8;
    {
        const int row = item >> 3, h = item & 7, b = row / S, t = row % S, cur = t >> 8;
        const bf16_t* qrow = p.proj + (size_t)row * LDP + OFF_QC + h * 64;
        float gate = NEGF;
        if (lane < cur) {
            const float* km = p.kmean + (((size_t)b * 8 + h) * 16 + lane) * 64;
            float dot = 0.f;
            for (int d = 0; d < 64; ++d) dot += bf2f(qrow[d]) * km[d];
            gate = dot;
        }
        int s0, s1, s2;
        { float v = gate; int idx = lane;
          for (int o = 32; o > 0; o >>= 1) { const float ov = __shfl_xor(v, o); const int oi = __shfl_xor(idx, o); if (ov > v || (ov == v && oi < idx)) { v = ov; idx = oi; } }
          s0 = (v > -1e29f) ? idx : -1; if (lane == idx) gate = -3e38f; }
        { float v = gate; int idx = lane;
          for (int o = 32; o > 0; o >>= 1) { const float ov = __shfl_xor(v, o); const int oi = __shfl_xor(idx, o); if (ov > v || (ov == v && oi < idx)) { v = ov; idx = oi; } }
          s1 = (v > -1e29f) ? idx : -1; if (lane == idx) gate = -3e38f; }
        { float v = gate; int idx = lane;
          for (int o = 32; o > 0; o >>= 1) { const float ov = __shfl_xor(v, o); const int oi = __shfl_xor(idx, o); if (ov > v || (ov == v && oi < idx)) { v = ov; idx = oi; } }
          s2 = (v > -1e29f) ? idx : -1; if (lane == idx) gate = -3e38f; }
        if (lane == 0) { selw[0] = s0; selw[1] = s1; selw[2] = s2; selw[3] = cur; }
        wave_lds_sync();
        MobaCand cd{p.proj + (size_t)b * S * LDP + OFF_KC + h * 64, p.proj + (size_t)b * S * LDP + OFF_VC + h * 64, t, selw, relb + 16 + h};
        float lse;
        const float o = attn_wave(qrow, cd, 1024, false, 0.f, sl, lse);
        p.oC[(size_t)row * 512 + h * 64 + lane] = f2bf(o);
    }
}
constexpr int N_NSA_ITEMS = 4 * 2 * S;
DI void phase_nsa_item(const P& p, int l, int item0, float* lds) {
    const int tid = tidx(), grp = tid >> 8, g = (tid >> 6) & 3, lane = tid & 63;
    const int item = item0 + grp;
    const int b = item / (2 * S), hk = (item / S) % 2, t = item % S, hq = hk * 4 + g;
    const int row = b * S + t, cur = t >> 6;
    float* gl = lds + grp * 4096;
    float* sl = gl + g * 1024;
    int* sel = (int*)(lds + 8192) + grp * 16;
    const bf16_t* qrow = p.proj + (size_t)row * LDP + OFF_QD + hq * 64;
    const float* relb = p.in[2];
    float lse;
    CmpCand cc{p.kc + ((size_t)b * 2 + hk) * 256 * 64, p.vc + ((size_t)b * 2 + hk) * 256 * 64, t};
    const float o_cmp = attn_wave(qrow, cc, 255, false, 0.f, sl, lse);
    __syncthreads();
    if (g == 0) {
        const int j = lane;
        float imp = 0.f;
        for (int n = 4 * j - 1; n <= 4 * j + 3; ++n)
            if (n >= 0 && n < 255) imp += gl[n] + gl[1024 + n] + gl[2048 + n] + gl[3072 + n];
        float val = (j == 0 || j == cur || j == cur - 1) ? 1e30f : (j <= cur ? imp : NEGF);
        for (int k = 0; k < 16; ++k) {
            float v = val; int idx = lane;
            for (int o = 32; o > 0; o >>= 1) { const float ov = __shfl_xor(v, o); const int oi = __shfl_xor(idx, o); if (ov > v || (ov == v && oi < idx)) { v = ov; idx = oi; } }
            if (lane == 0) sel[k] = (v > -1e29f) ? idx : -1;
            if (lane == idx) val = -3e38f;
        }
    }
    __syncthreads();
    SlcCand sc{p.proj + (size_t)b * S * LDP + OFF_KDS + hk * 64, p.proj + (size_t)b * S * LDP + OFF_VDS + hk * 64, t, sel, relb + 24 + hq};
    const float o_slc = attn_wave(qrow, sc, 1024, false, 0.f, sl, lse);
    BandCand wc{p.proj + (size_t)b * S * LDP + OFF_KDW + hk * 64, p.proj + (size_t)b * S * LDP + OFF_VDW + hk * 64, t, 1, relb + 24 + hq};
    const float o_win = attn_wave(qrow, wc, 512, false, 0.f, sl, lse);
    const bf16_t* gd = p.proj + (size_t)row * LDP + OFF_GD + hq * 3;
    const float g0 = sigmoidf_(bf2f(gd[0])), g1 = sigmoidf_(bf2f(gd[1])), g2 = sigmoidf_(bf2f(gd[2]));
    p.oD[(size_t)row * 512 + hq * 64 + lane] = f2bf(g0 * o_cmp + g1 * o_slc + g2 * o_win);
    __syncthreads();
}

constexpr int N_MIXN_WAVE_ITEMS = T * 4;
DI void phase_mixnorm_wave(const P& p, int item) {
    const int row = item >> 2, grp = item & 3, lane = tidx() & 63, h = lane >> 3;
    float v[8];
    if (grp == 0) {
        const float l0 = p.lseA[((size_t)0 * T + row) * 8 + h], l1 = p.lseA[((size_t)1 * T + row) * 8 + h], l2 = p.lseA[((size_t)2 * T + row) * 8 + h];
        const float m = fmaxf(l0, fmaxf(l1, l2));
        float w0 = __expf(l0 - m), w1 = __expf(l1 - m), w2 = __expf(l2 - m);
        const float inv = 1.f / (w0 + w1 + w2); w0 *= inv; w1 *= inv; w2 *= inv;
        const uint4 a = *(const uint4*)(p.oA + ((size_t)0 * T + row) * 512 + lane * 8);
        const uint4 bq = *(const uint4*)(p.oA + ((size_t)1 * T + row) * 512 + lane * 8);
        const uint4 c = *(const uint4*)(p.oA + ((size_t)2 * T + row) * 512 + lane * 8);
        const unsigned au[4] = {a.x, a.y, a.z, a.w}, bu[4] = {bq.x, bq.y, bq.z, bq.w}, cu[4] = {c.x, c.y, c.z, c.w};
#pragma unroll
        for (int j = 0; j < 4; ++j) {
            v[2 * j] = w0 * __uint_as_float(au[j] << 16) + w1 * __uint_as_float(bu[j] << 16) + w2 * __uint_as_float(cu[j] << 16);
            v[2 * j + 1] = w0 * __uint_as_float(au[j] & 0xffff0000u) + w1 * __uint_as_float(bu[j] & 0xffff0000u) + w2 * __uint_as_float(cu[j] & 0xffff0000u);
        }
    } else {
        const bf16_t* src = (grp == 1 ? p.oB : (grp == 2 ? p.oC : p.oD)) + (size_t)row * 512 + lane * 8;
        const uint4 a = *(const uint4*)src;
        const unsigned au[4] = {a.x, a.y, a.z, a.w};
#pragma unroll
        for (int j = 0; j < 4; ++j) { v[2 * j] = __uint_as_float(au[j] << 16); v[2 * j + 1] = __uint_as_float(au[j] & 0xffff0000u); }
    }
    float ss = 0.f;
#pragma unroll
    for (int j = 0; j < 8; ++j) ss += v[j] * v[j];
    ss = wave_sum(ss);
    const float r = rsqrtf(ss * (1.f / 512.f) + EPS);
    uint4 o;
    o.x = (unsigned)f2bf(v[0] * r) | ((unsigned)f2bf(v[1] * r) << 16);
    o.y = (unsigned)f2bf(v[2] * r) | ((unsigned)f2bf(v[3] * r) << 16);
    o.z = (unsigned)f2bf(v[4] * r) | ((unsigned)f2bf(v[5] * r) << 16);
    o.w = (unsigned)f2bf(v[6] * r) | ((unsigned)f2bf(v[7] * r) << 16);
    *(uint4*)(p.hbuf + (size_t)row * D + grp * 512 + lane * 8) = o;
}

DI void phase_final_wave(const P& p, int row, bool poison) {
    const int lane = tidx() & 63;
    const float* x = p.xres + (size_t)row * D;
    float4 v[8]; float ss = 0.f;
#pragma unroll
    for (int i = 0; i < 8; ++i) { v[i] = *(const float4*)(x + i * 256 + lane * 4); ss += v[i].x * v[i].x + v[i].y * v[i].y + v[i].z * v[i].z + v[i].w * v[i].w; }
    ss = wave_sum(ss);
    const float r = rsqrtf(ss * (1.f / D) + EPS);
#pragma unroll
    for (int i = 0; i < 8; ++i) {
        const float4 g = *(const float4*)(p.in[22] + i * 256 + lane * 4);
        float4 o; o.x = v[i].x * r * g.x; o.y = v[i].y * r * g.y; o.z = v[i].z * r * g.z; o.w = v[i].w * r * g.w;
        if (poison) { o.x = o.y = o.z = o.w = __uint_as_float(0x7fc00000u); }
        *(float4*)(p.out + (size_t)row * D + i * 256 + lane * 4) = o;
    }
}

#define XB_TMO      128
#define XB_XCNT(j)  (256  + 64 * (j))
#define XB_XSUB(j)  (1280 + 64 * (j))
#define XB_XGEN(j)  (2304 + 64 * (j))
#define XB_TOP      3328
#define XB_TOPGEN   3392
#define XCD_BAR_WORDS 3456
#define XB_SPIN_CAP (1u << 21)
#define LAS __attribute__((address_space(3)))

__device__ __forceinline__ unsigned xb_ld(unsigned* p)              { return __hip_atomic_load(p, __ATOMIC_RELAXED, __HIP_MEMORY_SCOPE_AGENT); }
__device__ __forceinline__ unsigned xb_add(unsigned* p, unsigned v) { return __hip_atomic_fetch_add(p, v, __ATOMIC_RELAXED, __HIP_MEMORY_SCOPE_AGENT); }
__device__ __forceinline__ unsigned xb_xcc_id() { return (unsigned)__builtin_amdgcn_s_getreg((3 << 11) | 20) & 0xFu; }
#define XB_SPIN(cond, bar) do { unsigned _sp = 0; while (cond) { __builtin_amdgcn_s_sleep(1); \
    if ((++_sp & 255u) == 0u) { if (xb_ld(&(bar)[XB_TMO])) break; if (_sp > XB_SPIN_CAP) { atomicAdd(&(bar)[XB_TMO], 1u); break; } } } } while (0)

struct XcdBarrier { unsigned* bar; unsigned x; volatile LAS unsigned* st; };

__device__ __forceinline__ XcdBarrier xcd_barrier_post(unsigned* bar, volatile LAS unsigned* st) {
    XcdBarrier b; b.bar = bar; b.x = xb_xcc_id(); b.st = st;
    if (threadIdx.x == 0) (void)xb_add(&bar[XB_XCNT(b.x)], 1u);
    return b;
}
__device__ __forceinline__ void xcd_barrier_complete(unsigned* bar, unsigned x, unsigned& nloc, unsigned& nx) {
    const unsigned G = gridDim.x * gridDim.y * gridDim.z;
    unsigned sum, cnt, mine, sp = 0u;
    for (;;) {
        sum = 0u; cnt = 0u; mine = 0u;
#pragma unroll
        for (unsigned j = 0; j < 16; ++j) { const unsigned c = xb_ld(&bar[XB_XCNT(j)]); sum += c; cnt += (c > 0u) ? 1u : 0u; mine = (j == x) ? c : mine; }
        if (sum == G) break;
        __builtin_amdgcn_s_sleep(1);
        if ((++sp & 255u) == 0u) { if (xb_ld(&bar[XB_TMO])) break; if (sp > XB_SPIN_CAP) { atomicAdd(&bar[XB_TMO], 1u); break; } }
    }
    nloc = mine > 0u ? mine : 1u; nx = cnt > 0u ? cnt : 1u;
}
__device__ __forceinline__ void xcd_barrier(const XcdBarrier& b) {
    asm volatile("s_waitcnt vmcnt(0)" ::: "memory");
    __syncthreads();
    if (threadIdx.x == 0) {
        unsigned* bar = b.bar;
        __builtin_amdgcn_s_waitcnt(0);
        unsigned nloc = b.st[0], nx = b.st[1];
        if (nloc == 0u) { xcd_barrier_complete(bar, b.x, nloc, nx); b.st[0] = nloc; b.st[1] = nx; }
        const unsigned old = xb_add(&bar[XB_XSUB(b.x)], 1u);
        const unsigned gen = old / nloc;
        if (old + 1u == (gen + 1u) * nloc) {
            __builtin_amdgcn_fence(__ATOMIC_RELEASE, "agent");
            asm volatile("s_waitcnt vmcnt(0)" ::: "memory");
            const unsigned og = xb_add(&bar[XB_TOP], 1u);
            const unsigned tg = og / nx;
            if (og + 1u == (tg + 1u) * nx) xb_add(&bar[XB_TOPGEN], 1u);
            else XB_SPIN(xb_ld(&bar[XB_TOPGEN]) == tg, bar);
            __builtin_amdgcn_fence(__ATOMIC_ACQUIRE, "agent");
            xb_add(&bar[XB_XGEN(b.x)], 1u);
            asm volatile("s_waitcnt vmcnt(0)" ::: "memory");
        } else {
            XB_SPIN(xb_ld(&bar[XB_XGEN(b.x)]) == gen, bar);
            __builtin_amdgcn_fence(__ATOMIC_ACQUIRE, "agent");
            asm volatile("s_waitcnt vmcnt(0)" ::: "memory");
        }
    }
    __syncthreads();
}

namespace pg8 {
#define PG8_LAS __attribute__((address_space(3)))
typedef short bf16x8 __attribute__((ext_vector_type(8)));
typedef float f32x4 __attribute__((ext_vector_type(4)));
typedef unsigned u32x4 __attribute__((ext_vector_type(4)));
constexpr int BM = 256, BK = 64, HALF = 128, HTB = HALF * BK * 2  , STAGE_BYTES = 8 * HTB, NXCD = 8, WGM = 8;

__device__ __forceinline__ int lds_byte(int r, int c) { const int st = (r >> 4) * 2 + (c >> 5), rr = r & 15, cc = c & 31, ob = rr * 64 + cc * 2; return st * 1024 + (ob ^ (((ob >> 9) & 1) << 5)); }
__device__ __forceinline__ void stage_rc(int b, int& R, int& C) { const int st = b / 1024, sb = b % 1024, swz = sb ^ (((sb >> 9) & 1) << 5); R = (st >> 1) * 16 + swz / 64; C = (st & 1) * 32 + (swz % 64) / 2; }
__device__ __forceinline__ int perm32(int rho) { const int n = rho >> 4, i = rho & 15; return 8 * (i >> 2) + 4 * n + (i & 3); }

struct Unit { int pm, pn; const char* A; const char* Ba; const char* Bb; int aux0, aux1, aux2; };
struct Shape { int K, lda, ldb, ksplit; };

__device__ __forceinline__ unsigned cvt_pk_bf16(float lo, float hi) { unsigned r; asm volatile("v_cvt_pk_bf16_f32 %0, %1, %2" : "=v"(r) : "v"(lo), "v"(hi)); return r; }

template <class Epi, class Sched, bool GATHER, bool ALIGN_EPI = true>
__device__ __forceinline__ void gemm_phase(PG8_LAS unsigned char* lds, const Shape g, const Sched& S, const Epi& E) {
    const int tid = tidx(), wid = __builtin_amdgcn_readfirstlane(tid >> 6), lane = tid & 63, wr = wid >> 2, wc = wid & 3, fr = lane & 15, fq = lane >> 4;
    const int nt = g.K / BK;
    int RA[2], CA[2];
    unsigned voffA[2], voffA1[2], voffB[2];
#pragma unroll
    for (int i = 0; i < 2; ++i) { int R, C; stage_rc(tid * 16 + i * 8192, R, C); const int Rb = Epi::PERM ? ((R & ~31) + perm32(R & 31)) : R;
        RA[i] = R; CA[i] = C; voffA[i] = (unsigned)(R * g.lda + C) * 2u; voffA1[i] = voffA[i]; voffB[i] = (unsigned)(Rb * g.ldb + C) * 2u; }
    const size_t kstep = (size_t)(BK * 2);
    const size_t hstepA = GATHER ? 0 : (size_t)HALF * g.lda * 2;
    const size_t hstepB = (size_t)HALF * g.ldb * 2;
    const unsigned ldsw = (unsigned)wid * 1024u;
    const int aoff = lds_byte(wr * 64 + fr, fq * 8), boff = lds_byte(wc * 32 + fr, fq * 8);
#define PG8_SA(b, h) (((b) * 2 + (h)) * HTB)
#define PG8_SB(b, h) ((4 + (b) * 2 + (h)) * HTB)
#define PG8_STAGE(bufoff, gbase, voff) do { _Pragma("unroll") for (int _i = 0; _i < 2; ++_i) \
        __builtin_amdgcn_global_load_lds((const unsigned*)((const char*)(gbase) + (voff)[_i]), (PG8_LAS unsigned*)(lds + (bufoff) + ldsw + _i * 8192), 16, 0, 0); } while (0)
#define PG8_STAGE_A0(bufoff, gbase) PG8_STAGE(bufoff, gbase, voffA)
#define PG8_STAGE_A1(bufoff, gbase) do { if constexpr (GATHER) PG8_STAGE(bufoff, gbase, voffA1); else PG8_STAGE(bufoff, (gbase) + hstepA, voffA); } while (0)
#define PG8_LDA(dst, b, h) do { _Pragma("unroll") for (int m = 0; m < 4; ++m) _Pragma("unroll") for (int k = 0; k < 2; ++k) dst[m][k] = *(const PG8_LAS bf16x8*)(lds + PG8_SA(b, h) + aoff + m * 2048 + k * 1024); } while (0)
#define PG8_LDB(dst, b, h) do { _Pragma("unroll") for (int n = 0; n < 2; ++n) _Pragma("unroll") for (int k = 0; k < 2; ++k) dst[n][k] = *(const PG8_LAS bf16x8*)(lds + PG8_SB(b, h) + boff + n * 2048 + k * 1024); } while (0)
#define PG8_MMA(ai, bj, At, Bt) do { __builtin_amdgcn_s_setprio(1); _Pragma("unroll") for (int m = 0; m < 4; ++m) _Pragma("unroll") for (int n = 0; n < 2; ++n) _Pragma("unroll") for (int k = 0; k < 2; ++k) \
        acc[ai][bj][m][n] = __builtin_amdgcn_mfma_f32_16x16x32_bf16(Bt[n][k], At[m][k], acc[ai][bj][m][n], 0, 0, 0); __builtin_amdgcn_s_setprio(0); } while (0)
#define PG8_WAIT_V(n) asm volatile("s_waitcnt vmcnt(" #n ")" ::: "memory")
#define PG8_WAIT_L(n) asm volatile("s_waitcnt lgkmcnt(" #n ")" ::: "memory")
#define PG8_BAR __builtin_amdgcn_s_barrier()
#define PG8_SCHED __builtin_amdgcn_sched_barrier(0)
#define PG8_BK(u, t) (((t) < g.ksplit ? (u).Ba : (u).Bb) + (size_t)(t) * kstep)
    Unit cur, nxt; int ui = 0;
    if (!S.next(0, cur)) return;
    f32x4 acc[2][2][4][2];
#pragma unroll
    for (int a = 0; a < 2; ++a)
#pragma unroll
        for (int b = 0; b < 2; ++b)
#pragma unroll
            for (int m = 0; m < 4; ++m)
#pragma unroll
                for (int n = 0; n < 2; ++n) acc[a][b][m][n] = (f32x4){0.f, 0.f, 0.f, 0.f};
    bf16x8 At[4][2], B0[2][2], B1[2][2];
    const char* cA = cur.A; const char* cB = cur.Ba;
    if constexpr (GATHER) {
#pragma unroll
        for (int i = 0; i < 2; ++i) { voffA[i] = (unsigned)(S.gather_row(cur, RA[i]) * g.lda + CA[i]) * 2u; voffA1[i] = (unsigned)(S.gather_row(cur, RA[i] + HALF) * g.lda + CA[i]) * 2u; }
    }
    PG8_STAGE(PG8_SB(0, 0), cB, voffB); PG8_STAGE(PG8_SB(0, 1), cB + hstepB, voffB); PG8_STAGE_A0(PG8_SA(0, 0), cA); PG8_STAGE_A1(PG8_SA(0, 1), cA);
    if (wr == 1) PG8_BAR;
    PG8_WAIT_V(2); PG8_BAR;
    PG8_STAGE(PG8_SB(1, 0), cB + kstep, voffB); PG8_STAGE_A0(PG8_SA(1, 0), cA + kstep); PG8_STAGE(PG8_SB(1, 1), cB + hstepB + kstep, voffB);
    PG8_WAIT_V(6); PG8_BAR;
    for (;;) {
        const bool has_next = S.next(ui + 1, nxt);
        const char* nA = has_next ? nxt.A : cA; const char* nB = has_next ? nxt.Ba : cB;
        for (int t = 0; t < nt; t += 2) {
            const bool last = (t == nt - 2);
            const char* a1 = cA + (size_t)(t + 1) * kstep;
            const char* a2 = last ? nA : cA + (size_t)(t + 2) * kstep; const char* b2 = last ? nB : PG8_BK(cur, t + 2);
            const char* a3 = a2 + kstep; const char* b3 = b2 + kstep;
            PG8_LDB(B0, 0, 0); PG8_LDB(B1, 0, 1); PG8_SCHED; PG8_LDA(At, 0, 0); PG8_STAGE_A1(PG8_SA(1, 1), a1);
            if constexpr (GATHER) { if (last && has_next) {
#pragma unroll
                for (int i = 0; i < 2; ++i) { voffA[i] = (unsigned)(S.gather_row(nxt, RA[i]) * g.lda + CA[i]) * 2u; voffA1[i] = (unsigned)(S.gather_row(nxt, RA[i] + HALF) * g.lda + CA[i]) * 2u; } } }
            PG8_WAIT_V(8); PG8_WAIT_L(0); PG8_BAR; PG8_MMA(0, 0, At, B0); PG8_MMA(0, 1, At, B1); PG8_BAR; PG8_SCHED;
            PG8_LDA(At, 0, 1); PG8_STAGE(PG8_SB(0, 0), b2, voffB); PG8_STAGE(PG8_SB(0, 1), b2 + hstepB, voffB); PG8_STAGE_A0(PG8_SA(0, 0), a2);
            PG8_WAIT_V(8); PG8_WAIT_L(0); PG8_BAR; PG8_MMA(1, 0, At, B0); PG8_MMA(1, 1, At, B1); PG8_BAR; PG8_SCHED;
            PG8_LDB(B0, 1, 0); PG8_LDB(B1, 1, 1); PG8_SCHED; PG8_LDA(At, 1, 0); PG8_STAGE_A1(PG8_SA(0, 1), a2);
            PG8_WAIT_V(8); PG8_WAIT_L(0); PG8_BAR; PG8_MMA(0, 0, At, B0); PG8_MMA(0, 1, At, B1); PG8_BAR; PG8_SCHED;
            PG8_LDA(At, 1, 1); PG8_STAGE(PG8_SB(1, 0), b3, voffB); PG8_STAGE(PG8_SB(1, 1), b3 + hstepB, voffB); PG8_STAGE_A0(PG8_SA(1, 0), a3);
            PG8_WAIT_V(8); PG8_WAIT_L(0); PG8_BAR; PG8_MMA(1, 0, At, B0); PG8_MMA(1, 1, At, B1); PG8_BAR; PG8_SCHED;
        }
        if constexpr (ALIGN_EPI) { if (wr == 0) PG8_BAR; }
        E(acc, cur, wr, wc, fr, fq);
        if (!has_next) break;
#pragma unroll
        for (int a = 0; a < 2; ++a)
#pragma unroll
            for (int b = 0; b < 2; ++b)
#pragma unroll
                for (int m = 0; m < 4; ++m)
#pragma unroll
                    for (int n = 0; n < 2; ++n) acc[a][b][m][n] = (f32x4){0.f, 0.f, 0.f, 0.f};
        cur = nxt; cA = nA; cB = nB; ++ui;
        if constexpr (ALIGN_EPI) { if (wr == 1) PG8_BAR; }
    }
    PG8_WAIT_V(0);
    if constexpr (!ALIGN_EPI) { if (wr == 0) PG8_BAR; }
    PG8_BAR;
#undef PG8_SA
#undef PG8_SB
#undef PG8_STAGE
#undef PG8_STAGE_A0
#undef PG8_STAGE_A1
#undef PG8_LDA
#undef PG8_LDB
#undef PG8_MMA
#undef PG8_WAIT_V
#undef PG8_WAIT_L
#undef PG8_BAR
#undef PG8_SCHED
#undef PG8_BK
}

struct GridOrder {
    int nM, nN, nwg, G, c;
    __device__ __forceinline__ void init(int M, int N, int G_, int c_) { nM = M / BM; nN = N / BM; nwg = nM * nN; G = G_; c = c_; }
    __device__ __forceinline__ bool flat(int i, int& pm, int& pn) const {
        const long L = (long)i * G + c; if (L >= nwg) return false;
        int wgid = (int)L; { const int q = nwg / NXCD, r = nwg % NXCD, xcd = wgid % NXCD, off = wgid / NXCD; wgid = (xcd < r ? xcd * (q + 1) : r * (q + 1) + (xcd - r) * q) + off; }
        const int nig = WGM * nN, gid = wgid / nig, fm = gid * WGM, gsz = (nM - fm) < WGM ? (nM - fm) : WGM;
        pm = fm + ((wgid % nig) % gsz); pn = (wgid % nig) / gsz; return true;
    }
};
}

struct DenseSched {
    pg8::GridOrder go; const char* A; const char* Bt; size_t a_tile, b_tile;
    DI bool next(int i, pg8::Unit& u) const { int pm, pn; if (!go.flat(i, pm, pn)) return false; u.pm = pm; u.pn = pn; u.A = A + (size_t)pm * a_tile; u.Ba = Bt + (size_t)pn * b_tile; u.Bb = u.Ba; u.aux0 = u.aux1 = u.aux2 = 0; return true; }
    DI int gather_row(const pg8::Unit&, int r) const { return r; }
};
struct EpiProj {
    static constexpr bool PERM = true;
    bf16_t* O;
    DI void operator()(const pg8::f32x4 (&acc)[2][2][4][2], const pg8::Unit& u, int wr, int wc, int fr, int fq) const {
        const int row0 = u.pm * 256 + wr * 64 + fr, col0 = u.pn * 256 + wc * 32 + 8 * fq;
#pragma unroll
        for (int ai = 0; ai < 2; ++ai)
#pragma unroll
            for (int m = 0; m < 4; ++m) { bf16_t* rowp = O + (size_t)(row0 + ai * 128 + m * 16) * LDP + col0;
#pragma unroll
                for (int bj = 0; bj < 2; ++bj) { const pg8::f32x4 v0 = acc[ai][bj][m][0], v1 = acc[ai][bj][m][1];
                    pg8::u32x4 w; w.x = pg8::cvt_pk_bf16(v0[0], v0[1]); w.y = pg8::cvt_pk_bf16(v0[2], v0[3]); w.z = pg8::cvt_pk_bf16(v1[0], v1[1]); w.w = pg8::cvt_pk_bf16(v1[2], v1[3]);
                    *(pg8::u32x4*)(rowp + bj * 128) = w; } }
    }
};
struct EpiResid {
    static constexpr bool PERM = true;
    const float* xs; float* xd; const float* gate;
    DI void operator()(const pg8::f32x4 (&acc)[2][2][4][2], const pg8::Unit& u, int wr, int wc, int fr, int fq) const {
        const int row0 = u.pm * 256 + wr * 64 + fr, col0 = u.pn * 256 + wc * 32 + 8 * fq;
        const float* gp = gate + (size_t)((u.pm * 256) / S) * 12288 + col0;
        pg8::f32x4 gv[2][2];
#pragma unroll
        for (int bj = 0; bj < 2; ++bj)
#pragma unroll
            for (int n = 0; n < 2; ++n) gv[bj][n] = *(const pg8::f32x4*)(gp + bj * 128 + 4 * n);
#pragma unroll
        for (int ai = 0; ai < 2; ++ai)
#pragma unroll
            for (int m = 0; m < 4; ++m) { const size_t ro = (size_t)(row0 + ai * 128 + m * 16) * D + col0;
#pragma unroll
                for (int bj = 0; bj < 2; ++bj)
#pragma unroll
                    for (int n = 0; n < 2; ++n) { const pg8::f32x4 xv = *(const pg8::f32x4*)(xs + ro + bj * 128 + 4 * n);
                        *(pg8::f32x4*)(xd + ro + bj * 128 + 4 * n) = xv + gv[bj][n] * acc[ai][bj][m][n]; } }
    }
};

constexpr int LDS_BYTES = 147456;
constexpr int LDS_MISC = 131072 / 4, LDS_TAB = 131328 / 4;
DI unsigned long long ld_tab(const float* lds, int i) {
    const unsigned lo = __builtin_amdgcn_readfirstlane(__float_as_uint(lds[LDS_TAB + 2 * i])), hi = __builtin_amdgcn_readfirstlane(__float_as_uint(lds[LDS_TAB + 2 * i + 1]));
    return ((unsigned long long)hi << 32) | lo;
}
DI P load_P(const float* lds) {
    asm volatile("" ::: "memory");
    P p;
#pragma unroll
    for (int i = 0; i < 23; ++i) p.in[i] = (const float*)ld_tab(lds, i);
    p.out = (float*)ld_tab(lds, 23);
    unsigned char* ws = (unsigned char*)ld_tab(lds, 24);
    p.ctl = (unsigned*)(ws + O_CTL); p.mod = (float*)(ws + O_MOD); p.xres = (float*)(ws + O_XRES); p.hbuf = (bf16_t*)(ws + O_HBUF); p.proj = (bf16_t*)(ws + O_PROJ);
    p.oA = (bf16_t*)(ws + O_OA); p.lseA = (float*)(ws + O_LSEA); p.oB = (bf16_t*)(ws + O_OB); p.oC = (bf16_t*)(ws + O_OC); p.oD = (bf16_t*)(ws + O_OD);
    p.kmean = (float*)(ws + O_KMEAN); p.kc = (bf16_t*)(ws + O_KC); p.vc = (bf16_t*)(ws + O_VC); p.cls_tok = (int*)(ws + O_CLSTOK); p.tokw = (float*)(ws + O_TOKW);
    p.hid = (bf16_t*)(ws + O_HID); p.winT = (bf16_t*)(ws + O_WINT); p.woutT = (bf16_t*)(ws + O_WOUTT); p.wguT = (bf16_t*)(ws + O_WGUT); p.wdT = (bf16_t*)(ws + O_WDT);
    p.cw1T = (bf16_t*)(ws + O_CW1T); p.cw2T = (bf16_t*)(ws + O_CW2T);
    return p;
}
__global__ void __launch_bounds__(NTHR, 2) mk_fwd(KArgs ka) {
    extern __shared__ __attribute__((aligned(16))) float lds[];
    const int bid = blockIdx.x, nb = gridDim.x;
#define w (tidx() >> 6)
    volatile LAS unsigned* xbw = (volatile LAS unsigned*)(lds + LDS_MISC);
    if (threadIdx.x == 0) { xbw[0] = 0u; xbw[1] = 0u; xbw[2] = 0u; xbw[3] = 0u; }
    if (threadIdx.x < 25) {
        const unsigned long long v = (threadIdx.x < 23) ? (unsigned long long)ka.in[threadIdx.x < 23 ? threadIdx.x : 0] : (threadIdx.x == 23 ? (unsigned long long)ka.out : (unsigned long long)ka.ws);
        lds[LDS_TAB + 2 * threadIdx.x] = __uint_as_float((unsigned)v); lds[LDS_TAB + 2 * threadIdx.x + 1] = __uint_as_float((unsigned)(v >> 32));
    }
    __syncthreads();
    XcdBarrier bar = xcd_barrier_post((unsigned*)(ka.ws + O_CTL), xbw);

    { const P p = load_P(lds);
      for (int it = bid; it < N_MOD_ITEMS + N_TR_ITEMS; it += nb) { if (it < N_MOD_ITEMS) phase_mod_item(p, it, lds); else phase_transpose_item(p, it - N_MOD_ITEMS, lds); } }
    xcd_barrier(bar);
    for (int l = 0; l < DEPTH; ++l) {
        { const P p = load_P(lds); for (int it = bid * 8 + w; it < T; it += nb * 8) phase_norm1_wave(p, l, it, lds + w * 2048); }
        xcd_barrier(bar);
        { const P p = load_P(lds);
          DenseSched sc; sc.go.init(T, 5120, nb, bid); sc.A = (const char*)p.hbuf; sc.Bt = (const char*)(p.winT + (size_t)l * NPAD_IN * 2048); sc.a_tile = (size_t)256 * D * 2; sc.b_tile = (size_t)256 * 2048 * 2;
          const pg8::Shape g{2048, D, 2048, 1 << 20};
          const EpiProj E{p.proj};
          pg8::gemm_phase<EpiProj, DenseSched, false>((PG8_LAS unsigned char*)lds, g, sc, E); }
        xcd_barrier(bar);
        { const P p = load_P(lds); for (int it = bid; it < N_KMEAN_ITEMS + N_CMP_ITEMS; it += nb) { if (it < N_KMEAN_ITEMS) phase_kmean_item(p, it, lds); else phase_cmp_item(p, l, it - N_KMEAN_ITEMS, lds); } }
        xcd_barrier(bar);
        { const P p = load_P(lds); for (int it = bid * 2; it < N_NSA_ITEMS; it += nb * 2) phase_nsa_item(p, l, it, lds); }
        { const P p = load_P(lds); for (int it = bid * 8 + w; it < N_ATT_WAVE_ITEMS; it += nb * 8) phase_attn_wave_item(p, l, it, lds + w * 1024, (int*)(lds + 8192) + 32 + 4 * w); }
        xcd_barrier(bar);
        { const P p = load_P(lds); for (int it = bid * 8 + w; it < N_MIXN_WAVE_ITEMS; it += nb * 8) phase_mixnorm_wave(p, it); }
        xcd_barrier(bar);
        { const P p = load_P(lds);
          DenseSched sc; sc.go.init(T, 2048, nb, bid); sc.A = (const char*)p.hbuf; sc.Bt = (const char*)(p.woutT + (size_t)l * 2048 * 2048); sc.a_tile = (size_t)256 * D * 2; sc.b_tile = (size_t)256 * 2048 * 2;
          const pg8::Shape g{2048, D, 2048, 1 << 20};
          const EpiResid E{l == 0 ? p.in[0] : p.xres, p.xres, p.mod + (size_t)l * 4 * 12288 + 2 * D};
          pg8::gemm_phase<EpiResid, DenseSched, false>((PG8_LAS unsigned char*)lds, g, sc, E); }
        xcd_barrier(bar);
        { const P p = load_P(lds); for (int it = bid * 8 + w; it < T; it += nb * 8) phase_norm2_router_wave(p, l, it, lds + w * 2048); }
        xcd_barrier(bar);
        { const P p = load_P(lds); phase_moe1(p, l, bid, nb, lds); }
        xcd_barrier(bar);
        { const P p = load_P(lds); phase_moe2(p, l, bid, nb, lds); }
        xcd_barrier(bar);
    }
    { const P p = load_P(lds);
      const bool tmo = xb_ld(p.ctl + XB_TMO) != 0u;
      for (int it = bid * 8 + w; it < T; it += nb * 8) phase_final_wave(p, it, tmo); }
#undef w
}

extern "C" void kernel_launch(void* const* d_in, const int* in_sizes, int n_in, void* d_out, int out_size, void* d_ws, size_t ws_size, hipStream_t stream) {
    KArgs ka{};
    for (int i = 0; i < 23; ++i) ka.in[i] = (const float*)d_in[i];
    ka.out = (float*)d_out;
    ka.ws = (unsigned char*)d_ws;
    if (WS_NEED > ws_size) { fprintf(stderr, "workspace too small: need %zu have %zu\n", (size_t)WS_NEED, ws_size); return; }
    static int grid = 0;
    if (!grid) {
        int dev = 0, cus = 0, per_cu = 0;
        (void)hipGetDevice(&dev);
        (void)hipDeviceGetAttribute(&cus, hipDeviceAttributeMultiprocessorCount, dev);
        (void)hipFuncSetAttribute((const void*)mk_fwd, hipFuncAttributeMaxDynamicSharedMemorySize, LDS_BYTES);
        (void)hipOccupancyMaxActiveBlocksPerMultiprocessor(&per_cu, (const void*)mk_fwd, NTHR, LDS_BYTES);
        if (per_cu < 1) fprintf(stderr, "occupancy query reports %d blocks per CU\n", per_cu);
        (void)hipGetLastError();
        grid = cus;
    }
    (void)hipMemsetAsync(ka.ws + O_CTL, 0, 1 << 20, stream);
    mk_fwd<<<grid, NTHR, LDS_BYTES, stream>>>(ka);
}
```

```cpp
#include <hip/hip_runtime.h>
#include <stdint.h>
#include <stdio.h>

typedef unsigned short bf16_t;
#define DI __device__ __forceinline__
#define LAS __attribute__((address_space(3)))

constexpr int D = 2048, NBATCH = 4, S = 4096, T = NBATCH * S, DEPTH = 4;
constexpr int NTHR = 512;
constexpr int LDP = 5144;
constexpr int NPAD_IN = 5120;
constexpr int OFF_QA = 0, OFF_KA = 512, OFF_VA = 1024, OFF_QB = 1536, OFF_KB = 2048, OFF_VB = 2176, OFF_QC = 2304, OFF_KC = 2816,
              OFF_VC = 3328, OFF_QD = 3840, OFF_KDC = 4352, OFF_VDC = 4480, OFF_KDS = 4608, OFF_VDS = 4736, OFF_KDW = 4864,
              OFF_VDW = 4992, OFF_GD = 5120;
constexpr int NCLS = 24, CLS_CAP = T, HID_ROWS = T + NCLS * 256;
constexpr float NEGF = -1e30f;
constexpr float EPS = 1e-6f;

struct P {
    const float* in[23];
    float* out;
    unsigned* ctl;
    float* mod;
    float* xres;
    bf16_t* hbuf;
    bf16_t* proj;
    bf16_t* oA;
    float* lseA;
    bf16_t* oB; bf16_t* oC; bf16_t* oD;
    float* kmean;
    bf16_t* kc; bf16_t* vc;
    int* cls_tok;
    float* tokw;
    bf16_t* hid;
    bf16_t* winT;
    bf16_t* woutT;
    bf16_t* wguT;
    bf16_t* wdT;
    bf16_t* cw1T;
    bf16_t* cw2T;
};
constexpr size_t al256(size_t x) { return (x + 255) & ~(size_t)255; }
constexpr size_t O_CTL = 0;
constexpr size_t O_MOD = O_CTL + al256((size_t)1 << 20);
constexpr size_t O_XRES = O_MOD + al256((size_t)4 * 4 * 12288 * 4);
constexpr size_t O_HBUF = O_XRES + al256((size_t)T * D * 4);
constexpr size_t O_PROJ = O_HBUF + al256((size_t)T * D * 2);
constexpr size_t O_OA = O_PROJ + al256((size_t)T * LDP * 2);
constexpr size_t O_LSEA = O_OA + al256((size_t)3 * T * 512 * 2);
constexpr size_t O_OB = O_LSEA + al256((size_t)3 * T * 8 * 4);
constexpr size_t O_OC = O_OB + al256((size_t)T * 512 * 2);
constexpr size_t O_OD = O_OC + al256((size_t)T * 512 * 2);
constexpr size_t O_KMEAN = O_OD + al256((size_t)T * 512 * 2);
constexpr size_t O_KC = O_KMEAN + al256((size_t)4 * 8 * 16 * 64 * 4);
constexpr size_t O_VC = O_KC + al256((size_t)4 * 2 * 256 * 64 * 2);
constexpr size_t O_CLSTOK = O_VC + al256((size_t)4 * 2 * 256 * 64 * 2);
constexpr size_t O_TOKW = O_CLSTOK + al256((size_t)NCLS * CLS_CAP * 4);
constexpr size_t O_HID = O_TOKW + al256((size_t)T * 2 * 4);
constexpr size_t O_WINT = O_HID + al256((size_t)HID_ROWS * 1024 * 2);
constexpr size_t O_WOUTT = O_WINT + al256((size_t)4 * NPAD_IN * 2048 * 2);
constexpr size_t O_WGUT = O_WOUTT + al256((size_t)4 * 2048 * 2048 * 2);
constexpr size_t O_WDT = O_WGUT + al256((size_t)4 * 16 * 1024 * 2048 * 2);
constexpr size_t O_CW1T = O_WDT + al256((size_t)4 * 16 * 2048 * 512 * 2);
constexpr size_t O_CW2T = O_CW1T + al256((size_t)4 * 2 * 128 * 2048 * 2);
constexpr size_t WS_NEED = O_CW2T + al256((size_t)4 * 2 * 64 * 128 * 2);
struct KArgs { const float* in[23]; float* out; unsigned char* ws; };
constexpr int CTL_CNT = 8192;
constexpr int CTL_Q = 8192 + 256;

DI int tidx() { int t = threadIdx.x; asm volatile("" : "+v"(t)); return t; }
DI float bf2f(bf16_t v) { return __uint_as_float(((unsigned)v) << 16); }
DI bf16_t f2bf(float f) { unsigned u = __float_as_uint(f); u += 0x7fffu + ((u >> 16) & 1u); return (bf16_t)(u >> 16); }
DI float wave_sum(float v) { for (int o = 32; o > 0; o >>= 1) v += __shfl_xor(v, o); return v; }
DI float wave_max(float v) { for (int o = 32; o > 0; o >>= 1) v = fmaxf(v, __shfl_xor(v, o)); return v; }
DI void wave_lds_sync() { asm volatile("s_waitcnt lgkmcnt(0)" ::: "memory"); __builtin_amdgcn_wave_barrier(); }
DI float sigmoidf_(float x) { return 1.f / (1.f + __expf(-x)); }
DI float siluf_(float x) { return x / (1.f + __expf(-x)); }
DI float gelu_tanh(float x) { float u = 0.7978845608028654f * (x + 0.044715f * x * x * x); return 0.5f * x * (1.f + tanhf(u)); }
DI int t5_bucket(int d) {
    if (d < 16) return d < 0 ? 0 : d;
    return 16 + (d >= 22) + (d >= 30) + (d >= 40) + (d >= 54) + (d >= 73) + (d >= 99) + (d >= 134) + (d >= 182) + (d >= 246) + (d >= 332) +
           (d >= 450) + (d >= 609) + (d >= 825) + (d >= 1117) + (d >= 1513);
}

DI void phase_mod_item(const P& p, int item, float* lds) {
    const int l = item / 48, jb = item % 48, tid = tidx();
    float* cact = lds;
    float* red = lds + 8192;
    const float* c = p.in[1];
    for (int i = tid; i < 4 * 2048; i += NTHR) cact[i] = siluf_(c[i]);
    __syncthreads();
    const int kq = tid >> 6, lane = tid & 63;
    const float* w = p.in[7] + (size_t)l * 2048 * 12288 + jb * 256 + lane * 4;
    float acc[4][4];
#pragma unroll
    for (int b = 0; b < 4; ++b)
#pragma unroll
        for (int j = 0; j < 4; ++j) acc[b][j] = 0.f;
#pragma unroll 4
    for (int k = kq * 256; k < kq * 256 + 256; ++k) {
        const float4 wv = *(const float4*)(w + (size_t)k * 12288);
#pragma unroll
        for (int b = 0; b < 4; ++b) {
            const float cv = cact[b * 2048 + k];
            acc[b][0] += cv * wv.x; acc[b][1] += cv * wv.y; acc[b][2] += cv * wv.z; acc[b][3] += cv * wv.w;
        }
    }
#pragma unroll
    for (int b = 0; b < 4; ++b)
#pragma unroll
        for (int j = 0; j < 4; ++j) red[(kq * 4 + b) * 256 + lane * 4 + j] = acc[b][j];
    __syncthreads();
    for (int i = tid; i < 1024; i += NTHR) {
        const int b = i >> 8, col = i & 255;
        float v = 0.f;
#pragma unroll
        for (int q = 0; q < 8; ++q) v += red[(q * 4 + b) * 256 + col];
        p.mod[((size_t)l * 4 + b) * 12288 + jb * 256 + col] = v + p.in[8][(size_t)l * 12288 + jb * 256 + col];
    }
    __syncthreads();
}
constexpr int N_MOD_ITEMS = 4 * 48;

DI void transpose_tile(const float* src, int ld, int k0, int n0, int N, bf16_t* dst, int lddst, int dst_row0, int blkstride, const float* kscale, float* lds) {
    float(*tl)[65] = (float(*)[65])lds;
    const int tid = tidx();
#pragma unroll 4
    for (int i = 0; i < 8; ++i) {
        const int e = tid + i * NTHR, kk = e >> 6, nn = e & 63, n = n0 + nn;
        float v = (n < N) ? src[(size_t)(k0 + kk) * ld + n] : 0.f;
        if (kscale) v *= kscale[k0 + kk];
        tl[kk][nn] = v;
    }
    __syncthreads();
#pragma unroll 4
    for (int i = 0; i < 8; ++i) {
        const int e = tid + i * NTHR, nn = e >> 6, kk = e & 63, n = n0 + nn;
        if (n < N) dst[(size_t)(dst_row0 + (nn >> 5) * blkstride + (nn & 31)) * lddst + k0 + kk] = f2bf(tl[kk][nn]);
    }
    __syncthreads();
}
constexpr int TR0 = 4 * 32 * 80, TR1 = 4 * 32 * 32, TR2 = 4 * 16 * 32 * 8, TR3 = TR2, TR4 = 4 * 16 * 8 * 32, TR5 = 4 * 32 * 2, TR6 = TR5, TR7 = 4 * 2, TR8 = TR7;
constexpr int N_TR_ITEMS = TR0 + TR1 + TR2 + TR3 + TR4 + TR5 + TR6 + TR7 + TR8;
DI void phase_transpose_item(const P& p, int item, float* lds) {
    int i = item;
    if (i < TR0) { const int l = i / (32 * 80), r = i % (32 * 80), kt = r / 80, nt = r % 80;
        transpose_tile(p.in[9] + (size_t)l * 2048 * 5144, 5144, kt * 64, nt * 64, 5144, p.winT + (size_t)l * NPAD_IN * 2048, 2048, nt * 64, 32, nullptr, lds); return; }
    i -= TR0;
    if (i < TR1) { const int l = i / 1024, r = i % 1024, kt = r / 32, nt = r % 32;
        transpose_tile(p.in[18] + (size_t)l * 2048 * 2048, 2048, kt * 64, nt * 64, 2048, p.woutT + (size_t)l * 2048 * 2048, 2048, nt * 64, 32, p.in[17] + (size_t)l * 2048, lds); return; }
    i -= TR1;
    if (i < TR2 + TR3) { const int up = i >= TR2; if (up) i -= TR2; const int le = i / 256, r = i % 256, kt = r / 8, nt = r % 8;
        transpose_tile(p.in[up ? 20 : 19] + (size_t)le * 2048 * 512, 512, kt * 64, nt * 64, 512, p.wguT + (size_t)le * 1024 * 2048, 2048, (nt >> 1) * 256 + (nt & 1) * 64 + (up ? 128 : 0), 32, nullptr, lds); return; }
    i -= TR2 + TR3;
    if (i < TR4) { const int le = i / 256, r = i % 256, kt = r / 32, nt = r % 32;
        transpose_tile(p.in[21] + (size_t)le * 512 * 2048, 2048, kt * 64, nt * 64, 2048, p.wdT + (size_t)le * 2048 * 512, 512, nt * 64, 32, nullptr, lds); return; }
    i -= TR4;
    if (i < TR5 + TR6) { const int v = i >= TR5; if (v) i -= TR5; const int l = i / 64, r = i % 64, kt = r / 2, nt = r % 2;
        transpose_tile(p.in[v ? 14 : 12] + (size_t)l * 2048 * 128, 128, kt * 64, nt * 64, 128, p.cw1T + (size_t)(l * 2 + v) * 128 * 2048, 2048, nt * 64, 32, nullptr, lds); return; }
    i -= TR5 + TR6;
    { const int v = i >= TR7; if (v) i -= TR7; const int l = i / 2, kt = i % 2;
        transpose_tile(p.in[v ? 15 : 13] + (size_t)l * 128 * 64, 64, kt * 64, 0, 64, p.cw2T + (size_t)(l * 2 + v) * 64 * 128, 128, 0, 32, nullptr, lds); }
}

DI void norm_mod_row(const P& p, int l, int row, int which, float (&hv)[32]) {
    const int lane = tidx() & 63, b = row / S;
    const float* x = ((l == 0 && which == 0) ? p.in[0] : p.xres) + (size_t)row * D;
    float ss = 0.f;
#pragma unroll
    for (int i = 0; i < 8; ++i) {
        const float4 v = *(const float4*)(x + i * 256 + lane * 4);
        hv[i * 4 + 0] = v.x; hv[i * 4 + 1] = v.y; hv[i * 4 + 2] = v.z; hv[i * 4 + 3] = v.w;
        ss += v.x * v.x + v.y * v.y + v.z * v.z + v.w * v.w;
    }
    ss = wave_sum(ss);
    const float r = rsqrtf(ss * (1.f / D) + EPS);
    const float* g = p.in[which ? 6 : 5] + (size_t)l * D;
    const float* sh = p.mod + ((size_t)l * 4 + b) * 12288 + (which ? 3 * D : 0);
    const float* sc = sh + D;
    bf16_t* h = p.hbuf + (size_t)row * D;
#pragma unroll
    for (int i = 0; i < 8; ++i) {
        const int col = i * 256 + lane * 4;
        const float4 gv = *(const float4*)(g + col), shv = *(const float4*)(sh + col), scv = *(const float4*)(sc + col);
        hv[i * 4 + 0] = hv[i * 4 + 0] * r * gv.x * (1.f + scv.x) + shv.x;
        hv[i * 4 + 1] = hv[i * 4 + 1] * r * gv.y * (1.f + scv.y) + shv.y;
        hv[i * 4 + 2] = hv[i * 4 + 2] * r * gv.z * (1.f + scv.z) + shv.z;
        hv[i * 4 + 3] = hv[i * 4 + 3] * r * gv.w * (1.f + scv.w) + shv.w;
        uint2 pk;
        pk.x = (unsigned)f2bf(hv[i * 4 + 0]) | ((unsigned)f2bf(hv[i * 4 + 1]) << 16);
        pk.y = (unsigned)f2bf(hv[i * 4 + 2]) | ((unsigned)f2bf(hv[i * 4 + 3]) << 16);
        *(uint2*)(h + col) = pk;
    }
}
DI void phase_norm1_wave(const P& p, int l, int row, float* hrow  ) {
    float hv[32];
    norm_mod_row(p, l, row, 0, hv);
    const int lane = tidx() & 63;
    wave_lds_sync();
#pragma unroll
    for (int i = 0; i < 8; ++i) { float4 v; v.x = hv[i * 4]; v.y = hv[i * 4 + 1]; v.z = hv[i * 4 + 2]; v.w = hv[i * 4 + 3]; *(float4*)(hrow + i * 256 + lane * 4) = v; }
    wave_lds_sync();
    const int e = lane & 31, half = lane >> 5;
    const float* wp = p.in[9] + (size_t)l * 2048 * 5144 + (size_t)half * 1024 * 5144 + 5120 + (e < 24 ? e : 0);
    const float* hp = hrow + half * 1024;
    float a0 = 0.f, a1 = 0.f, a2 = 0.f, a3 = 0.f;
#pragma unroll 2
    for (int c = 0; c < 1024; c += 4) {
        a0 += hp[c] * wp[(size_t)(c + 0) * 5144]; a1 += hp[c + 1] * wp[(size_t)(c + 1) * 5144]; a2 += hp[c + 2] * wp[(size_t)(c + 2) * 5144]; a3 += hp[c + 3] * wp[(size_t)(c + 3) * 5144];
    }
    float acc = (a0 + a1) + (a2 + a3);
    acc += __shfl_xor(acc, 32);
    if (lane < 24) p.proj[(size_t)row * LDP + OFF_GD + lane] = f2bf(acc);
}

DI void phase_norm2_router_wave(const P& p, int l, int row, float* hrow  ) {
    float hv[32];
    norm_mod_row(p, l, row, 1, hv);
    const int lane = tidx() & 63;
    const float* rw = p.in[3];
    wave_lds_sync();
#pragma unroll
    for (int i = 0; i < 8; ++i) { float4 v; v.x = hv[i * 4]; v.y = hv[i * 4 + 1]; v.z = hv[i * 4 + 2]; v.w = hv[i * 4 + 3]; *(float4*)(hrow + i * 256 + lane * 4) = v; }
    wave_lds_sync();
    float lg[16];
    {
        const int e = lane & 15, part = lane >> 4;
        float a0 = 0.f, a1 = 0.f, a2 = 0.f, a3 = 0.f;
        const float* wp = rw + (size_t)part * 512 * 16 + e;
        const float* hp = hrow + part * 512;
#pragma unroll 2
        for (int c = 0; c < 512; c += 4) {
            a0 += hp[c] * wp[(c + 0) * 16]; a1 += hp[c + 1] * wp[(c + 1) * 16]; a2 += hp[c + 2] * wp[(c + 2) * 16]; a3 += hp[c + 3] * wp[(c + 3) * 16];
        }
        float acc = (a0 + a1) + (a2 + a3);
        acc += __shfl_xor(acc, 16); acc += __shfl_xor(acc, 32);
#pragma unroll
        for (int k = 0; k < 16; ++k) lg[k] = __shfl(acc, k);
    }
    if (lane == 0) {
        float aff[16], sc[16];
#pragma unroll
        for (int e = 0; e < 16; ++e) { aff[e] = sigmoidf_(lg[e]); sc[e] = aff[e] + p.in[4][e]; }
        int bg = 0; float bgs = -3e38f;
#pragma unroll
        for (int g = 0; g < 4; ++g) {
            float m1 = -3e38f, m2 = -3e38f;
#pragma unroll
            for (int j = 0; j < 4; ++j) { const float v = sc[g * 4 + j]; if (v > m1) { m2 = m1; m1 = v; } else if (v > m2) m2 = v; }
            const float gs = m1 + m2;
            if (gs > bgs) { bgs = gs; bg = g; }
        }
        float s4[4], a4[4];
#pragma unroll
        for (int g = 0; g < 4; ++g)
#pragma unroll
            for (int j = 0; j < 4; ++j) if (g == bg) { s4[j] = sc[g * 4 + j]; a4[j] = aff[g * 4 + j]; }
        int i1 = 0; float b1 = s4[0];
#pragma unroll
        for (int j = 1; j < 4; ++j) if (s4[j] > b1) { b1 = s4[j]; i1 = j; }
        int i2 = -1; float b2 = -3e38f;
#pragma unroll
        for (int j = 0; j < 4; ++j) if (j != i1 && s4[j] > b2) { b2 = s4[j]; i2 = j; }
        float w1 = 0.f, w2 = 0.f;
#pragma unroll
        for (int j = 0; j < 4; ++j) { if (j == i1) w1 = a4[j]; if (j == i2) w2 = a4[j]; }
        const float inv = 1.f / (w1 + w2);
        w1 *= inv; w2 *= inv;
        const int a = i1 < i2 ? i1 : i2, bb = i1 < i2 ? i2 : i1;
        const float wa = i1 < i2 ? w1 : w2, wb = i1 < i2 ? w2 : w1;
        const int pidx = (a == 0) ? (bb - 1) : (a == 1 ? (bb + 1) : 5);
        const int cls = bg * 6 + pidx;
        const unsigned pos = atomicAdd(p.ctl + CTL_CNT + l * 32 + cls, 1u);
        p.cls_tok[(size_t)cls * CLS_CAP + pos] = row;
        p.tokw[(size_t)row * 2 + 0] = wa; p.tokw[(size_t)row * 2 + 1] = wb;
    }
}

DI void cls_experts(int cls, int& ea, int& eb) {
    const int g = cls / 6, pi = cls % 6;
    const int a = pi < 3 ? 0 : (pi < 5 ? 1 : 2);
    const int b = pi < 3 ? pi + 1 : (pi < 5 ? pi - 1 : 3);
    ea = g * 4 + a; eb = g * 4 + b;
}
DI bool cls_find(unsigned* cnt, int ft, int& cls, int& mt, int& slot_base) {
    int base = 0;
    for (int c = 0; c < NCLS; ++c) {
        const int nt = ((int)__hip_atomic_load(cnt + c, __ATOMIC_RELAXED, __HIP_MEMORY_SCOPE_AGENT) + 255) >> 8;
        if (ft < base + nt) { cls = c; mt = ft - base; slot_base = base * 256; return true; }
        base += nt;
    }
    return false;
}
DI int cls_total_tiles(unsigned* cnt) { int base = 0; for (int c = 0; c < NCLS; ++c) base += ((int)__hip_atomic_load(cnt + c, __ATOMIC_RELAXED, __HIP_MEMORY_SCOPE_AGENT) + 255) >> 8; return base; }

constexpr int N_KMEAN_ITEMS = 4 * 8 * 16;
DI void phase_kmean_item(const P& p, int item, float* lds) {
    const int b = item / 128, h = (item / 16) % 8, blk = item % 16, tid = tidx(), d = tid & 63, part = tid >> 6;
    const bf16_t* k = p.proj + ((size_t)b * S + blk * 256 + part * 32) * LDP + OFF_KC + h * 64 + d;
    float s = 0.f;
    for (int i = 0; i < 32; ++i) s += bf2f(k[(size_t)i * LDP]);
    lds[tid] = s;
    __syncthreads();
    if (tid < 64) { float v = 0.f; for (int q = 0; q < 8; ++q) v += lds[tid + 64 * q]; p.kmean[(size_t)item * 64 + tid] = v * (1.f / 256.f); }
    __syncthreads();
}
constexpr int N_CMP_ITEMS = 2 * 4 * 2 * 255;
DI void phase_cmp_item(const P& p, int l, int item, float* lds) {
    const int v = item / (4 * 2 * 255), r = item % (4 * 2 * 255), b = r / 510, hk = (r / 255) % 2, n = r % 255, tid = tidx();
    float* in = lds;
    float* part = lds + 2048;
    float* hd = lds + 2560;
    const float* pe = p.in[v ? 11 : 10] + (size_t)l * 2048;
    const bf16_t* src = p.proj + ((size_t)b * S + 16 * n) * LDP + (v ? OFF_VDC : OFF_KDC) + hk * 64;
    for (int i = tid; i < 2048; i += NTHR) in[i] = bf2f(src[(size_t)(i >> 6) * LDP + (i & 63)]) + pe[i];
    __syncthreads();
    const float* w1 = p.in[v ? 14 : 12] + (size_t)l * 2048 * 128;
    { const int j = tid & 127, q = tid >> 7; float s = 0.f;
      for (int i = q * 512; i < q * 512 + 512; ++i) s += in[i] * w1[(size_t)i * 128 + j];
      part[tid] = s; }
    __syncthreads();
    if (tid < 128) hd[tid] = gelu_tanh(part[tid] + part[tid + 128] + part[tid + 256] + part[tid + 384]);
    __syncthreads();
    const float* w2 = p.in[v ? 15 : 13] + (size_t)l * 128 * 64;
    { const int d = tid & 63, q = tid >> 6; float s = 0.f;
      for (int j = q * 16; j < q * 16 + 16; ++j) s += hd[j] * w2[j * 64 + d];
      part[tid] = s; }
    __syncthreads();
    if (tid < 64) { float o = 0.f; for (int q = 0; q < 8; ++q) o += part[tid + 64 * q]; (v ? p.vc : p.kc)[(((size_t)b * 2 + hk) * 256 + n) * 64 + tid] = f2bf(o); }
    __syncthreads();
}


template <class C>
DI float attn_wave(const bf16_t* qrow, const C& cand, int ncand, bool has_sink, float sink, float* sl, float& lse_out) {
    const int lane = tidx() & 63;
    float q[64];
#pragma unroll
    for (int i = 0; i < 8; ++i) {
        const uint4 v = *(const uint4*)(qrow + i * 8);
        const unsigned u[4] = {v.x, v.y, v.z, v.w};
#pragma unroll
        for (int j = 0; j < 4; ++j) { q[i * 8 + 2 * j] = __uint_as_float(u[j] << 16); q[i * 8 + 2 * j + 1] = __uint_as_float(u[j] & 0xffff0000u); }
    }
    float mx = NEGF;
    for (int c0 = 0; c0 < ncand; c0 += 64) {
        const int c = c0 + lane;
        float s = NEGF;
        if (c < ncand) {
            const bf16_t *kr, *vr; float bias;
            if (cand.get(c, kr, vr, bias)) {
                float dot = 0.f;
#pragma unroll
                for (int i = 0; i < 8; ++i) {
                    const uint4 v = *(const uint4*)(kr + i * 8);
                    const unsigned u[4] = {v.x, v.y, v.z, v.w};
#pragma unroll
                    for (int j = 0; j < 4; ++j) { dot += q[i * 8 + 2 * j] * __uint_as_float(u[j] << 16); dot += q[i * 8 + 2 * j + 1] * __uint_as_float(u[j] & 0xffff0000u); }
                }
                s = dot * 0.125f + bias;
            }
            sl[c] = s;
        }
        mx = fmaxf(mx, s);
    }
    mx = wave_max(mx);
    if (has_sink) mx = fmaxf(mx, sink);
    float sum = 0.f;
    for (int c0 = 0; c0 < ncand; c0 += 64) {
        const int c = c0 + lane;
        if (c < ncand) { const float s = sl[c]; const float e = (s > -1e29f) ? __expf(s - mx) : 0.f; sl[c] = e; sum += e; }
    }
    sum = wave_sum(sum);
    if (has_sink) sum += __expf(sink - mx);
    sum = fmaxf(sum, 1.17549435e-38f);
    lse_out = mx + logf(sum);
    const float inv = 1.f / sum;
    for (int c0 = 0; c0 < ncand; c0 += 64) { const int c = c0 + lane; if (c < ncand) sl[c] *= inv; }
    wave_lds_sync();
    float o = 0.f;
    for (int c = 0; c < ncand; ++c) {
        const float pr = sl[c];
        if (pr != 0.f) { const bf16_t *kr, *vr; float bias; cand.get(c, kr, vr, bias); o += pr * bf2f(vr[lane]); }
    }
    return o;
}

struct BandCand {
    const bf16_t *kb, *vb; int t, r; const float* tab;
    DI bool get(int c, const bf16_t*& kr, const bf16_t*& vr, float& bias) const {
        const int kp = t - c * r; if (kp < 0) return false;
        kr = kb + (size_t)kp * LDP; vr = vb + (size_t)kp * LDP; bias = tab[t5_bucket(c * r) * 32]; return true;
    }
};
struct MobaCand {
    const bf16_t *kb, *vb; int t; const int* sel; const float* tab;
    DI bool get(int c, const bf16_t*& kr, const bf16_t*& vr, float& bias) const {
        const int blk = sel[c >> 8], j = c & 255;
        if (blk < 0) return false;
        const int kp = blk * 256 + j; if (kp > t) return false;
        kr = kb + (size_t)kp * LDP; vr = vb + (size_t)kp * LDP; bias = tab[t5_bucket(t - kp) * 32]; return true;
    }
};
struct CmpCand {
    const bf16_t *kc, *vc; int t;
    DI bool get(int c, const bf16_t*& kr, const bf16_t*& vr, float& bias) const {
        if (16 * c + 31 > t) return false;
        kr = kc + (size_t)c * 64; vr = vc + (size_t)c * 64; bias = 0.f; return true;
    }
};
struct SlcCand {
    const bf16_t *kb, *vb; int t; const int* sel; const float* tab;
    DI bool get(int c, const bf16_t*& kr, const bf16_t*& vr, float& bias) const {
        const int blk = sel[c >> 6]; if (blk < 0) return false;
        const int kp = blk * 64 + (c & 63); if (kp > t) return false;
        kr = kb + (size_t)kp * LDP; vr = vb + (size_t)kp * LDP; bias = tab[t5_bucket(t - kp) * 32]; return true;
    }
};

constexpr int N_ATT_WAVE_ITEMS = 3 * T * 8 + T * 8 + T * 8;
DI void phase_attn_wave_item(const P& p, int l, int item, float* sl, int* selw) {
    const int lane = tidx() & 63;
    const float* relb = p.in[2];
    if (item < 3 * T * 8) {
        const int cfg = item / (T * 8), rem = item % (T * 8), row = rem >> 3, h = rem & 7, b = row / S, t = row % S;
        const int r = cfg == 0 ? 1 : (cfg == 1 ? 4 : 16);
        BandCand cd{p.proj + (size_t)b * S * LDP + OFF_KA + h * 64, p.proj + (size_t)b * S * LDP + OFF_VA + h * 64, t, r, relb + 0 + h};
        float lse;
        const float o = attn_wave(p.proj + (size_t)row * LDP + OFF_QA + h * 64, cd, 129, false, 0.f, sl, lse);
        p.oA[((size_t)cfg * T + row) * 512 + h * 64 + lane] = f2bf(o);
        if (lane == 0) p.lseA[((size_t)cfg * T + row) * 8 + h] = lse;
        return;
    }
    item -= 3 * T * 8;
    if (item < T * 8) {
        const int row = item >> 3, hq = item & 7, kvh = hq >> 2, b = row / S, t = row % S;
        BandCand cd{p.proj + (size_t)b * S * LDP + OFF_KB + kvh * 64, p.proj + (size_t)b * S * LDP + OFF_VB + kvh * 64, t, 1, relb + 8 + hq};
        float lse;
        const float o = attn_wave(p.proj + (size_t)row * LDP + OFF_QB + hq * 64, cd, 128, true, p.in[16][l * 8 + hq], sl, lse);
        p.oB[(size_t)row * 512 + hq * 64 + lane] = f2bf(o);
        return;
    }
    item -= T * 8;
    {
        const int row = item >> 3, h = item & 7, b = row / S, t = row % S, cur = t >> 8;
        const bf16_t* qrow = p.proj + (size_t)row * LDP + OFF_QC + h * 64;
        float gate = NEGF;
        if (lane < cur) {
            const float* km = p.kmean + (((size_t)b * 8 + h) * 16 + lane) * 64;
            float dot = 0.f;
            for (int d = 0; d < 64; ++d) dot += bf2f(qrow[d]) * km[d];
            gate = dot;
        }
        int s0, s1, s2;
        { float v = gate; int idx = lane;
          for (int o = 32; o > 0; o >>= 1) { const float ov = __shfl_xor(v, o); const int oi = __shfl_xor(idx, o); if (ov > v || (ov == v && oi < idx)) { v = ov; idx = oi; } }
          s0 = (v > -1e29f) ? idx : -1; if (lane == idx) gate = -3e38f; }
        { float v = gate; int idx = lane;
          for (int o = 32; o > 0; o >>= 1) { const float ov = __shfl_xor(v, o); const int oi = __shfl_xor(idx, o); if (ov > v || (ov == v && oi < idx)) { v = ov; idx = oi; } }
          s1 = (v > -1e29f) ? idx : -1; if (lane == idx) gate = -3e38f; }
        { float v = gate; int idx = lane;
          for (int o = 32; o > 0; o >>= 1) { const float ov = __shfl_xor(v, o); const int oi = __shfl_xor(idx, o); if (ov > v || (ov == v && oi < idx)) { v = ov; idx = oi; } }
          s2 = (v > -1e29f) ? idx : -1; if (lane == idx) gate = -3e38f; }
        if (lane == 0) { selw[0] = s0; selw[1] = s1; selw[2] = s2; selw[3] = cur; }
        wave_lds_sync();
        MobaCand cd{p.proj + (size_t)b * S * LDP + OFF_KC + h * 64, p.proj + (size_t)b * S * LDP + OFF_VC + h * 64, t, selw, relb + 16 + h};
        float lse;
        const float o = attn_wave(qrow, cd, 1024, false, 0.f, sl, lse);
        p.oC[(size_t)row * 512 + h * 64 + lane] = f2bf(o);
    }
}
constexpr int N_NSA_ITEMS = 4 * 2 * S;
DI void phase_nsa_item(const P& p, int l, int item0, float* lds) {
    const int tid = tidx(), grp = tid >> 8, g = (tid >> 6) & 3, lane = tid & 63;
    const int item = item0 + grp;
    const int b = item / (2 * S), hk = (item / S) % 2, t = item % S, hq = hk * 4 + g;
    const int row = b * S + t, cur = t >> 6;
    float* gl = lds + grp * 4096;
    float* sl = gl + g * 1024;
    int* sel = (int*)(lds + 8192) + grp * 16;
    const bf16_t* qrow = p.proj + (size_t)row * LDP + OFF_QD + hq * 64;
    const float* relb = p.in[2];
    float lse;
    CmpCand cc{p.kc + ((size_t)b * 2 + hk) * 256 * 64, p.vc + ((size_t)b * 2 + hk) * 256 * 64, t};
    const float o_cmp = attn_wave(qrow, cc, 255, false, 0.f, sl, lse);
    __syncthreads();
    if (g == 0) {
        const int j = lane;
        float imp = 0.f;
        for (int n = 4 * j - 1; n <= 4 * j + 3; ++n)
            if (n >= 0 && n < 255) imp += gl[n] + gl[1024 + n] + gl[2048 + n] + gl[3072 + n];
        float val = (j == 0 || j == cur || j == cur - 1) ? 1e30f : (j <= cur ? imp : NEGF);
        for (int k = 0; k < 16; ++k) {
            float v = val; int idx = lane;
            for (int o = 32; o > 0; o >>= 1) { const float ov = __shfl_xor(v, o); const int oi = __shfl_xor(idx, o); if (ov > v || (ov == v && oi < idx)) { v = ov; idx = oi; } }
            if (lane == 0) sel[k] = (v > -1e29f) ? idx : -1;
            if (lane == idx) val = -3e38f;
        }
    }
    __syncthreads();
    SlcCand sc{p.proj + (size_t)b * S * LDP + OFF_KDS + hk * 64, p.proj + (size_t)b * S * LDP + OFF_VDS + hk * 64, t, sel, relb + 24 + hq};
    const float o_slc = attn_wave(qrow, sc, 1024, false, 0.f, sl, lse);
    BandCand wc{p.proj + (size_t)b * S * LDP + OFF_KDW + hk * 64, p.proj + (size_t)b * S * LDP + OFF_VDW + hk * 64, t, 1, relb + 24 + hq};
    const float o_win = attn_wave(qrow, wc, 512, false, 0.f, sl, lse);
    const bf16_t* gd = p.proj + (size_t)row * LDP + OFF_GD + hq * 3;
    const float g0 = sigmoidf_(bf2f(gd[0])), g1 = sigmoidf_(bf2f(gd[1])), g2 = sigmoidf_(bf2f(gd[2]));
    p.oD[(size_t)row * 512 + hq * 64 + lane] = f2bf(g0 * o_cmp + g1 * o_slc + g2 * o_win);
    __syncthreads();
}

constexpr int N_MIXN_WAVE_ITEMS = T * 4;
DI void phase_mixnorm_wave(const P& p, int item) {
    const int row = item >> 2, grp = item & 3, lane = tidx() & 63, h = lane >> 3;
    float v[8];
    if (grp == 0) {
        const float l0 = p.lseA[((size_t)0 * T + row) * 8 + h], l1 = p.lseA[((size_t)1 * T + row) * 8 + h], l2 = p.lseA[((size_t)2 * T + row) * 8 + h];
        const float m = fmaxf(l0, fmaxf(l1, l2));
        float w0 = __expf(l0 - m), w1 = __expf(l1 - m), w2 = __expf(l2 - m);
        const float inv = 1.f / (w0 + w1 + w2); w0 *= inv; w1 *= inv; w2 *= inv;
        const uint4 a = *(const uint4*)(p.oA + ((size_t)0 * T + row) * 512 + lane * 8);
        const uint4 bq = *(const uint4*)(p.oA + ((size_t)1 * T + row) * 512 + lane * 8);
        const uint4 c = *(const uint4*)(p.oA + ((size_t)2 * T + row) * 512 + lane * 8);
        const unsigned au[4] = {a.x, a.y, a.z, a.w}, bu[4] = {bq.x, bq.y, bq.z, bq.w}, cu[4] = {c.x, c.y, c.z, c.w};
#pragma unroll
        for (int j = 0; j < 4; ++j) {
            v[2 * j] = w0 * __uint_as_float(au[j] << 16) + w1 * __uint_as_float(bu[j] << 16) + w2 * __uint_as_float(cu[j] << 16);
            v[2 * j + 1] = w0 * __uint_as_float(au[j] & 0xffff0000u) + w1 * __uint_as_float(bu[j] & 0xffff0000u) + w2 * __uint_as_float(cu[j] & 0xffff0000u);
        }
    } else {
        const bf16_t* src = (grp == 1 ? p.oB : (grp == 2 ? p.oC : p.oD)) + (size_t)row * 512 + lane * 8;
        const uint4 a = *(const uint4*)src;
        const unsigned au[4] = {a.x, a.y, a.z, a.w};
#pragma unroll
        for (int j = 0; j < 4; ++j) { v[2 * j] = __uint_as_float(au[j] << 16); v[2 * j + 1] = __uint_as_float(au[j] & 0xffff0000u); }
    }
    float ss = 0.f;
#pragma unroll
    for (int j = 0; j < 8; ++j) ss += v[j] * v[j];
    ss = wave_sum(ss);
    const float r = rsqrtf(ss * (1.f / 512.f) + EPS);
    uint4 o;
    o.x = (unsigned)f2bf(v[0] * r) | ((unsigned)f2bf(v[1] * r) << 16);
    o.y = (unsigned)f2bf(v[2] * r) | ((unsigned)f2bf(v[3] * r) << 16);
    o.z = (unsigned)f2bf(v[4] * r) | ((unsigned)f2bf(v[5] * r) << 16);
    o.w = (unsigned)f2bf(v[6] * r) | ((unsigned)f2bf(v[7] * r) << 16);
    *(uint4*)(p.hbuf + (size_t)row * D + grp * 512 + lane * 8) = o;
}

DI void phase_final_wave(const P& p, int row, bool poison) {
    const int lane = tidx() & 63;
    const float* x = p.xres + (size_t)row * D;
    float4 v[8]; float ss = 0.f;
#pragma unroll
    for (int i = 0; i < 8; ++i) { v[i] = *(const float4*)(x + i * 256 + lane * 4); ss += v[i].x * v[i].x + v[i].y * v[i].y + v[i].z * v[i].z + v[i].w * v[i].w; }
    ss = wave_sum(ss);
    const float r = rsqrtf(ss * (1.f / D) + EPS);
#pragma unroll
    for (int i = 0; i < 8; ++i) {
        const float4 g = *(const float4*)(p.in[22] + i * 256 + lane * 4);
        float4 o; o.x = v[i].x * r * g.x; o.y = v[i].y * r * g.y; o.z = v[i].z * r * g.z; o.w = v[i].w * r * g.w;
        if (poison) { o.x = o.y = o.z = o.w = __uint_as_float(0x7fc00000u); }
        *(float4*)(p.out + (size_t)row * D + i * 256 + lane * 4) = o;
    }
}

#define XB_TMO      128
#define XB_XCNT(j)  (256  + 64 * (j))
#define XB_XSUB(j)  (1280 + 64 * (j))
#define XB_XGEN(j)  (2304 + 64 * (j))
#define XB_TOP      3328
#define XB_TOPGEN   3392
#define XCD_BAR_WORDS 3456
#define XB_SPIN_CAP (1u << 21)

__device__ __forceinline__ unsigned xb_ld(unsigned* p)              { return __hip_atomic_load(p, __ATOMIC_RELAXED, __HIP_MEMORY_SCOPE_AGENT); }
__device__ __forceinline__ unsigned xb_add(unsigned* p, unsigned v) { return __hip_atomic_fetch_add(p, v, __ATOMIC_RELAXED, __HIP_MEMORY_SCOPE_AGENT); }
__device__ __forceinline__ unsigned xb_xcc_id() { return (unsigned)__builtin_amdgcn_s_getreg((3 << 11) | 20) & 0xFu; }
#define XB_SPIN(cond, bar) do { unsigned _sp = 0; while (cond) { __builtin_amdgcn_s_sleep(1); \
    if ((++_sp & 255u) == 0u) { if (xb_ld(&(bar)[XB_TMO])) break; if (_sp > XB_SPIN_CAP) { atomicAdd(&(bar)[XB_TMO], 1u); break; } } } } while (0)

struct XcdBarrier { unsigned* bar; unsigned x; volatile LAS unsigned* st; };

__device__ __forceinline__ XcdBarrier xcd_barrier_post(unsigned* bar, volatile LAS unsigned* st) {
    XcdBarrier b; b.bar = bar; b.x = xb_xcc_id(); b.st = st;
    if (threadIdx.x == 0) (void)xb_add(&bar[XB_XCNT(b.x)], 1u);
    return b;
}
__device__ __forceinline__ void xcd_barrier_complete(unsigned* bar, unsigned x, unsigned& nloc, unsigned& nx) {
    const unsigned G = gridDim.x * gridDim.y * gridDim.z;
    unsigned sum, cnt, mine, sp = 0u;
    for (;;) {
        sum = 0u; cnt = 0u; mine = 0u;
#pragma unroll
        for (unsigned j = 0; j < 16; ++j) { const unsigned c = xb_ld(&bar[XB_XCNT(j)]); sum += c; cnt += (c > 0u) ? 1u : 0u; mine = (j == x) ? c : mine; }
        if (sum == G) break;
        __builtin_amdgcn_s_sleep(1);
        if ((++sp & 255u) == 0u) { if (xb_ld(&bar[XB_TMO])) break; if (sp > XB_SPIN_CAP) { atomicAdd(&bar[XB_TMO], 1u); break; } }
    }
    nloc = mine > 0u ? mine : 1u; nx = cnt > 0u ? cnt : 1u;
}
__device__ __forceinline__ void xcd_barrier(const XcdBarrier& b) {
    asm volatile("s_waitcnt vmcnt(0)" ::: "memory");
    __syncthreads();
    if (threadIdx.x == 0) {
        unsigned* bar = b.bar;
        __builtin_amdgcn_s_waitcnt(0);
        unsigned nloc = b.st[0], nx = b.st[1];
        if (nloc == 0u) { xcd_barrier_complete(bar, b.x, nloc, nx); b.st[0] = nloc; b.st[1] = nx; }
        const unsigned old = xb_add(&bar[XB_XSUB(b.x)], 1u);
        const unsigned gen = old / nloc;
        if (old + 1u == (gen + 1u) * nloc) {
            __builtin_amdgcn_fence(__ATOMIC_RELEASE, "agent");
            asm volatile("s_waitcnt vmcnt(0)" ::: "memory");
            const unsigned og = xb_add(&bar[XB_TOP], 1u);
            const unsigned tg = og / nx;
            if (og + 1u == (tg + 1u) * nx) xb_add(&bar[XB_TOPGEN], 1u);
            else XB_SPIN(xb_ld(&bar[XB_TOPGEN]) == tg, bar);
            __builtin_amdgcn_fence(__ATOMIC_ACQUIRE, "agent");
            xb_add(&bar[XB_XGEN(b.x)], 1u);
            asm volatile("s_waitcnt vmcnt(0)" ::: "memory");
        } else {
            XB_SPIN(xb_ld(&bar[XB_XGEN(b.x)]) == gen, bar);
            __builtin_amdgcn_fence(__ATOMIC_ACQUIRE, "agent");
            asm volatile("s_waitcnt vmcnt(0)" ::: "memory");
        }
    }
    __syncthreads();
}

namespace fa {
typedef short bf16x8 __attribute__((ext_vector_type(8)));
typedef short s16x4 __attribute__((ext_vector_type(4)));
typedef float f32x16 __attribute__((ext_vector_type(16)));
typedef __bf16 bf16x2_t __attribute__((ext_vector_type(2)));
typedef float f32x2_t __attribute__((ext_vector_type(2)));
constexpr int KP = 144, TILEB = 64 * KP;
constexpr int BT = 768;
constexpr int L_K = 0, L_V = 2 * TILEB, L_BT = 4 * TILEB, L_B32 = L_BT + 4 * BT * 4, L_IMPA = L_B32 + 512, L_IMPB = L_IMPA + 64 * 64 * 4, L_SEL = L_IMPB + 64 * 64 * 4, L_TICKET = L_SEL + 512, L_OACC = L_TICKET + 512, L_END = L_OACC + 16 * 512 * 4;
static_assert(L_END <= 131072, "attention LDS map");
constexpr float LOG2E = 1.4426950408889634f, SC2 = 0.125f * LOG2E, LN2 = 0.6931471805599453f;
#define FA_MFMA(a, b, c) __builtin_amdgcn_mfma_f32_32x32x16_bf16((a), (b), (c), 0, 0, 0)
DI unsigned cvtpk(float lo, float hi) { f32x2_t v = {lo, hi}; bf16x2_t b = __builtin_convertvector(v, bf16x2_t); return __builtin_bit_cast(unsigned, b); }
DI s16x4 vtr(const LAS char* p) { return __builtin_bit_cast(s16x4, __builtin_amdgcn_ds_read_tr16_b64_v4i16((LAS s16x4*)p)); }
DI float xhalf(float v) { return __shfl_xor(v, 32); }
DI float quad_sum(float v) {
    v += __builtin_bit_cast(float, __builtin_amdgcn_update_dpp(0, __builtin_bit_cast(int, v), 0xB1, 0xF, 0xF, true));
    v += __builtin_bit_cast(float, __builtin_amdgcn_update_dpp(0, __builtin_bit_cast(int, v), 0x4E, 0xF, 0xF, true));
    return v;
}

struct Pass {
    const bf16_t* kb; const bf16_t* vb;
    int kpitch, kstride, nkeys;
    int t_lo, t_hi;
    int W;
    int msh;
};
typedef unsigned u32x4 __attribute__((ext_vector_type(4)));
DI void stage_load(const Pass& ps, int jt, int tid, u32x4& kreg, u32x4& vreg) {
    const int key = tid >> 3, chunk = tid & 7;
    int kidx = jt * 64 + key; kidx = kidx < 0 ? 0 : (kidx >= ps.nkeys ? ps.nkeys - 1 : kidx);
    const size_t off = (size_t)(kidx * ps.kstride) * ps.kpitch + chunk * 8;
    kreg = *(const u32x4*)(ps.kb + off); vreg = *(const u32x4*)(ps.vb + off);
}
DI void stage_store(LAS char* base, int buf, int tid, const u32x4& kreg, const u32x4& vreg) {
    const int key = tid >> 3, chunk = tid & 7;
    *(LAS u32x4*)(base + L_K + buf * TILEB + key * KP + chunk * 16) = kreg;
    *(LAS u32x4*)(base + L_V + buf * TILEB + key * KP + chunk * 16) = vreg;
}
template <int MODE>
DI void flash_pass(LAS char* base, const Pass& ps, const bf16x8 (&qf)[4], int qidx, int tg, unsigned long long selmask, int wq_lo, int wq_hi,
                   f32x16 (&o)[2], float& m, float& l, float pscale, int qloc) {
    constexpr bool BAND = MODE & 1, MASKED = MODE & 2, BIAS = MODE & 4, STATS = MODE & 8, IMP = MODE & 16;
    const int tid = tidx(), lane = tid & 63, r = lane & 31, h = lane >> 5;
    const int n = ps.t_hi - ps.t_lo;
    if (n <= 0) return;
    u32x4 kreg, vreg;
    stage_load(ps, ps.t_lo, tid, kreg, vreg);
    stage_store(base, 0, tid, kreg, vreg);
    __syncthreads();
    const LAS float* bt = (const LAS float*)(base + L_BT) + tg * BT;
    const LAS float* b32 = (const LAS float*)(base + L_B32) + tg * 32;
    for (int it = 0; it < n; ++it) {
        const int jt = ps.t_lo + it, buf = it & 1;
        if (it + 1 < n) stage_load(ps, jt + 1, tid, kreg, vreg);
        const int k0 = jt * 64;
        bool lane_ok = true;
        if constexpr (MASKED) lane_ok = (selmask >> (jt >> ps.msh)) & 1ull;
        bool need;
        if constexpr (BAND) need = (k0 <= wq_hi) && (k0 + 63 >= wq_lo - ps.W);
        else need = (k0 <= wq_hi);
        if constexpr (MASKED) need = need && (__builtin_amdgcn_ballot_w64(lane_ok) != 0ull);
        if (need) {
            const LAS char* Kt = base + L_K + buf * TILEB; const LAS char* Vt = base + L_V + buf * TILEB;
            f32x16 st[2];
#pragma unroll
            for (int kb = 0; kb < 2; ++kb) {
#pragma unroll
                for (int i = 0; i < 16; ++i) st[kb][i] = 0.f;
#pragma unroll
                for (int s = 0; s < 4; ++s) { const bf16x8 kf = *(const LAS bf16x8*)(Kt + (kb * 32 + r) * KP + (2 * s + h) * 16); st[kb] = FA_MFMA(kf, qf[s], st[kb]); }
            }
            const int d0 = qidx - k0 - 4 * h;
            const bool full = BAND ? (wq_hi - k0 <= ps.W && wq_lo - (k0 + 63) >= 0) : (wq_lo - (k0 + 63) >= 0);
            float bv0 = 0.f, bv1 = 0.f; int t1 = 0x7fffffff; bool far = false;
            if constexpr (BIAS) {
                far = (wq_hi - k0) >= BT;
                if (far) {
                    int dmin = wq_lo - (k0 + 63); dmin = dmin < 0 ? 0 : dmin;
                    const int b0 = 28 + (dmin >= 825) + (dmin >= 1117) + (dmin >= 1513);
                    t1 = b0 == 28 ? 825 : (b0 == 29 ? 1117 : (b0 == 30 ? 1513 : 0x7fffffff));
                    bv0 = b32[b0]; bv1 = b32[b0 < 31 ? b0 + 1 : 31];
                }
            }
            float mx = -INFINITY;
#pragma unroll
            for (int kb = 0; kb < 2; ++kb)
#pragma unroll
                for (int i = 0; i < 16; ++i) {
                    const int d = d0 - (32 * kb + (i & 3) + 8 * (i >> 2));
                    float v = st[kb][i] * SC2;
                    if constexpr (BIAS) {
                        if (far) v += (d >= t1) ? bv1 : bv0;
                        else { const unsigned dc = (unsigned)d < (unsigned)BT ? (unsigned)d : (unsigned)(BT - 1); v += bt[dc]; }
                    }
                    bool ok = lane_ok;
                    if (!full) { if constexpr (BAND) ok = ok && ((unsigned)d <= (unsigned)ps.W); else ok = ok && (d >= 0); }
                    v = ok ? v : -INFINITY;
                    st[kb][i] = v; mx = fmaxf(mx, v);
                }
            mx = fmaxf(mx, xhalf(mx));
            const float mn = fmaxf(m, mx), alpha = __builtin_amdgcn_exp2f(m - mn);
            m = mn;
            float ls = 0.f;
#pragma unroll
            for (int kb = 0; kb < 2; ++kb)
#pragma unroll
                for (int i = 0; i < 16; ++i) { const float pe = __builtin_amdgcn_exp2f(st[kb][i] - mn); st[kb][i] = pe; ls += pe; }
            l = l * alpha + ls;
            if constexpr (IMP) {
                LAS float* impA = (LAS float*)(base + L_IMPA) + qloc * 64; LAS float* impB = (LAS float*)(base + L_IMPB) + qloc * 64;
#pragma unroll
                for (int kb = 0; kb < 2; ++kb)
#pragma unroll
                    for (int c4 = 0; c4 < 4; ++c4) {
                        const float s4 = quad_sum((st[kb][4 * c4] + st[kb][4 * c4 + 1]) + (st[kb][4 * c4 + 2] + st[kb][4 * c4 + 3]));
                        const float sp = quad_sum(st[kb][4 * c4 + 3]);
                        const int j = 16 * jt + 8 * kb + 2 * c4 + h;
                        if ((lane & 3) == 0) { impA[j] = s4 * pscale; if (j + 1 < 64) impB[j + 1] = sp * pscale; }
                    }
            }
            if constexpr (!STATS) {
                if (__builtin_amdgcn_ballot_w64(alpha != 1.0f) != 0ull) {
#pragma unroll
                    for (int i = 0; i < 16; ++i) { o[0][i] *= alpha; o[1][i] *= alpha; }
                }
                bf16x8 pf[2][2];
#pragma unroll
                for (int kb = 0; kb < 2; ++kb)
#pragma unroll
                    for (int s = 0; s < 2; ++s) {
                        uint4 pk; pk.x = cvtpk(st[kb][8 * s], st[kb][8 * s + 1]); pk.y = cvtpk(st[kb][8 * s + 2], st[kb][8 * s + 3]);
                        pk.z = cvtpk(st[kb][8 * s + 4], st[kb][8 * s + 5]); pk.w = cvtpk(st[kb][8 * s + 6], st[kb][8 * s + 7]);
                        pf[kb][s] = __builtin_bit_cast(bf16x8, pk);
                    }
                const int i16 = lane & 15, q = i16 >> 2, pp = i16 & 3, g16 = (lane >> 4) & 1;
                const LAS char* vbase = Vt + (4 * h + q) * KP + g16 * 32 + 8 * pp;
#pragma unroll
                for (int dh = 0; dh < 2; ++dh)
#pragma unroll
                    for (int kb = 0; kb < 2; ++kb)
#pragma unroll
                        for (int s = 0; s < 2; ++s) {
                            const LAS char* va = vbase + (kb * 32 + 16 * s) * KP + dh * 64;
                            const s16x4 lo = vtr(va), hi = vtr(va + 8 * KP);
                            const bf16x8 vf = __builtin_shufflevector(lo, hi, 0, 1, 2, 3, 4, 5, 6, 7);
                            o[dh] = FA_MFMA(vf, pf[kb][s], o[dh]);
                        }
            }
        }
        if (it + 1 < n) stage_store(base, buf ^ 1, tid, kreg, vreg);
        __syncthreads();
    }
}
DI void load_q(const bf16_t* qrow, int h, bf16x8 (&qf)[4]) {
#pragma unroll
    for (int s = 0; s < 4; ++s) qf[s] = __builtin_bit_cast(bf16x8, *(const uint4*)(qrow + 16 * s + 8 * h));
}
DI void store_o(bf16_t* orow, int h, const f32x16 (&o)[2], float inv) {
#pragma unroll
    for (int dh = 0; dh < 2; ++dh)
#pragma unroll
        for (int c4 = 0; c4 < 4; ++c4) {
            uint2 pk; pk.x = cvtpk(o[dh][4 * c4] * inv, o[dh][4 * c4 + 1] * inv); pk.y = cvtpk(o[dh][4 * c4 + 2] * inv, o[dh][4 * c4 + 3] * inv);
            *(uint2*)(orow + dh * 32 + 8 * c4 + 4 * h) = pk;
        }
}
DI void build_bias(LAS char* base, const float* relb, int col0, int ng, int dscale) {
    const int tid = tidx();
    LAS float* bt = (LAS float*)(base + L_BT); LAS float* b32 = (LAS float*)(base + L_B32);
    for (int e = tid; e < ng * BT; e += NTHR) { const int g = e / BT, d = e % BT; bt[e] = relb[t5_bucket(d * dscale) * 32 + col0 + g] * LOG2E; }
    if (tid < ng * 32) { const int g = tid >> 5, bk = tid & 31; b32[tid] = relb[bk * 32 + col0 + g] * LOG2E; }
    __syncthreads();
}

DI void item_band(const P& p, LAS char* base, const bf16_t* qb_, int qtok_stride, int q0, const Pass& ps, const float* relb, int col, int dscale,
                  bool has_sink, float sink, bf16_t* ob, float* lse_out  , int lse_stride) {
    const int tid = tidx(), lane = tid & 63, w = tid >> 6, r = lane & 31, h = lane >> 5;
    build_bias(base, relb, col, 1, dscale);
    const int qidx = q0 + w * 32 + r;
    bf16x8 qf[4]; load_q(qb_ + (size_t)qidx * qtok_stride * LDP, h, qf);
    f32x16 o[2];
#pragma unroll
    for (int i = 0; i < 16; ++i) { o[0][i] = 0.f; o[1][i] = 0.f; }
    float m = has_sink ? sink * LOG2E : -1e30f, l = (has_sink && h == 0) ? 1.f : 0.f;
    flash_pass<1 | 4>(base, ps, qf, qidx, 0, 0ull, q0 + w * 32, q0 + w * 32 + 31, o, m, l, 1.f, 0);
    l += xhalf(l);
    const float lt = fmaxf(l, 1.17549435e-38f);
    store_o(ob + (size_t)qidx * qtok_stride * 512, h, o, 1.f / lt);
    if (lse_out && h == 0) lse_out[(size_t)qidx * qtok_stride * lse_stride] = (m + __builtin_amdgcn_logf(lt)) * LN2;
}
DI void item_moba(const P& p, LAS char* base, int b, int hd, int qb) {
    const int tid = tidx(), lane = tid & 63, w = tid >> 6, r = lane & 31, h = lane >> 5;
    build_bias(base, p.in[2], 16 + hd, 1, 1);
    const int qidx = qb * 256 + w * 32 + r;
    const size_t row = (size_t)b * S + qidx;
    bf16x8 qf[4]; load_q(p.proj + row * LDP + OFF_QC + hd * 64, h, qf);
    f32x16 ga;
#pragma unroll
    for (int i = 0; i < 16; ++i) ga[i] = 0.f;
    const float* km = p.kmean + (((size_t)b * 8 + hd) * 16 + (r & 15)) * 64;
#pragma unroll
    for (int s = 0; s < 4; ++s) {
        const float4 a = *(const float4*)(km + 16 * s + 8 * h), c = *(const float4*)(km + 16 * s + 8 * h + 4);
        const float f[8] = {a.x, a.y, a.z, a.w, c.x, c.y, c.z, c.w};
        unsigned hi[4], lo[4];
#pragma unroll
        for (int j = 0; j < 4; ++j) {
            const float x0 = r < 16 ? f[2 * j] : 0.f, x1 = r < 16 ? f[2 * j + 1] : 0.f;
            const unsigned ph = cvtpk(x0, x1); hi[j] = ph;
            lo[j] = cvtpk(x0 - __uint_as_float(ph << 16), x1 - __uint_as_float(ph & 0xffff0000u));
        }
        uint4 uh; uh.x = hi[0]; uh.y = hi[1]; uh.z = hi[2]; uh.w = hi[3];
        uint4 ul; ul.x = lo[0]; ul.y = lo[1]; ul.z = lo[2]; ul.w = lo[3];
        ga = FA_MFMA(__builtin_bit_cast(bf16x8, uh), qf[s], ga);
        ga = FA_MFMA(__builtin_bit_cast(bf16x8, ul), qf[s], ga);
    }
    float gv[16];
#pragma unroll
    for (int i = 0; i < 8; ++i) {
        const float mine = ga[i], other = xhalf(mine);
        const int c = i >> 2, e = i & 3;
        gv[8 * c + e] = h ? other : mine; gv[8 * c + 4 + e] = h ? mine : other;
    }
    unsigned msk = 1u << qb;
#pragma unroll
    for (int k = 0; k < 3; ++k) {
        float best = -INFINITY; int bi = -1;
#pragma unroll
        for (int nn = 0; nn < 16; ++nn) if (nn < qb && gv[nn] > best) { best = gv[nn]; bi = nn; }
#pragma unroll
        for (int nn = 0; nn < 16; ++nn) if (nn == bi) gv[nn] = -INFINITY;
        if (bi >= 0) msk |= 1u << bi;
    }
    Pass ps{p.proj + (size_t)b * S * LDP + OFF_KC + hd * 64, p.proj + (size_t)b * S * LDP + OFF_VC + hd * 64, LDP, 1, S, 0, 4 * (qb + 1), 0, 2};
    f32x16 o[2];
#pragma unroll
    for (int i = 0; i < 16; ++i) { o[0][i] = 0.f; o[1][i] = 0.f; }
    float m = -1e30f, l = 0.f;
    flash_pass<2 | 4>(base, ps, qf, qidx, 0, (unsigned long long)msk, qb * 256 + w * 32, qb * 256 + w * 32 + 31, o, m, l, 1.f, 0);
    l += xhalf(l);
    store_o(p.oC + row * 512 + hd * 64, h, o, 1.f / fmaxf(l, 1.17549435e-38f));
}
DI void item_nsa(const P& p, LAS char* base, int b, int hk, int c) {
    const int tid = tidx(), lane = tid & 63, w = tid >> 6, r = lane & 31, h = lane >> 5, qq = r >> 2, g = r & 3;
    const int qloc = 8 * w + qq, qpos = c * 64 + qloc, hq = hk * 4 + g;
    const size_t row = (size_t)b * S + qpos;
    { LAS float* z = (LAS float*)(base + L_IMPA); for (int e = tid; e < 2 * 64 * 64; e += NTHR) z[e] = 0.f; }
    build_bias(base, p.in[2], 24 + hk * 4, 4, 1);
    bf16x8 qf[4]; load_q(p.proj + row * LDP + OFF_QD + hq * 64, h, qf);
    const bf16_t* gd = p.proj + row * LDP + OFF_GD + hq * 3;
    LAS unsigned* oacc = (LAS unsigned*)(base + L_OACC) + tid;
    f32x16 o[2];
    const int wq_lo = c * 64 + 8 * w, wq_hi = wq_lo + 7;
    {
        int nmax = (qpos - 31) >> 4; nmax = nmax > 254 ? 254 : nmax;
        const int wn_lo = (wq_lo - 31) >> 4, wn_hi = (wq_hi - 31) >> 4;
        int thi = ((c * 64 + 63 - 31) >> 4) / 64 + 1; thi = thi > 4 ? 4 : thi;
        Pass ps{p.kc + ((size_t)b * 2 + hk) * 256 * 64, p.vc + ((size_t)b * 2 + hk) * 256 * 64, 64, 1, 255, 0, thi, 0, 0};
        float m = -1e30f, l = 0.f;
        flash_pass<8>(base, ps, qf, nmax, 0, 0ull, wn_lo, wn_hi, o, m, l, 1.f, qloc);
        l += xhalf(l);
        const float inv = 1.f / fmaxf(l, 1.17549435e-38f);
#pragma unroll
        for (int i = 0; i < 16; ++i) { o[0][i] = 0.f; o[1][i] = 0.f; }
        float l2 = 0.f;
        flash_pass<16>(base, ps, qf, nmax, 0, 0ull, wn_lo, wn_hi, o, m, l2, inv, qloc);
        const float sc = sigmoidf_(bf2f(gd[0])) * inv;
#pragma unroll
        for (int dh = 0; dh < 2; ++dh)
#pragma unroll
            for (int i = 0; i < 8; ++i) oacc[(dh * 8 + i) * 512] = cvtpk(o[dh][2 * i] * sc, o[dh][2 * i + 1] * sc);
    }
    {
        const LAS float* impA = (const LAS float*)(base + L_IMPA); const LAS float* impB = (const LAS float*)(base + L_IMPB);
        LAS unsigned long long* sel = (LAS unsigned long long*)(base + L_SEL);
        for (int k = 0; k < 8; ++k) {
            const int ql = 8 * w + k, j = lane;
            const float val = (j == 0 || j == c || j == c - 1) ? 1e30f : (j <= c ? impA[ql * 64 + j] + impB[ql * 64 + j] : -1e30f);
            int rank = 0;
#pragma unroll 8
            for (int jj = 0; jj < 64; ++jj) { const float ov = __builtin_bit_cast(float, __builtin_amdgcn_readlane(__builtin_bit_cast(int, val), jj)); rank += (ov > val || (ov == val && jj < j)) ? 1 : 0; }
            const unsigned long long mk = __builtin_amdgcn_ballot_w64(rank < 16 && val > -1e29f);
            if (lane == 0) sel[ql] = mk;
        }
        __syncthreads();
    }
    const unsigned long long selmask = ((const LAS unsigned long long*)(base + L_SEL))[qloc];
    {
        Pass ps{p.proj + (size_t)b * S * LDP + OFF_KDS + hk * 64, p.proj + (size_t)b * S * LDP + OFF_VDS + hk * 64, LDP, 1, S, 0, c + 1, 0, 0};
#pragma unroll
        for (int i = 0; i < 16; ++i) { o[0][i] = 0.f; o[1][i] = 0.f; }
        float m = -1e30f, l = 0.f;
        flash_pass<2 | 4>(base, ps, qf, qpos, g, selmask, wq_lo, wq_hi, o, m, l, 1.f, qloc);
        l += xhalf(l);
        const float sc = sigmoidf_(bf2f(gd[1])) / fmaxf(l, 1.17549435e-38f);
#pragma unroll
        for (int dh = 0; dh < 2; ++dh)
#pragma unroll
            for (int i = 0; i < 8; ++i) { const unsigned pv = oacc[(dh * 8 + i) * 512];
                oacc[(dh * 8 + i) * 512] = cvtpk(__uint_as_float(pv << 16) + o[dh][2 * i] * sc, __uint_as_float(pv & 0xffff0000u) + o[dh][2 * i + 1] * sc); }
    }
    {
        Pass ps{p.proj + (size_t)b * S * LDP + OFF_KDW + hk * 64, p.proj + (size_t)b * S * LDP + OFF_VDW + hk * 64, LDP, 1, S, (c - 8 > 0 ? c - 8 : 0), c + 1, 511, 0};
#pragma unroll
        for (int i = 0; i < 16; ++i) { o[0][i] = 0.f; o[1][i] = 0.f; }
        float m = -1e30f, l = 0.f;
        flash_pass<1 | 4>(base, ps, qf, qpos, g, 0ull, wq_lo, wq_hi, o, m, l, 1.f, qloc);
        l += xhalf(l);
        const float sc = sigmoidf_(bf2f(gd[2])) / fmaxf(l, 1.17549435e-38f);
        bf16_t* orow = p.oD + row * 512 + hq * 64;
#pragma unroll
        for (int dh = 0; dh < 2; ++dh)
#pragma unroll
            for (int c4 = 0; c4 < 4; ++c4) {
                uint2 pk; const unsigned p0 = oacc[(dh * 8 + 2 * c4) * 512], p1 = oacc[(dh * 8 + 2 * c4 + 1) * 512];
                pk.x = cvtpk(__uint_as_float(p0 << 16) + o[dh][4 * c4] * sc, __uint_as_float(p0 & 0xffff0000u) + o[dh][4 * c4 + 1] * sc);
                pk.y = cvtpk(__uint_as_float(p1 << 16) + o[dh][4 * c4 + 2] * sc, __uint_as_float(p1 & 0xffff0000u) + o[dh][4 * c4 + 3] * sc);
                *(uint2*)(orow + dh * 32 + 8 * c4 + 4 * h) = pk;
            }
    }
}
constexpr int N_ITEMS = 3072;
DI void run_item(const P& p, int l, LAS char* base, int f) {
    if (f < 1024) {
        const int k = f >> 4, slot = f & 15;
        if (slot < 8) item_nsa(p, base, slot >> 1, slot & 1, 63 - k);
        else { const int idx = k * 8 + (slot - 8); item_moba(p, base, (idx & 31) >> 3, idx & 7, 15 - (idx >> 5)); }
    } else if (f < 1536) {
        const int i = f - 1024, qb = i & 15, hq = (i >> 4) & 7, b = i >> 7, kvh = hq >> 2;
        const bf16_t* bb = p.proj + (size_t)b * S * LDP;
        Pass ps{bb + OFF_KB + kvh * 64, bb + OFF_VB + kvh * 64, LDP, 1, S, (4 * qb - 2 > 0 ? 4 * qb - 2 : 0), 4 * qb + 4, 127, 0};
        item_band(p, base, bb + OFF_QB + hq * 64, 1, qb * 256, ps, p.in[2], 8 + hq, 1, true, p.in[16][l * 8 + hq], p.oB + (size_t)b * S * 512 + hq * 64, nullptr, 0);
    } else {
        const int i = f - 1536, cfg = i >> 9, j = i & 511, sub = j & 15, hd = (j >> 4) & 7, b = j >> 7;
        const int rr = cfg == 0 ? 1 : (cfg == 1 ? 4 : 16), nblk = 16 / rr;
        const int res = sub / nblk, blk = sub % nblk;
        const bf16_t* bb = p.proj + ((size_t)b * S + res) * LDP;
        Pass ps{bb + OFF_KA + hd * 64, bb + OFF_VA + hd * 64, LDP, rr, S / rr, (4 * blk - 2 > 0 ? 4 * blk - 2 : 0), 4 * blk + 4, 128, 0};
        item_band(p, base, bb + OFF_QA + hd * 64, rr, blk * 256, ps, p.in[2], hd, rr, false, 0.f,
                  p.oA + ((size_t)cfg * T + (size_t)b * S + res) * 512 + hd * 64, p.lseA + ((size_t)cfg * T + (size_t)b * S + res) * 8 + hd, 8);
    }
}
DI void phase_attention(const P& p, int l, float* lds) {
    LAS char* base = (LAS char*)lds;
    unsigned* ctr = p.ctl + CTL_Q + l;
    for (;;) {
        if (tidx() == 0) *(LAS int*)(base + L_TICKET) = (int)atomicAdd(ctr, 1u);
        __syncthreads();
        const int f = __builtin_amdgcn_readfirstlane(*(LAS int*)(base + L_TICKET));
        __syncthreads();
        if (f >= N_ITEMS) break;
        run_item(p, l, base, f);
    }
}
}

namespace pg8 {
#define PG8_LAS __attribute__((address_space(3)))
typedef short bf16x8 __attribute__((ext_vector_type(8)));
typedef float f32x4 __attribute__((ext_vector_type(4)));
typedef unsigned u32x4 __attribute__((ext_vector_type(4)));
constexpr int BM = 256, BK = 64, HALF = 128, HTB = HALF * BK * 2  , STAGE_BYTES = 8 * HTB, NXCD = 8, WGM = 8;

__device__ __forceinline__ int lds_byte(int r, int c) { const int st = (r >> 4) * 2 + (c >> 5), rr = r & 15, cc = c & 31, ob = rr * 64 + cc * 2; return st * 1024 + (ob ^ (((ob >> 9) & 1) << 5)); }
__device__ __forceinline__ void stage_rc(int b, int& R, int& C) { const int st = b / 1024, sb = b % 1024, swz = sb ^ (((sb >> 9) & 1) << 5); R = (st >> 1) * 16 + swz / 64; C = (st & 1) * 32 + (swz % 64) / 2; }
__device__ __forceinline__ int perm32(int rho) { const int n = rho >> 4, i = rho & 15; return 8 * (i >> 2) + 4 * n + (i & 3); }

struct Unit { int pm, pn; const char* A; const char* Ba; const char* Bb; int aux0, aux1, aux2; };
struct Shape { int K, lda, ldb, ksplit; };

__device__ __forceinline__ unsigned cvt_pk_bf16(float lo, float hi) { unsigned r; asm volatile("v_cvt_pk_bf16_f32 %0, %1, %2" : "=v"(r) : "v"(lo), "v"(hi)); return r; }

template <class Epi, class Sched, bool GATHER, bool ALIGN_EPI = true>
__device__ __forceinline__ void gemm_phase(PG8_LAS unsigned char* lds, const Shape g, const Sched& S, const Epi& E) {
    const int tid = tidx(), wid = __builtin_amdgcn_readfirstlane(tid >> 6), lane = tid & 63, wr = wid >> 2, wc = wid & 3, fr = lane & 15, fq = lane >> 4;
    const int nt = g.K / BK;
    unsigned voffA[2], voffA1[2], voffB[2];
#pragma unroll
    for (int i = 0; i < 2; ++i) { int R, C; stage_rc(tid * 16 + i * 8192, R, C); const int Rb = Epi::PERM ? ((R & ~31) + perm32(R & 31)) : R;
        voffA[i] = (unsigned)(R * g.lda + C) * 2u; voffA1[i] = voffA[i]; voffB[i] = (unsigned)(Rb * g.ldb + C) * 2u; }
    const size_t kstep = (size_t)(BK * 2);
    const size_t hstepA = GATHER ? 0 : (size_t)HALF * g.lda * 2;
    const size_t hstepB = (size_t)HALF * g.ldb * 2;
    const unsigned ldsw = (unsigned)wid * 1024u;
    const int aoff = lds_byte(wr * 64 + fr, fq * 8), boff = lds_byte(wc * 32 + fr, fq * 8);
#define PG8_SA(b, h) (((b) * 2 + (h)) * HTB)
#define PG8_SB(b, h) ((4 + (b) * 2 + (h)) * HTB)
#define PG8_STAGE(bufoff, gbase, voff) do { _Pragma("unroll") for (int _i = 0; _i < 2; ++_i) \
        __builtin_amdgcn_global_load_lds((const unsigned*)((const char*)(gbase) + (voff)[_i]), (PG8_LAS unsigned*)(lds + (bufoff) + ldsw + _i * 8192), 16, 0, 0); } while (0)
#define PG8_STAGE_A0(bufoff, gbase) PG8_STAGE(bufoff, gbase, voffA)
#define PG8_STAGE_A1(bufoff, gbase) do { if constexpr (GATHER) PG8_STAGE(bufoff, gbase, voffA1); else PG8_STAGE(bufoff, (gbase) + hstepA, voffA); } while (0)
#define PG8_LDA(dst, b, h) do { _Pragma("unroll") for (int m = 0; m < 4; ++m) _Pragma("unroll") for (int k = 0; k < 2; ++k) dst[m][k] = *(const PG8_LAS bf16x8*)(lds + PG8_SA(b, h) + aoff + m * 2048 + k * 1024); } while (0)
#define PG8_LDB(dst, b, h) do { _Pragma("unroll") for (int n = 0; n < 2; ++n) _Pragma("unroll") for (int k = 0; k < 2; ++k) dst[n][k] = *(const PG8_LAS bf16x8*)(lds + PG8_SB(b, h) + boff + n * 2048 + k * 1024); } while (0)
#define PG8_MMA(ai, bj, At, Bt) do { __builtin_amdgcn_s_setprio(1); _Pragma("unroll") for (int m = 0; m < 4; ++m) _Pragma("unroll") for (int n = 0; n < 2; ++n) _Pragma("unroll") for (int k = 0; k < 2; ++k) \
        acc[ai][bj][m][n] = __builtin_amdgcn_mfma_f32_16x16x32_bf16(Bt[n][k], At[m][k], acc[ai][bj][m][n], 0, 0, 0); __builtin_amdgcn_s_setprio(0); } while (0)
#define PG8_WAIT_V(n) asm volatile("s_waitcnt vmcnt(" #n ")" ::: "memory")
#define PG8_WAIT_L(n) asm volatile("s_waitcnt lgkmcnt(" #n ")" ::: "memory")
#define PG8_BAR __builtin_amdgcn_s_barrier()
#define PG8_SCHED __builtin_amdgcn_sched_barrier(0)
#define PG8_BK(u, t) (((t) < g.ksplit ? (u).Ba : (u).Bb) + (size_t)(t) * kstep)
    Unit cur, nxt; int ui = 0;
    if (!S.next(0, cur)) return;
    f32x4 acc[2][2][4][2];
#pragma unroll
    for (int a = 0; a < 2; ++a)
#pragma unroll
        for (int b = 0; b < 2; ++b)
#pragma unroll
            for (int m = 0; m < 4; ++m)
#pragma unroll
                for (int n = 0; n < 2; ++n) acc[a][b][m][n] = (f32x4){0.f, 0.f, 0.f, 0.f};
    bf16x8 At[4][2], B0[2][2], B1[2][2];
    const char* cA = cur.A; const char* cB = cur.Ba;
    if constexpr (GATHER) {
#pragma unroll
        for (int i = 0; i < 2; ++i) { int R, C; stage_rc(tidx() * 16 + i * 8192, R, C); voffA[i] = (unsigned)(S.gather_row(cur, R) * g.lda + C) * 2u; voffA1[i] = (unsigned)(S.gather_row(cur, R + HALF) * g.lda + C) * 2u; }
    }
    PG8_STAGE(PG8_SB(0, 0), cB, voffB); PG8_STAGE(PG8_SB(0, 1), cB + hstepB, voffB); PG8_STAGE_A0(PG8_SA(0, 0), cA); PG8_STAGE_A1(PG8_SA(0, 1), cA);
    if (wr == 1) PG8_BAR;
    PG8_WAIT_V(2); PG8_BAR;
    PG8_STAGE(PG8_SB(1, 0), cB + kstep, voffB); PG8_STAGE_A0(PG8_SA(1, 0), cA + kstep); PG8_STAGE(PG8_SB(1, 1), cB + hstepB + kstep, voffB);
    PG8_WAIT_V(6); PG8_BAR;
    for (;;) {
        const bool has_next = S.next(ui + 1, nxt);
        const char* nA = has_next ? nxt.A : cA; const char* nB = has_next ? nxt.Ba : cB;
        for (int t = 0; t < nt; t += 2) {
            const bool last = (t == nt - 2);
            const char* a1 = cA + (size_t)(t + 1) * kstep;
            const char* a2 = last ? nA : cA + (size_t)(t + 2) * kstep; const char* b2 = last ? nB : PG8_BK(cur, t + 2);
            const char* a3 = a2 + kstep; const char* b3 = b2 + kstep;
            PG8_LDB(B0, 0, 0); PG8_LDB(B1, 0, 1); PG8_SCHED; PG8_LDA(At, 0, 0); PG8_STAGE_A1(PG8_SA(1, 1), a1);
            if constexpr (GATHER) { if (last && has_next) {
#pragma unroll
                for (int i = 0; i < 2; ++i) { int R, C; stage_rc(tidx() * 16 + i * 8192, R, C); voffA[i] = (unsigned)(S.gather_row(nxt, R) * g.lda + C) * 2u; voffA1[i] = (unsigned)(S.gather_row(nxt, R + HALF) * g.lda + C) * 2u; } } }
            PG8_WAIT_V(8); PG8_WAIT_L(0); PG8_BAR; PG8_MMA(0, 0, At, B0); PG8_MMA(0, 1, At, B1); PG8_BAR; PG8_SCHED;
            PG8_LDA(At, 0, 1); PG8_STAGE(PG8_SB(0, 0), b2, voffB); PG8_STAGE(PG8_SB(0, 1), b2 + hstepB, voffB); PG8_STAGE_A0(PG8_SA(0, 0), a2);
            PG8_WAIT_V(8); PG8_WAIT_L(0); PG8_BAR; PG8_MMA(1, 0, At, B0); PG8_MMA(1, 1, At, B1); PG8_BAR; PG8_SCHED;
            PG8_LDB(B0, 1, 0); PG8_LDB(B1, 1, 1); PG8_SCHED; PG8_LDA(At, 1, 0); PG8_STAGE_A1(PG8_SA(0, 1), a2);
            PG8_WAIT_V(8); PG8_WAIT_L(0); PG8_BAR; PG8_MMA(0, 0, At, B0); PG8_MMA(0, 1, At, B1); PG8_BAR; PG8_SCHED;
            PG8_LDA(At, 1, 1); PG8_STAGE(PG8_SB(1, 0), b3, voffB); PG8_STAGE(PG8_SB(1, 1), b3 + hstepB, voffB); PG8_STAGE_A0(PG8_SA(1, 0), a3);
            PG8_WAIT_V(8); PG8_WAIT_L(0); PG8_BAR; PG8_MMA(1, 0, At, B0); PG8_MMA(1, 1, At, B1); PG8_BAR; PG8_SCHED;
        }
        if constexpr (ALIGN_EPI) { if (wr == 0) PG8_BAR; }
        { int fr_ = fr, fq_ = fq; asm volatile("" : "+v"(fr_), "+v"(fq_));
          E(acc, cur, wr, wc, fr_, fq_); }
        if (!has_next) break;
#pragma unroll
        for (int a = 0; a < 2; ++a)
#pragma unroll
            for (int b = 0; b < 2; ++b)
#pragma unroll
                for (int m = 0; m < 4; ++m)
#pragma unroll
                    for (int n = 0; n < 2; ++n) acc[a][b][m][n] = (f32x4){0.f, 0.f, 0.f, 0.f};
        cur = nxt; cA = nA; cB = nB; ++ui;
        if constexpr (ALIGN_EPI) { if (wr == 1) PG8_BAR; }
    }
    PG8_WAIT_V(0);
    if constexpr (!ALIGN_EPI) { if (wr == 0) PG8_BAR; }
    PG8_BAR;
#undef PG8_SA
#undef PG8_SB
#undef PG8_STAGE
#undef PG8_STAGE_A0
#undef PG8_STAGE_A1
#undef PG8_LDA
#undef PG8_LDB
#undef PG8_MMA
#undef PG8_WAIT_V
#undef PG8_WAIT_L
#undef PG8_BAR
#undef PG8_SCHED
#undef PG8_BK
}

struct GridOrder {
    int nM, nN, nwg, G, c;
    __device__ __forceinline__ void init(int M, int N, int G_, int c_) { nM = M / BM; nN = N / BM; nwg = nM * nN; G = G_; c = c_; }
    __device__ __forceinline__ bool flat(int i, int& pm, int& pn) const {
        const long L = (long)i * G + c; if (L >= nwg) return false;
        int wgid = (int)L; { const int q = nwg / NXCD, r = nwg % NXCD, xcd = wgid % NXCD, off = wgid / NXCD; wgid = (xcd < r ? xcd * (q + 1) : r * (q + 1) + (xcd - r) * q) + off; }
        const int nig = WGM * nN, gid = wgid / nig, fm = gid * WGM, gsz = (nM - fm) < WGM ? (nM - fm) : WGM;
        pm = fm + ((wgid % nig) % gsz); pn = (wgid % nig) / gsz; return true;
    }
};
}

struct DenseSched {
    pg8::GridOrder go; const char* A; const char* Bt; size_t a_tile, b_tile;
    DI bool next(int i, pg8::Unit& u) const { int pm, pn; if (!go.flat(i, pm, pn)) return false; u.pm = pm; u.pn = pn; u.A = A + (size_t)pm * a_tile; u.Ba = Bt + (size_t)pn * b_tile; u.Bb = u.Ba; u.aux0 = u.aux1 = u.aux2 = 0; return true; }
    DI int gather_row(const pg8::Unit&, int r) const { return r; }
};
struct EpiProj {
    static constexpr bool PERM = true;
    bf16_t* O;
    DI void operator()(const pg8::f32x4 (&acc)[2][2][4][2], const pg8::Unit& u, int wr, int wc, int fr, int fq) const {
        const int row0 = u.pm * 256 + wr * 64 + fr, col0 = u.pn * 256 + wc * 32 + 8 * fq;
#pragma unroll
        for (int ai = 0; ai < 2; ++ai)
#pragma unroll
            for (int m = 0; m < 4; ++m) { bf16_t* rowp = O + (size_t)(row0 + ai * 128 + m * 16) * LDP + col0;
#pragma unroll
                for (int bj = 0; bj < 2; ++bj) { const pg8::f32x4 v0 = acc[ai][bj][m][0], v1 = acc[ai][bj][m][1];
                    pg8::u32x4 w; w.x = pg8::cvt_pk_bf16(v0[0], v0[1]); w.y = pg8::cvt_pk_bf16(v0[2], v0[3]); w.z = pg8::cvt_pk_bf16(v1[0], v1[1]); w.w = pg8::cvt_pk_bf16(v1[2], v1[3]);
                    *(pg8::u32x4*)(rowp + bj * 128) = w; } }
    }
};
struct EpiResid {
    static constexpr bool PERM = true;
    const float* xs; float* xd; const float* gate;
    DI void operator()(const pg8::f32x4 (&acc)[2][2][4][2], const pg8::Unit& u, int wr, int wc, int fr, int fq) const {
        const int row0 = u.pm * 256 + wr * 64 + fr, col0 = u.pn * 256 + wc * 32 + 8 * fq;
        const float* gp = gate + (size_t)((u.pm * 256) / S) * 12288 + col0;
        pg8::f32x4 gv[2][2];
#pragma unroll
        for (int bj = 0; bj < 2; ++bj)
#pragma unroll
            for (int n = 0; n < 2; ++n) gv[bj][n] = *(const pg8::f32x4*)(gp + bj * 128 + 4 * n);
#pragma unroll
        for (int ai = 0; ai < 2; ++ai)
#pragma unroll
            for (int m = 0; m < 4; ++m) { const size_t ro = (size_t)(row0 + ai * 128 + m * 16) * D + col0;
#pragma unroll
                for (int bj = 0; bj < 2; ++bj)
#pragma unroll
                    for (int n = 0; n < 2; ++n) { const pg8::f32x4 xv = *(const pg8::f32x4*)(xs + ro + bj * 128 + 4 * n);
                        *(pg8::f32x4*)(xd + ro + bj * 128 + 4 * n) = xv + gv[bj][n] * acc[ai][bj][m][n]; } }
    }
};

constexpr int LDS_MOE_TAB = 132096 / 4;
DI void moe_build_table(const P& p, int l, float* lds) {
    int* tab = (int*)(lds + LDS_MOE_TAB);
    unsigned* cnt = p.ctl + CTL_CNT + l * 32;
    const int tid = tidx();
    if (tid < 96) { int cls = 0, mt = 0, sb = 0; const bool ok = cls_find(cnt, tid, cls, mt, sb);
        tab[4 + 4 * tid] = ok ? cls : 0; tab[5 + 4 * tid] = mt; tab[6 + 4 * tid] = sb; tab[7 + 4 * tid] = ok ? (int)__hip_atomic_load(cnt + cls, __ATOMIC_RELAXED, __HIP_MEMORY_SCOPE_AGENT) : 0; }
    if (tid == 0) tab[0] = cls_total_tiles(cnt);
    __syncthreads();
}
DI int rfl(int v) { return __builtin_amdgcn_readfirstlane(v); }
struct MoeSched1 {
    const int* tab; int G, c; const char* hb; const char* wgu; const int* cls_tok;
    DI bool next(int i, pg8::Unit& u) const {
        const int L = i * G + c, nt = rfl(tab[0]); if (L >= nt * 8) return false;
        const int ft = L >> 3, pn = L & 7;
        const int cls = rfl(tab[4 + 4 * ft]), mt = rfl(tab[5 + 4 * ft]), sb = rfl(tab[6 + 4 * ft]), n = rfl(tab[7 + 4 * ft]);
        int ea, eb; cls_experts(cls, ea, eb); const int e = pn < 4 ? ea : eb;
        u.pm = (sb >> 8) + mt; u.pn = pn; u.A = hb; u.Ba = wgu + ((size_t)e * 1024 + (pn & 3) * 256) * 2048 * 2; u.Bb = u.Ba; u.aux0 = cls; u.aux1 = mt * 256; u.aux2 = n; return true;
    }
    DI int gather_row(const pg8::Unit& u, int r) const { const int ri = u.aux1 + r; return cls_tok[(size_t)u.aux0 * CLS_CAP + (ri < u.aux2 ? ri : 0)]; }
};
struct MoeSched2 {
    const int* tab; int G, c; const char* hid; const char* wd;
    DI bool next(int i, pg8::Unit& u) const {
        const int L = i * G + c, nt = rfl(tab[0]); if (L >= nt * 8) return false;
        const int ft = L >> 3, pn = L & 7;
        const int cls = rfl(tab[4 + 4 * ft]), mt = rfl(tab[5 + 4 * ft]), sb = rfl(tab[6 + 4 * ft]), n = rfl(tab[7 + 4 * ft]);
        int ea, eb; cls_experts(cls, ea, eb);
        u.pm = (sb >> 8) + mt; u.pn = pn; u.A = hid + (size_t)(sb + mt * 256) * 1024 * 2;
        u.Ba = wd + ((size_t)ea * 2048 + pn * 256) * 512 * 2; u.Bb = wd + ((size_t)eb * 2048 + pn * 256) * 512 * 2 - (size_t)8 * 128;
        u.aux0 = cls; u.aux1 = mt * 256; u.aux2 = n; return true;
    }
    DI int gather_row(const pg8::Unit&, int r) const { return r; }
};
struct EpiMoe1 {
    static constexpr bool PERM = true;
    bf16_t* hid; const int* cls_tok; const float* tokw;
    DI void operator()(const pg8::f32x4 (&acc)[2][2][4][2], const pg8::Unit& u, int wr, int wc, int fr, int fq) const {
        const int which = u.pn >> 2, q = u.pn & 3;
        const int* toks = cls_tok + (size_t)u.aux0 * CLS_CAP;
        bf16_t* hb = hid + (size_t)u.pm * 256 * 1024 + which * 512 + q * 128 + wc * 32 + 8 * fq;
#pragma unroll
        for (int ai = 0; ai < 2; ++ai)
#pragma unroll
            for (int m = 0; m < 4; ++m) {
                const int r = wr * 64 + fr + ai * 128 + m * 16, ri = u.aux1 + r;
                if (ri < u.aux2) {
                    const float w = tokw[(size_t)toks[ri] * 2 + which];
                    const pg8::f32x4 g0 = acc[ai][0][m][0], g1 = acc[ai][0][m][1], u0 = acc[ai][1][m][0], u1 = acc[ai][1][m][1];
                    pg8::u32x4 o;
                    o.x = pg8::cvt_pk_bf16(siluf_(g0[0]) * u0[0] * w, siluf_(g0[1]) * u0[1] * w); o.y = pg8::cvt_pk_bf16(siluf_(g0[2]) * u0[2] * w, siluf_(g0[3]) * u0[3] * w);
                    o.z = pg8::cvt_pk_bf16(siluf_(g1[0]) * u1[0] * w, siluf_(g1[1]) * u1[1] * w); o.w = pg8::cvt_pk_bf16(siluf_(g1[2]) * u1[2] * w, siluf_(g1[3]) * u1[3] * w);
                    *(pg8::u32x4*)(hb + (size_t)r * 1024) = o;
                }
                asm volatile("" ::: "memory");
            }
    }
};
struct EpiMoe2 {
    static constexpr bool PERM = true;
    float* x; const int* cls_tok; const float* g2;
    DI void operator()(const pg8::f32x4 (&acc)[2][2][4][2], const pg8::Unit& u, int wr, int wc, int fr, int fq) const {
        const int* toks = cls_tok + (size_t)u.aux0 * CLS_CAP;
        const int col0 = u.pn * 256 + wc * 32 + 8 * fq;
#pragma unroll
        for (int ai = 0; ai < 2; ++ai)
#pragma unroll
            for (int m = 0; m < 4; ++m) {
                const int r = wr * 64 + fr + ai * 128 + m * 16, ri = u.aux1 + r;
                if (ri < u.aux2) {
                    const int tok = toks[ri];
                    float* xr = x + (size_t)tok * D + col0;
                    const float* gp = g2 + (size_t)(tok / S) * 12288 + col0;
#pragma unroll
                    for (int bj = 0; bj < 2; ++bj)
#pragma unroll
                        for (int n = 0; n < 2; ++n) { const pg8::f32x4 xv = *(const pg8::f32x4*)(xr + bj * 128 + 4 * n), gv = *(const pg8::f32x4*)(gp + bj * 128 + 4 * n);
                            *(pg8::f32x4*)(xr + bj * 128 + 4 * n) = xv + gv * acc[ai][bj][m][n]; }
                }
            }
    }
};

constexpr int LDS_BYTES = 147456;
constexpr int LDS_MISC = 131072 / 4, LDS_TAB = 131328 / 4;
DI unsigned long long ld_tab(const float* lds, int i) {
    const unsigned lo = __builtin_amdgcn_readfirstlane(__float_as_uint(lds[LDS_TAB + 2 * i])), hi = __builtin_amdgcn_readfirstlane(__float_as_uint(lds[LDS_TAB + 2 * i + 1]));
    return ((unsigned long long)hi << 32) | lo;
}
DI P load_P(const float* lds) {
    asm volatile("" ::: "memory");
    P p;
#pragma unroll
    for (int i = 0; i < 23; ++i) p.in[i] = (const float*)ld_tab(lds, i);
    p.out = (float*)ld_tab(lds, 23);
    unsigned char* ws = (unsigned char*)ld_tab(lds, 24);
    p.ctl = (unsigned*)(ws + O_CTL); p.mod = (float*)(ws + O_MOD); p.xres = (float*)(ws + O_XRES); p.hbuf = (bf16_t*)(ws + O_HBUF); p.proj = (bf16_t*)(ws + O_PROJ);
    p.oA = (bf16_t*)(ws + O_OA); p.lseA = (float*)(ws + O_LSEA); p.oB = (bf16_t*)(ws + O_OB); p.oC = (bf16_t*)(ws + O_OC); p.oD = (bf16_t*)(ws + O_OD);
    p.kmean = (float*)(ws + O_KMEAN); p.kc = (bf16_t*)(ws + O_KC); p.vc = (bf16_t*)(ws + O_VC); p.cls_tok = (int*)(ws + O_CLSTOK); p.tokw = (float*)(ws + O_TOKW);
    p.hid = (bf16_t*)(ws + O_HID); p.winT = (bf16_t*)(ws + O_WINT); p.woutT = (bf16_t*)(ws + O_WOUTT); p.wguT = (bf16_t*)(ws + O_WGUT); p.wdT = (bf16_t*)(ws + O_WDT);
    p.cw1T = (bf16_t*)(ws + O_CW1T); p.cw2T = (bf16_t*)(ws + O_CW2T);
    return p;
}
__global__ void __launch_bounds__(NTHR, 2) mk_fwd(KArgs ka) {
    extern __shared__ __attribute__((aligned(16))) float lds[];
    const int bid = blockIdx.x, nb = gridDim.x;
#define w (tidx() >> 6)
    volatile LAS unsigned* xbw = (volatile LAS unsigned*)(lds + LDS_MISC);
    if (threadIdx.x == 0) { xbw[0] = 0u; xbw[1] = 0u; xbw[2] = 0u; xbw[3] = 0u; }
    if (threadIdx.x < 25) {
        const unsigned long long v = (threadIdx.x < 23) ? (unsigned long long)ka.in[threadIdx.x < 23 ? threadIdx.x : 0] : (threadIdx.x == 23 ? (unsigned long long)ka.out : (unsigned long long)ka.ws);
        lds[LDS_TAB + 2 * threadIdx.x] = __uint_as_float((unsigned)v); lds[LDS_TAB + 2 * threadIdx.x + 1] = __uint_as_float((unsigned)(v >> 32));
    }
    __syncthreads();
    XcdBarrier bar = xcd_barrier_post((unsigned*)(ka.ws + O_CTL), xbw);

    { const P p = load_P(lds);
      for (int it = bid; it < N_MOD_ITEMS + N_TR_ITEMS; it += nb) { if (it < N_MOD_ITEMS) phase_mod_item(p, it, lds); else phase_transpose_item(p, it - N_MOD_ITEMS, lds); } }
    xcd_barrier(bar);
    for (int l = 0; l < DEPTH; ++l) {
        { const P p = load_P(lds); for (int it = bid * 8 + w; it < T; it += nb * 8) phase_norm1_wave(p, l, it, lds + w * 2048); }
        xcd_barrier(bar);
        { const P p = load_P(lds);
          DenseSched sc; sc.go.init(T, 5120, nb, bid); sc.A = (const char*)p.hbuf; sc.Bt = (const char*)(p.winT + (size_t)l * NPAD_IN * 2048); sc.a_tile = (size_t)256 * D * 2; sc.b_tile = (size_t)256 * 2048 * 2;
          const pg8::Shape g{2048, D, 2048, 1 << 20};
          const EpiProj E{p.proj};
          pg8::gemm_phase<EpiProj, DenseSched, false>((PG8_LAS unsigned char*)lds, g, sc, E); }
        xcd_barrier(bar);
        { const P p = load_P(lds); for (int it = bid; it < N_KMEAN_ITEMS + N_CMP_ITEMS; it += nb) { if (it < N_KMEAN_ITEMS) phase_kmean_item(p, it, lds); else phase_cmp_item(p, l, it - N_KMEAN_ITEMS, lds); } }
        xcd_barrier(bar);
        { const P p = load_P(lds); fa::phase_attention(p, l, lds); }
        xcd_barrier(bar);
        { const P p = load_P(lds); for (int it = bid * 8 + w; it < N_MIXN_WAVE_ITEMS; it += nb * 8) phase_mixnorm_wave(p, it); }
        xcd_barrier(bar);
        { const P p = load_P(lds);
          DenseSched sc; sc.go.init(T, 2048, nb, bid); sc.A = (const char*)p.hbuf; sc.Bt = (const char*)(p.woutT + (size_t)l * 2048 * 2048); sc.a_tile = (size_t)256 * D * 2; sc.b_tile = (size_t)256 * 2048 * 2;
          const pg8::Shape g{2048, D, 2048, 1 << 20};
          const EpiResid E{l == 0 ? p.in[0] : p.xres, p.xres, p.mod + (size_t)l * 4 * 12288 + 2 * D};
          pg8::gemm_phase<EpiResid, DenseSched, false>((PG8_LAS unsigned char*)lds, g, sc, E); }
        xcd_barrier(bar);
        { const P p = load_P(lds); for (int it = bid * 8 + w; it < T; it += nb * 8) phase_norm2_router_wave(p, l, it, lds + w * 2048); }
        xcd_barrier(bar);
        { const P p = load_P(lds); moe_build_table(p, l, lds);
          const MoeSched1 sc{(const int*)(lds + LDS_MOE_TAB), nb, bid, (const char*)p.hbuf, (const char*)(p.wguT + (size_t)l * 16 * 1024 * 2048), p.cls_tok};
          const pg8::Shape g{2048, D, 2048, 1 << 20};
          const EpiMoe1 E{p.hid, p.cls_tok, p.tokw};
          pg8::gemm_phase<EpiMoe1, MoeSched1, true>((PG8_LAS unsigned char*)lds, g, sc, E); }
        xcd_barrier(bar);
        { const P p = load_P(lds);
          const MoeSched2 sc{(const int*)(lds + LDS_MOE_TAB), nb, bid, (const char*)p.hid, (const char*)(p.wdT + (size_t)l * 16 * 2048 * 512)};
          const pg8::Shape g{1024, 1024, 512, 8};
          const EpiMoe2 E{p.xres, p.cls_tok, p.mod + (size_t)l * 4 * 12288 + 5 * D};
          pg8::gemm_phase<EpiMoe2, MoeSched2, false>((PG8_LAS unsigned char*)lds, g, sc, E); }
        xcd_barrier(bar);
    }
    { const P p = load_P(lds);
      const bool tmo = xb_ld(p.ctl + XB_TMO) != 0u;
      for (int it = bid * 8 + w; it < T; it += nb * 8) phase_final_wave(p, it, tmo); }
#undef w
}

extern "C" void kernel_launch(void* const* d_in, const int* in_sizes, int n_in, void* d_out, int out_size, void* d_ws, size_t ws_size, hipStream_t stream) {
    KArgs ka{};
    for (int i = 0; i < 23; ++i) ka.in[i] = (const float*)d_in[i];
    ka.out = (float*)d_out;
    ka.ws = (unsigned char*)d_ws;
    if (WS_NEED > ws_size) { fprintf(stderr, "workspace too small: need %zu have %zu\n", (size_t)WS_NEED, ws_size); return; }
    static int grid = 0;
    if (!grid) {
        int dev = 0, cus = 0, per_cu = 0;
        (void)hipGetDevice(&dev);
        (void)hipDeviceGetAttribute(&cus, hipDeviceAttributeMultiprocessorCount, dev);
        (void)hipFuncSetAttribute((const void*)mk_fwd, hipFuncAttributeMaxDynamicSharedMemorySize, LDS_BYTES);
        (void)hipOccupancyMaxActiveBlocksPerMultiprocessor(&per_cu, (const void*)mk_fwd, NTHR, LDS_BYTES);
        if (per_cu < 1) fprintf(stderr, "occupancy query reports %d blocks per CU\n", per_cu);
        (void)hipGetLastError();
        grid = cus;
    }
    (void)hipMemsetAsync(ka.ws + O_CTL, 0, 1 << 20, stream);
    mk_fwd<<<grid, NTHR, LDS_BYTES, stream>>>(ka);
}
```

```cpp
#include <hip/hip_runtime.h>
#include <stdint.h>
#include <stdio.h>

typedef unsigned short bf16_t;
#define DI __device__ __forceinline__
#define LAS __attribute__((address_space(3)))

constexpr int D = 2048, NBATCH = 4, S = 4096, T = NBATCH * S, DEPTH = 4;
constexpr int NTHR = 512;
constexpr int LDP = 5144;
constexpr int NPAD_IN = 5120;
constexpr int OFF_QA = 0, OFF_KA = 512, OFF_VA = 1024, OFF_QB = 1536, OFF_KB = 2048, OFF_VB = 2176, OFF_QC = 2304, OFF_KC = 2816,
              OFF_VC = 3328, OFF_QD = 3840, OFF_KDC = 4352, OFF_VDC = 4480, OFF_KDS = 4608, OFF_VDS = 4736, OFF_KDW = 4864,
              OFF_VDW = 4992, OFF_GD = 5120;
constexpr int NCLS = 24, CLS_CAP = T, HID_ROWS = T + NCLS * 256;
constexpr float NEGF = -1e30f;
constexpr float EPS = 1e-6f;

struct P {
    const float* in[23];
    float* out;
    unsigned* ctl;
    float* mod;
    float* xres;
    bf16_t* hbuf;
    bf16_t* proj;
    bf16_t* oA;
    float* lseA;
    bf16_t* oB; bf16_t* oC; bf16_t* oD;
    float* kmean;
    bf16_t* kc; bf16_t* vc;
    int* cls_tok;
    float* tokw;
    bf16_t* hid;
    bf16_t* winT;
    bf16_t* woutT;
    bf16_t* wguT;
    bf16_t* wdT;
    bf16_t* cw1T;
    bf16_t* cw2T;
    bf16_t* cgT;
    bf16_t* crT;
    bf16_t* hlo;
};
constexpr size_t al256(size_t x) { return (x + 255) & ~(size_t)255; }
constexpr size_t O_CTL = 0;
constexpr size_t O_MOD = O_CTL + al256((size_t)1 << 20);
constexpr size_t O_XRES = O_MOD + al256((size_t)4 * 4 * 12288 * 4);
constexpr size_t O_HBUF = O_XRES + al256((size_t)T * D * 4);
constexpr size_t O_PROJ = O_HBUF + al256((size_t)T * D * 2);
constexpr size_t O_OA = O_PROJ + al256((size_t)T * LDP * 2);
constexpr size_t O_LSEA = O_OA + al256((size_t)3 * T * 512 * 2);
constexpr size_t O_OB = O_LSEA + al256((size_t)3 * T * 8 * 4);
constexpr size_t O_OC = O_OB + al256((size_t)T * 512 * 2);
constexpr size_t O_OD = O_OC + al256((size_t)T * 512 * 2);
constexpr size_t O_KMEAN = O_OD + al256((size_t)T * 512 * 2);
constexpr size_t O_KC = O_KMEAN + al256((size_t)4 * 8 * 16 * 64 * 4);
constexpr size_t O_VC = O_KC + al256((size_t)4 * 2 * 256 * 64 * 2);
constexpr size_t O_CLSTOK = O_VC + al256((size_t)4 * 2 * 256 * 64 * 2);
constexpr size_t O_TOKW = O_CLSTOK + al256((size_t)NCLS * CLS_CAP * 4);
constexpr size_t O_HID = O_TOKW + al256((size_t)T * 2 * 4);
constexpr size_t O_WINT = O_HID + al256((size_t)HID_ROWS * 1024 * 2);
constexpr size_t O_WOUTT = O_WINT + al256((size_t)4 * NPAD_IN * 2048 * 2);
constexpr size_t O_WGUT = O_WOUTT + al256((size_t)4 * 2048 * 2048 * 2);
constexpr size_t O_WDT = O_WGUT + al256((size_t)4 * 16 * 1024 * 2048 * 2);
constexpr size_t O_CW1T = O_WDT + al256((size_t)4 * 16 * 2048 * 512 * 2);
constexpr size_t O_CW2T = O_CW1T + al256((size_t)4 * 2 * 128 * 2048 * 2);
constexpr size_t O_CGT = O_CW2T + al256((size_t)4 * 2 * 64 * 128 * 2);
constexpr size_t O_CRT = O_CGT + al256((size_t)4 * 32 * 2048 * 2);
constexpr size_t O_HLO = O_CRT + al256((size_t)2 * 32 * 2048 * 2);
constexpr size_t WS_NEED = O_HLO + al256((size_t)T * D * 2);
struct KArgs { const float* in[23]; float* out; unsigned char* ws; };
constexpr int CTL_CNT = 8192;
constexpr int CTL_Q = 8192 + 256;

DI int tidx() { int t = threadIdx.x; asm volatile("" : "+v"(t)); return t; }
DI float bf2f(bf16_t v) { return __uint_as_float(((unsigned)v) << 16); }
DI bf16_t f2bf(float f) { unsigned u = __float_as_uint(f); u += 0x7fffu + ((u >> 16) & 1u); return (bf16_t)(u >> 16); }
DI float wave_sum(float v) { for (int o = 32; o > 0; o >>= 1) v += __shfl_xor(v, o); return v; }
DI float wave_max(float v) { for (int o = 32; o > 0; o >>= 1) v = fmaxf(v, __shfl_xor(v, o)); return v; }
DI void wave_lds_sync() { asm volatile("s_waitcnt lgkmcnt(0)" ::: "memory"); __builtin_amdgcn_wave_barrier(); }
DI float sigmoidf_(float x) { return 1.f / (1.f + __expf(-x)); }
DI float siluf_(float x) { return x / (1.f + __expf(-x)); }
DI float gelu_tanh(float x) { float u = 0.7978845608028654f * (x + 0.044715f * x * x * x); return 0.5f * x * (1.f + tanhf(u)); }
DI int t5_bucket(int d) {
    if (d < 16) return d < 0 ? 0 : d;
    return 16 + (d >= 22) + (d >= 30) + (d >= 40) + (d >= 54) + (d >= 73) + (d >= 99) + (d >= 134) + (d >= 182) + (d >= 246) + (d >= 332) +
           (d >= 450) + (d >= 609) + (d >= 825) + (d >= 1117) + (d >= 1513);
}

DI void phase_mod_item(const P& p, int item, float* lds) {
    const int l = item / 48, jb = item % 48, tid = tidx();
    float* cact = lds;
    float* red = lds + 8192;
    const float* c = p.in[1];
    for (int i = tid; i < 4 * 2048; i += NTHR) cact[i] = siluf_(c[i]);
    __syncthreads();
    const int kq = tid >> 6, lane = tid & 63;
    const float* w = p.in[7] + (size_t)l * 2048 * 12288 + jb * 256 + lane * 4;
    float acc[4][4];
#pragma unroll
    for (int b = 0; b < 4; ++b)
#pragma unroll
        for (int j = 0; j < 4; ++j) acc[b][j] = 0.f;
#pragma unroll 4
    for (int k = kq * 256; k < kq * 256 + 256; ++k) {
        const float4 wv = *(const float4*)(w + (size_t)k * 12288);
#pragma unroll
        for (int b = 0; b < 4; ++b) {
            const float cv = cact[b * 2048 + k];
            acc[b][0] += cv * wv.x; acc[b][1] += cv * wv.y; acc[b][2] += cv * wv.z; acc[b][3] += cv * wv.w;
        }
    }
#pragma unroll
    for (int b = 0; b < 4; ++b)
#pragma unroll
        for (int j = 0; j < 4; ++j) red[(kq * 4 + b) * 256 + lane * 4 + j] = acc[b][j];
    __syncthreads();
    for (int i = tid; i < 1024; i += NTHR) {
        const int b = i >> 8, col = i & 255;
        float v = 0.f;
#pragma unroll
        for (int q = 0; q < 8; ++q) v += red[(q * 4 + b) * 256 + col];
        p.mod[((size_t)l * 4 + b) * 12288 + jb * 256 + col] = v + p.in[8][(size_t)l * 12288 + jb * 256 + col];
    }
    __syncthreads();
}
constexpr int N_MOD_ITEMS = 4 * 48;

DI void transpose_tile(const float* src, int ld, int k0, int n0, int N, bf16_t* dst, int lddst, int dst_row0, int blkstride, const float* kscale, float* lds, bf16_t* dst_lo = nullptr) {
    float(*tl)[65] = (float(*)[65])lds;
    const int tid = tidx();
#pragma unroll 4
    for (int i = 0; i < 8; ++i) {
        const int e = tid + i * NTHR, kk = e >> 6, nn = e & 63, n = n0 + nn;
        float v = (n < N) ? src[(size_t)(k0 + kk) * ld + n] : 0.f;
        if (kscale) v *= kscale[k0 + kk];
        tl[kk][nn] = v;
    }
    __syncthreads();
#pragma unroll 4
    for (int i = 0; i < 8; ++i) {
        const int e = tid + i * NTHR, nn = e >> 6, kk = e & 63, n = n0 + nn;
        if (n < N) { const size_t di = (size_t)(dst_row0 + (nn >> 5) * blkstride + (nn & 31)) * lddst + k0 + kk; const bf16_t hi = f2bf(tl[kk][nn]); dst[di] = hi; if (dst_lo) dst_lo[di] = f2bf(tl[kk][nn] - bf2f(hi)); }
    }
    __syncthreads();
}
constexpr int TR0 = 4 * 32 * 80, TR1 = 4 * 32 * 32, TR2 = 4 * 16 * 32 * 8, TR3 = TR2, TR4 = 4 * 16 * 8 * 32, TR5 = 4 * 32 * 2, TR6 = TR5, TR7 = 4 * 2, TR8 = TR7, TR9 = 4 * 32, TR10 = 32;
constexpr int N_TR_ITEMS = TR0 + TR1 + TR2 + TR3 + TR4 + TR5 + TR6 + TR7 + TR8 + TR9 + TR10;
DI void phase_transpose_item(const P& p, int item, float* lds) {
    int i = item;
    if (i < TR0) { const int l = i / (32 * 80), r = i % (32 * 80), kt = r / 80, nt = r % 80;
        transpose_tile(p.in[9] + (size_t)l * 2048 * 5144, 5144, kt * 64, nt * 64, 5144, p.winT + (size_t)l * NPAD_IN * 2048, 2048, nt * 64, 32, nullptr, lds); return; }
    i -= TR0;
    if (i < TR1) { const int l = i / 1024, r = i % 1024, kt = r / 32, nt = r % 32;
        transpose_tile(p.in[18] + (size_t)l * 2048 * 2048, 2048, kt * 64, nt * 64, 2048, p.woutT + (size_t)l * 2048 * 2048, 2048, nt * 64, 32, p.in[17] + (size_t)l * 2048, lds); return; }
    i -= TR1;
    if (i < TR2 + TR3) { const int up = i >= TR2; if (up) i -= TR2; const int le = i / 256, r = i % 256, kt = r / 8, nt = r % 8;
        transpose_tile(p.in[up ? 20 : 19] + (size_t)le * 2048 * 512, 512, kt * 64, nt * 64, 512, p.wguT + (size_t)le * 1024 * 2048, 2048, (nt >> 1) * 256 + (nt & 1) * 64 + (up ? 128 : 0), 32, nullptr, lds); return; }
    i -= TR2 + TR3;
    if (i < TR4) { const int le = i / 256, r = i % 256, kt = r / 32, nt = r % 32;
        transpose_tile(p.in[21] + (size_t)le * 512 * 2048, 2048, kt * 64, nt * 64, 2048, p.wdT + (size_t)le * 2048 * 512, 512, nt * 64, 32, nullptr, lds); return; }
    i -= TR4;
    if (i < TR5 + TR6) { const int v = i >= TR5; if (v) i -= TR5; const int l = i / 64, r = i % 64, kt = r / 2, nt = r % 2;
        transpose_tile(p.in[v ? 14 : 12] + (size_t)l * 2048 * 128, 128, kt * 64, nt * 64, 128, p.cw1T + (size_t)(l * 2 + v) * 128 * 2048, 2048, nt * 64, 32, nullptr, lds); return; }
    i -= TR5 + TR6;
    if (i < TR7 + TR8) { const int v = i >= TR7; if (v) i -= TR7; const int l = i / 2, kt = i % 2;
        transpose_tile(p.in[v ? 15 : 13] + (size_t)l * 128 * 64, 64, kt * 64, 0, 64, p.cw2T + (size_t)(l * 2 + v) * 64 * 128, 128, 0, 32, nullptr, lds); return; }
    i -= TR7 + TR8;
    if (i < TR9) { const int l = i / 32, kt = i % 32;
        transpose_tile(p.in[9] + (size_t)l * 2048 * 5144 + 5120, 5144, kt * 64, 0, 24, p.cgT + (size_t)l * 32 * 2048, 2048, 0, 32, nullptr, lds); return; }
    i -= TR9;
    transpose_tile(p.in[3], 16, i * 64, 0, 16, p.crT, 2048, 0, 32, nullptr, lds, p.crT + 32 * 2048);
}

DI void norm_mod_row(const P& p, int l, int row, int which, float (&hv)[32]) {
    const int lane = tidx() & 63, b = row / S;
    const float* x = ((l == 0 && which == 0) ? p.in[0] : p.xres) + (size_t)row * D;
    float ss = 0.f;
#pragma unroll
    for (int i = 0; i < 8; ++i) {
        const float4 v = *(const float4*)(x + i * 256 + lane * 4);
        hv[i * 4 + 0] = v.x; hv[i * 4 + 1] = v.y; hv[i * 4 + 2] = v.z; hv[i * 4 + 3] = v.w;
        ss += v.x * v.x + v.y * v.y + v.z * v.z + v.w * v.w;
    }
    ss = wave_sum(ss);
    const float r = rsqrtf(ss * (1.f / D) + EPS);
    const float* g = p.in[which ? 6 : 5] + (size_t)l * D;
    const float* sh = p.mod + ((size_t)l * 4 + b) * 12288 + (which ? 3 * D : 0);
    const float* sc = sh + D;
    bf16_t* h = p.hbuf + (size_t)row * D;
#pragma unroll
    for (int i = 0; i < 8; ++i) {
        const int col = i * 256 + lane * 4;
        const float4 gv = *(const float4*)(g + col), shv = *(const float4*)(sh + col), scv = *(const float4*)(sc + col);
        hv[i * 4 + 0] = hv[i * 4 + 0] * r * gv.x * (1.f + scv.x) + shv.x;
        hv[i * 4 + 1] = hv[i * 4 + 1] * r * gv.y * (1.f + scv.y) + shv.y;
        hv[i * 4 + 2] = hv[i * 4 + 2] * r * gv.z * (1.f + scv.z) + shv.z;
        hv[i * 4 + 3] = hv[i * 4 + 3] * r * gv.w * (1.f + scv.w) + shv.w;
        uint2 pk;
        pk.x = (unsigned)f2bf(hv[i * 4 + 0]) | ((unsigned)f2bf(hv[i * 4 + 1]) << 16);
        pk.y = (unsigned)f2bf(hv[i * 4 + 2]) | ((unsigned)f2bf(hv[i * 4 + 3]) << 16);
        *(uint2*)(h + col) = pk;
        if (which) {
            uint2 lo;
            lo.x = (unsigned)f2bf(hv[i * 4 + 0] - __uint_as_float(pk.x << 16)) | ((unsigned)f2bf(hv[i * 4 + 1] - __uint_as_float(pk.x & 0xffff0000u)) << 16);
            lo.y = (unsigned)f2bf(hv[i * 4 + 2] - __uint_as_float(pk.y << 16)) | ((unsigned)f2bf(hv[i * 4 + 3] - __uint_as_float(pk.y & 0xffff0000u)) << 16);
            *(uint2*)(p.hlo + (size_t)row * D + col) = lo;
        }
    }
}
DI void route_token(const P& p, int l, int row, const float (&lg)[16]) {
    {
        float aff[16], sc[16];
#pragma unroll
        for (int e = 0; e < 16; ++e) { aff[e] = sigmoidf_(lg[e]); sc[e] = aff[e] + p.in[4][e]; }
        int bg = 0; float bgs = -3e38f;
#pragma unroll
        for (int g = 0; g < 4; ++g) {
            float m1 = -3e38f, m2 = -3e38f;
#pragma unroll
            for (int j = 0; j < 4; ++j) { const float v = sc[g * 4 + j]; if (v > m1) { m2 = m1; m1 = v; } else if (v > m2) m2 = v; }
            const float gs = m1 + m2;
            if (gs > bgs) { bgs = gs; bg = g; }
        }
        float s4[4], a4[4];
#pragma unroll
        for (int g = 0; g < 4; ++g)
#pragma unroll
            for (int j = 0; j < 4; ++j) if (g == bg) { s4[j] = sc[g * 4 + j]; a4[j] = aff[g * 4 + j]; }
        int i1 = 0; float b1 = s4[0];
#pragma unroll
        for (int j = 1; j < 4; ++j) if (s4[j] > b1) { b1 = s4[j]; i1 = j; }
        int i2 = -1; float b2 = -3e38f;
#pragma unroll
        for (int j = 0; j < 4; ++j) if (j != i1 && s4[j] > b2) { b2 = s4[j]; i2 = j; }
        float w1 = 0.f, w2 = 0.f;
#pragma unroll
        for (int j = 0; j < 4; ++j) { if (j == i1) w1 = a4[j]; if (j == i2) w2 = a4[j]; }
        const float inv = 1.f / (w1 + w2);
        w1 *= inv; w2 *= inv;
        const int a = i1 < i2 ? i1 : i2, bb = i1 < i2 ? i2 : i1;
        const float wa = i1 < i2 ? w1 : w2, wb = i1 < i2 ? w2 : w1;
        const int pidx = (a == 0) ? (bb - 1) : (a == 1 ? (bb + 1) : 5);
        const int cls = bg * 6 + pidx;
        const unsigned pos = atomicAdd(p.ctl + CTL_CNT + l * 32 + cls, 1u);
        p.cls_tok[(size_t)cls * CLS_CAP + pos] = row;
        p.tokw[(size_t)row * 2 + 0] = wa; p.tokw[(size_t)row * 2 + 1] = wb;
    }
}


constexpr int N_NORM_GROUPS = T / 32;
DI void phase_norm_group(const P& p, int l, int which, int grp, float* lds) {
    typedef short bf16x8 __attribute__((ext_vector_type(8)));
    typedef float f32x16 __attribute__((ext_vector_type(16)));
    const int tid = tidx(), w = tid >> 6, lane = tid & 63, r = lane & 31, h = lane >> 5;
    const int R0 = grp * 32;
#pragma unroll 1
    for (int q = 0; q < 4; ++q) { float hv[32]; norm_mod_row(p, l, R0 + 4 * w + q, which, hv); }
    asm volatile("s_waitcnt vmcnt(0)" ::: "memory");
    __syncthreads();
    f32x16 acc;
#pragma unroll
    for (int i = 0; i < 16; ++i) acc[i] = 0.f;
    const bf16_t* brow = p.hbuf + (size_t)(R0 + r) * D + 8 * h;
    const bf16_t* blo = p.hlo + (size_t)(R0 + r) * D + 8 * h;
    const bf16_t* arow = (which ? p.crT : p.cgT + (size_t)l * 32 * 2048) + (size_t)r * 2048 + 8 * h;
#pragma unroll 4
    for (int ks = 16 * w; ks < 16 * w + 16; ++ks) {
        const bf16x8 bq = __builtin_bit_cast(bf16x8, *(const uint4*)(brow + 16 * ks)), aq = __builtin_bit_cast(bf16x8, *(const uint4*)(arow + 16 * ks));
        acc = __builtin_amdgcn_mfma_f32_32x32x16_bf16(aq, bq, acc, 0, 0, 0);
        if (which) {
            const bf16x8 al = __builtin_bit_cast(bf16x8, *(const uint4*)(arow + 32 * 2048 + 16 * ks)), bl = __builtin_bit_cast(bf16x8, *(const uint4*)(blo + 16 * ks));
            acc = __builtin_amdgcn_mfma_f32_32x32x16_bf16(al, bq, acc, 0, 0, 0);
            acc = __builtin_amdgcn_mfma_f32_32x32x16_bf16(aq, bl, acc, 0, 0, 0);
        }
    }
    float* red = lds;
    float* fin = lds + 8192;
#pragma unroll
    for (int i = 0; i < 16; ++i) red[(w * 16 + i) * 64 + lane] = acc[i];
    __syncthreads();
#pragma unroll
    for (int j = 0; j < 2; ++j) {
        const int idx = tid + NTHR * j, i = idx >> 6, ln = idx & 63;
        float v = 0.f;
#pragma unroll
        for (int ww = 0; ww < 8; ++ww) v += red[(ww * 16 + i) * 64 + ln];
        const int e = (i & 3) + 8 * (i >> 2) + 4 * (ln >> 5);
        fin[e * 33 + (ln & 31)] = v;
    }
    __syncthreads();
    if (!which) {
        for (int idx = tid; idx < 32 * 24; idx += NTHR) { const int row = idx / 24, e = idx % 24; p.proj[(size_t)(R0 + row) * LDP + OFF_GD + e] = f2bf(fin[e * 33 + row]); }
    } else if (tid < 32) {
        float lg[16];
#pragma unroll
        for (int e = 0; e < 16; ++e) lg[e] = fin[e * 33 + tid];
        route_token(p, l, R0 + tid, lg);
    }
    __syncthreads();
}

DI void cls_experts(int cls, int& ea, int& eb) {
    const int g = cls / 6, pi = cls % 6;
    const int a = pi < 3 ? 0 : (pi < 5 ? 1 : 2);
    const int b = pi < 3 ? pi + 1 : (pi < 5 ? pi - 1 : 3);
    ea = g * 4 + a; eb = g * 4 + b;
}
DI bool cls_find(unsigned* cnt, int ft, int& cls, int& mt, int& slot_base) {
    int base = 0;
    for (int c = 0; c < NCLS; ++c) {
        const int nt = ((int)__hip_atomic_load(cnt + c, __ATOMIC_RELAXED, __HIP_MEMORY_SCOPE_AGENT) + 255) >> 8;
        if (ft < base + nt) { cls = c; mt = ft - base; slot_base = base * 256; return true; }
        base += nt;
    }
    return false;
}
DI int cls_total_tiles(unsigned* cnt) { int base = 0; for (int c = 0; c < NCLS; ++c) base += ((int)__hip_atomic_load(cnt + c, __ATOMIC_RELAXED, __HIP_MEMORY_SCOPE_AGENT) + 255) >> 8; return base; }

constexpr int N_KMEAN_ITEMS = 4 * 8 * 16;
DI void phase_kmean_item(const P& p, int item, float* lds) {
    const int b = item / 128, h = (item / 16) % 8, blk = item % 16, tid = tidx(), d = tid & 63, part = tid >> 6;
    const bf16_t* k = p.proj + ((size_t)b * S + blk * 256 + part * 32) * LDP + OFF_KC + h * 64 + d;
    float s = 0.f;
    for (int i = 0; i < 32; ++i) s += bf2f(k[(size_t)i * LDP]);
    lds[tid] = s;
    __syncthreads();
    if (tid < 64) { float v = 0.f; for (int q = 0; q < 8; ++q) v += lds[tid + 64 * q]; p.kmean[(size_t)item * 64 + tid] = v * (1.f / 256.f); }
    __syncthreads();
}
namespace fa { DI unsigned cvtpk(float lo, float hi); typedef float f32x16 __attribute__((ext_vector_type(16))); DI void store_o(bf16_t* orow, int h, const f32x16 (&o)[2], float inv); }
constexpr int N_CMP_WITEMS = 2 * 64;
DI void phase_cmp_wave(const P& p, int l, int item) {
    typedef short bf16x8 __attribute__((ext_vector_type(8)));
    typedef float f32x16 __attribute__((ext_vector_type(16)));
    const int lane = tidx() & 63, r = lane & 31, h = lane >> 5;
    const int v = item >> 6, rb = item & 63;
    int R = rb * 32 + r; const bool valid = R < 2040; if (!valid) R = 2039;
    const int b = R / 510, hk = (R / 255) & 1, n = R % 255;
    const bf16_t* src = p.proj + ((size_t)b * S + 16 * n) * LDP + (v ? OFF_VDC : OFF_KDC) + hk * 64 + 8 * h;
    const float* pe = p.in[v ? 11 : 10] + (size_t)l * 2048 + 8 * h;
    const bf16_t* w1 = p.cw1T + (size_t)(l * 2 + v) * 128 * 2048 + (size_t)r * 2048 + 8 * h;
    f32x16 acc[4];
#pragma unroll
    for (int hb = 0; hb < 4; ++hb)
#pragma unroll
        for (int i = 0; i < 16; ++i) acc[hb][i] = 0.f;
#pragma unroll 2
    for (int ks = 0; ks < 128; ++ks) {
        const int ti = ks >> 2, d0 = (ks & 3) * 16;
        const uint4 xa = *(const uint4*)(src + (size_t)ti * LDP + d0);
        const float4 p0 = *(const float4*)(pe + ti * 64 + d0), p1 = *(const float4*)(pe + ti * 64 + d0 + 4);
        uint4 xb;
        xb.x = fa::cvtpk(__uint_as_float(xa.x << 16) + p0.x, __uint_as_float(xa.x & 0xffff0000u) + p0.y);
        xb.y = fa::cvtpk(__uint_as_float(xa.y << 16) + p0.z, __uint_as_float(xa.y & 0xffff0000u) + p0.w);
        xb.z = fa::cvtpk(__uint_as_float(xa.z << 16) + p1.x, __uint_as_float(xa.z & 0xffff0000u) + p1.y);
        xb.w = fa::cvtpk(__uint_as_float(xa.w << 16) + p1.z, __uint_as_float(xa.w & 0xffff0000u) + p1.w);
        const bf16x8 xf = __builtin_bit_cast(bf16x8, xb);
#pragma unroll
        for (int hb = 0; hb < 4; ++hb) {
            const bf16x8 wa = __builtin_bit_cast(bf16x8, *(const uint4*)(w1 + (size_t)hb * 32 * 2048 + 16 * ks));
            acc[hb] = __builtin_amdgcn_mfma_f32_32x32x16_bf16(wa, xf, acc[hb], 0, 0, 0);
        }
    }
    f32x16 o[2];
#pragma unroll
    for (int i = 0; i < 16; ++i) { o[0][i] = 0.f; o[1][i] = 0.f; }
    const bf16_t* w2 = p.cw2T + (size_t)(l * 2 + v) * 64 * 128 + (size_t)r * 128 + 4 * h;
#pragma unroll
    for (int hb = 0; hb < 4; ++hb)
#pragma unroll
        for (int s2 = 0; s2 < 2; ++s2) {
            uint4 pk;
            pk.x = fa::cvtpk(gelu_tanh(acc[hb][8 * s2]), gelu_tanh(acc[hb][8 * s2 + 1])); pk.y = fa::cvtpk(gelu_tanh(acc[hb][8 * s2 + 2]), gelu_tanh(acc[hb][8 * s2 + 3]));
            pk.z = fa::cvtpk(gelu_tanh(acc[hb][8 * s2 + 4]), gelu_tanh(acc[hb][8 * s2 + 5])); pk.w = fa::cvtpk(gelu_tanh(acc[hb][8 * s2 + 6]), gelu_tanh(acc[hb][8 * s2 + 7]));
            const bf16x8 pb = __builtin_bit_cast(bf16x8, pk);
#pragma unroll
            for (int dh = 0; dh < 2; ++dh) {
                const bf16_t* wp = w2 + (size_t)dh * 32 * 128 + hb * 32 + 16 * s2;
                const uint2 lo = *(const uint2*)wp, hi = *(const uint2*)(wp + 8);
                uint4 wv; wv.x = lo.x; wv.y = lo.y; wv.z = hi.x; wv.w = hi.y;
                o[dh] = __builtin_amdgcn_mfma_f32_32x32x16_bf16(__builtin_bit_cast(bf16x8, wv), pb, o[dh], 0, 0, 0);
            }
        }
    if (valid) fa::store_o((v ? p.vc : p.kc) + (((size_t)b * 2 + hk) * 256 + n) * 64, h, o, 1.f);
}


template <class C>
DI float attn_wave(const bf16_t* qrow, const C& cand, int ncand, bool has_sink, float sink, float* sl, float& lse_out) {
    const int lane = tidx() & 63;
    float q[64];
#pragma unroll
    for (int i = 0; i < 8; ++i) {
        const uint4 v = *(const uint4*)(qrow + i * 8);
        const unsigned u[4] = {v.x, v.y, v.z, v.w};
#pragma unroll
        for (int j = 0; j < 4; ++j) { q[i * 8 + 2 * j] = __uint_as_float(u[j] << 16); q[i * 8 + 2 * j + 1] = __uint_as_float(u[j] & 0xffff0000u); }
    }
    float mx = NEGF;
    for (int c0 = 0; c0 < ncand; c0 += 64) {
        const int c = c0 + lane;
        float s = NEGF;
        if (c < ncand) {
            const bf16_t *kr, *vr; float bias;
            if (cand.get(c, kr, vr, bias)) {
                float dot = 0.f;
#pragma unroll
                for (int i = 0; i < 8; ++i) {
                    const uint4 v = *(const uint4*)(kr + i * 8);
                    const unsigned u[4] = {v.x, v.y, v.z, v.w};
#pragma unroll
                    for (int j = 0; j < 4; ++j) { dot += q[i * 8 + 2 * j] * __uint_as_float(u[j] << 16); dot += q[i * 8 + 2 * j + 1] * __uint_as_float(u[j] & 0xffff0000u); }
                }
                s = dot * 0.125f + bias;
            }
            sl[c] = s;
        }
        mx = fmaxf(mx, s);
    }
    mx = wave_max(mx);
    if (has_sink) mx = fmaxf(mx, sink);
    float sum = 0.f;
    for (int c0 = 0; c0 < ncand; c0 += 64) {
        const int c = c0 + lane;
        if (c < ncand) { const float s = sl[c]; const float e = (s > -1e29f) ? __expf(s - mx) : 0.f; sl[c] = e; sum += e; }
    }
    sum = wave_sum(sum);
    if (has_sink) sum += __expf(sink - mx);
    sum = fmaxf(sum, 1.17549435e-38f);
    lse_out = mx + logf(sum);
    const float inv = 1.f / sum;
    for (int c0 = 0; c0 < ncand; c0 += 64) { const int c = c0 + lane; if (c < ncand) sl[c] *= inv; }
    wave_lds_sync();
    float o = 0.f;
    for (int c = 0; c < ncand; ++c) {
        const float pr = sl[c];
        if (pr != 0.f) { const bf16_t *kr, *vr; float bias; cand.get(c, kr, vr, bias); o += pr * bf2f(vr[lane]); }
    }
    return o;
}

struct BandCand {
    const bf16_t *kb, *vb; int t, r; const float* tab;
    DI bool get(int c, const bf16_t*& kr, const bf16_t*& vr, float& bias) const {
        const int kp = t - c * r; if (kp < 0) return false;
        kr = kb + (size_t)kp * LDP; vr = vb + (size_t)kp * LDP; bias = tab[t5_bucket(c * r) * 32]; return true;
    }
};
struct MobaCand {
    const bf16_t *kb, *vb; int t; const int* sel; const float* tab;
    DI bool get(int c, const bf16_t*& kr, const bf16_t*& vr, float& bias) const {
        const int blk = sel[c >> 8], j = c & 255;
        if (blk < 0) return false;
        const int kp = blk * 256 + j; if (kp > t) return false;
        kr = kb + (size_t)kp * LDP; vr = vb + (size_t)kp * LDP; bias = tab[t5_bucket(t - kp) * 32]; return true;
    }
};
struct CmpCand {
    const bf16_t *kc, *vc; int t;
    DI bool get(int c, const bf16_t*& kr, const bf16_t*& vr, float& bias) const {
        if (16 * c + 31 > t) return false;
        kr = kc + (size_t)c * 64; vr = vc + (size_t)c * 64; bias = 0.f; return true;
    }
};
struct SlcCand {
    const bf16_t *kb, *vb; int t; const int* sel; const float* tab;
    DI bool get(int c, const bf16_t*& kr, const bf16_t*& vr, float& bias) const {
        const int blk = sel[c >> 6]; if (blk < 0) return false;
        const int kp = blk * 64 + (c & 63); if (kp > t) return false;
        kr = kb + (size_t)kp * LDP; vr = vb + (size_t)kp * LDP; bias = tab[t5_bucket(t - kp) * 32]; return true;
    }
};

constexpr int N_ATT_WAVE_ITEMS = 3 * T * 8 + T * 8 + T * 8;
DI void phase_attn_wave_item(const P& p, int l, int item, float* sl, int* selw) {
    const int lane = tidx() & 63;
    const float* relb = p.in[2];
    if (item < 3 * T * 8) {
        const int cfg = item / (T * 8), rem = item % (T * 8), row = rem >> 3, h = rem & 7, b = row / S, t = row % S;
        const int r = cfg == 0 ? 1 : (cfg == 1 ? 4 : 16);
        BandCand cd{p.proj + (size_t)b * S * LDP + OFF_KA + h * 64, p.proj + (size_t)b * S * LDP + OFF_VA + h * 64, t, r, relb + 0 + h};
        float lse;
        const float o = attn_wave(p.proj + (size_t)row * LDP + OFF_QA + h * 64, cd, 129, false, 0.f, sl, lse);
        p.oA[((size_t)cfg * T + row) * 512 + h * 64 + lane] = f2bf(o);
        if (lane == 0) p.lseA[((size_t)cfg * T + row) * 8 + h] = lse;
        return;
    }
    item -= 3 * T * 8;
    if (item < T * 8) {
        const int row = item >> 3, hq = item & 7, kvh = hq >> 2, b = row / S, t = row % S;
        BandCand cd{p.proj + (size_t)b * S * LDP + OFF_KB + kvh * 64, p.proj + (size_t)b * S * LDP + OFF_VB + kvh * 64, t, 1, relb + 8 + hq};
        float lse;
        const float o = attn_wave(p.proj + (size_t)row * LDP + OFF_QB + hq * 64, cd, 128, true, p.in[16][l * 8 + hq], sl, lse);
        p.oB[(size_t)row * 512 + hq * 64 + lane] = f2bf(o);
        return;
    }
    item -= T * 8;
    {
        const int row = item >> 3, h = item & 7, b = row / S, t = row % S, cur = t >> 8;
        const bf16_t* qrow = p.proj + (size_t)row * LDP + OFF_QC + h * 64;
        float gate = NEGF;
        if (lane < cur) {
            const float* km = p.kmean + (((size_t)b * 8 + h) * 16 + lane) * 64;
            float dot = 0.f;
            for (int d = 0; d < 64; ++d) dot += bf2f(qrow[d]) * km[d];
            gate = dot;
        }
        int s0, s1, s2;
        { float v = gate; int idx = lane;
          for (int o = 32; o > 0; o >>= 1) { const float ov = __shfl_xor(v, o); const int oi = __shfl_xor(idx, o); if (ov > v || (ov == v && oi < idx)) { v = ov; idx = oi; } }
          s0 = (v > -1e29f) ? idx : -1; if (lane == idx) gate = -3e38f; }
        { float v = gate; int idx = lane;
          for (int o = 32; o > 0; o >>= 1) { const float ov = __shfl_xor(v, o); const int oi = __shfl_xor(idx, o); if (ov > v || (ov == v && oi < idx)) { v = ov; idx = oi; } }
          s1 = (v > -1e29f) ? idx : -1; if (lane == idx) gate = -3e38f; }
        { float v = gate; int idx = lane;
          for (int o = 32; o > 0; o >>= 1) { const float ov = __shfl_xor(v, o); const int oi = __shfl_xor(idx, o); if (ov > v || (ov == v && oi < idx)) { v = ov; idx = oi; } }
          s2 = (v > -1e29f) ? idx : -1; if (lane == idx) gate = -3e38f; }
        if (lane == 0) { selw[0] = s0; selw[1] = s1; selw[2] = s2; selw[3] = cur; }
        wave_lds_sync();
        MobaCand cd{p.proj + (size_t)b * S * LDP + OFF_KC + h * 64, p.proj + (size_t)b * S * LDP + OFF_VC + h * 64, t, selw, relb + 16 + h};
        float lse;
        const float o = attn_wave(qrow, cd, 1024, false, 0.f, sl, lse);
        p.oC[(size_t)row * 512 + h * 64 + lane] = f2bf(o);
    }
}
constexpr int N_NSA_ITEMS = 4 * 2 * S;
DI void phase_nsa_item(const P& p, int l, int item0, float* lds) {
    const int tid = tidx(), grp = tid >> 8, g = (tid >> 6) & 3, lane = tid & 63;
    const int item = item0 + grp;
    const int b = item / (2 * S), hk = (item / S) % 2, t = item % S, hq = hk * 4 + g;
    const int row = b * S + t, cur = t >> 6;
    float* gl = lds + grp * 4096;
    float* sl = gl + g * 1024;
    int* sel = (int*)(lds + 8192) + grp * 16;
    const bf16_t* qrow = p.proj + (size_t)row * LDP + OFF_QD + hq * 64;
    const float* relb = p.in[2];
    float lse;
    CmpCand cc{p.kc + ((size_t)b * 2 + hk) * 256 * 64, p.vc + ((size_t)b * 2 + hk) * 256 * 64, t};
    const float o_cmp = attn_wave(qrow, cc, 255, false, 0.f, sl, lse);
    __syncthreads();
    if (g == 0) {
        const int j = lane;
        float imp = 0.f;
        for (int n = 4 * j - 1; n <= 4 * j + 3; ++n)
            if (n >= 0 && n < 255) imp += gl[n] + gl[1024 + n] + gl[2048 + n] + gl[3072 + n];
        float val = (j == 0 || j == cur || j == cur - 1) ? 1e30f : (j <= cur ? imp : NEGF);
        for (int k = 0; k < 16; ++k) {
            float v = val; int idx = lane;
            for (int o = 32; o > 0; o >>= 1) { const float ov = __shfl_xor(v, o); const int oi = __shfl_xor(idx, o); if (ov > v || (ov == v && oi < idx)) { v = ov; idx = oi; } }
            if (lane == 0) sel[k] = (v > -1e29f) ? idx : -1;
            if (lane == idx) val = -3e38f;
        }
    }
    __syncthreads();
    SlcCand sc{p.proj + (size_t)b * S * LDP + OFF_KDS + hk * 64, p.proj + (size_t)b * S * LDP + OFF_VDS + hk * 64, t, sel, relb + 24 + hq};
    const float o_slc = attn_wave(qrow, sc, 1024, false, 0.f, sl, lse);
    BandCand wc{p.proj + (size_t)b * S * LDP + OFF_KDW + hk * 64, p.proj + (size_t)b * S * LDP + OFF_VDW + hk * 64, t, 1, relb + 24 + hq};
    const float o_win = attn_wave(qrow, wc, 512, false, 0.f, sl, lse);
    const bf16_t* gd = p.proj + (size_t)row * LDP + OFF_GD + hq * 3;
    const float g0 = sigmoidf_(bf2f(gd[0])), g1 = sigmoidf_(bf2f(gd[1])), g2 = sigmoidf_(bf2f(gd[2]));
    p.oD[(size_t)row * 512 + hq * 64 + lane] = f2bf(g0 * o_cmp + g1 * o_slc + g2 * o_win);
    __syncthreads();
}

constexpr int N_MIXN_WAVE_ITEMS = T * 4;
DI void phase_mixnorm_wave(const P& p, int item) {
    const int row = item >> 2, grp = item & 3, lane = tidx() & 63, h = lane >> 3;
    float v[8];
    if (grp == 0) {
        const float l0 = p.lseA[((size_t)0 * T + row) * 8 + h], l1 = p.lseA[((size_t)1 * T + row) * 8 + h], l2 = p.lseA[((size_t)2 * T + row) * 8 + h];
        const float m = fmaxf(l0, fmaxf(l1, l2));
        float w0 = __expf(l0 - m), w1 = __expf(l1 - m), w2 = __expf(l2 - m);
        const float inv = 1.f / (w0 + w1 + w2); w0 *= inv; w1 *= inv; w2 *= inv;
        const uint4 a = *(const uint4*)(p.oA + ((size_t)0 * T + row) * 512 + lane * 8);
        const uint4 bq = *(const uint4*)(p.oA + ((size_t)1 * T + row) * 512 + lane * 8);
        const uint4 c = *(const uint4*)(p.oA + ((size_t)2 * T + row) * 512 + lane * 8);
        const unsigned au[4] = {a.x, a.y, a.z, a.w}, bu[4] = {bq.x, bq.y, bq.z, bq.w}, cu[4] = {c.x, c.y, c.z, c.w};
#pragma unroll
        for (int j = 0; j < 4; ++j) {
            v[2 * j] = w0 * __uint_as_float(au[j] << 16) + w1 * __uint_as_float(bu[j] << 16) + w2 * __uint_as_float(cu[j] << 16);
            v[2 * j + 1] = w0 * __uint_as_float(au[j] & 0xffff0000u) + w1 * __uint_as_float(bu[j] & 0xffff0000u) + w2 * __uint_as_float(cu[j] & 0xffff0000u);
        }
    } else {
        const bf16_t* src = (grp == 1 ? p.oB : (grp == 2 ? p.oC : p.oD)) + (size_t)row * 512 + lane * 8;
        const uint4 a = *(const uint4*)src;
        const unsigned au[4] = {a.x, a.y, a.z, a.w};
#pragma unroll
        for (int j = 0; j < 4; ++j) { v[2 * j] = __uint_as_float(au[j] << 16); v[2 * j + 1] = __uint_as_float(au[j] & 0xffff0000u); }
    }
    float ss = 0.f;
#pragma unroll
    for (int j = 0; j < 8; ++j) ss += v[j] * v[j];
    ss = wave_sum(ss);
    const float r = rsqrtf(ss * (1.f / 512.f) + EPS);
    uint4 o;
    o.x = (unsigned)f2bf(v[0] * r) | ((unsigned)f2bf(v[1] * r) << 16);
    o.y = (unsigned)f2bf(v[2] * r) | ((unsigned)f2bf(v[3] * r) << 16);
    o.z = (unsigned)f2bf(v[4] * r) | ((unsigned)f2bf(v[5] * r) << 16);
    o.w = (unsigned)f2bf(v[6] * r) | ((unsigned)f2bf(v[7] * r) << 16);
    *(uint4*)(p.hbuf + (size_t)row * D + grp * 512 + lane * 8) = o;
}

DI void phase_final_wave(const P& p, int row, bool poison) {
    const int lane = tidx() & 63;
    const float* x = p.xres + (size_t)row * D;
    float4 v[8]; float ss = 0.f;
#pragma unroll
    for (int i = 0; i < 8; ++i) { v[i] = *(const float4*)(x + i * 256 + lane * 4); ss += v[i].x * v[i].x + v[i].y * v[i].y + v[i].z * v[i].z + v[i].w * v[i].w; }
    ss = wave_sum(ss);
    const float r = rsqrtf(ss * (1.f / D) + EPS);
#pragma unroll
    for (int i = 0; i < 8; ++i) {
        const float4 g = *(const float4*)(p.in[22] + i * 256 + lane * 4);
        float4 o; o.x = v[i].x * r * g.x; o.y = v[i].y * r * g.y; o.z = v[i].z * r * g.z; o.w = v[i].w * r * g.w;
        if (poison) { o.x = o.y = o.z = o.w = __uint_as_float(0x7fc00000u); }
        *(float4*)(p.out + (size_t)row * D + i * 256 + lane * 4) = o;
    }
}

#define XB_TMO      128
#define XB_XCNT(j)  (256  + 64 * (j))
#define XB_XSUB(j)  (1280 + 64 * (j))
#define XB_XGEN(j)  (2304 + 64 * (j))
#define XB_TOP      3328
#define XB_TOPGEN   3392
#define XCD_BAR_WORDS 3456
#define XB_SPIN_CAP (1u << 21)

__device__ __forceinline__ unsigned xb_ld(unsigned* p)              { return __hip_atomic_load(p, __ATOMIC_RELAXED, __HIP_MEMORY_SCOPE_AGENT); }
__device__ __forceinline__ unsigned xb_add(unsigned* p, unsigned v) { return __hip_atomic_fetch_add(p, v, __ATOMIC_RELAXED, __HIP_MEMORY_SCOPE_AGENT); }
__device__ __forceinline__ unsigned xb_xcc_id() { return (unsigned)__builtin_amdgcn_s_getreg((3 << 11) | 20) & 0xFu; }
#define XB_SPIN(cond, bar) do { unsigned _sp = 0; while (cond) { __builtin_amdgcn_s_sleep(1); \
    if ((++_sp & 255u) == 0u) { if (xb_ld(&(bar)[XB_TMO])) break; if (_sp > XB_SPIN_CAP) { atomicAdd(&(bar)[XB_TMO], 1u); break; } } } } while (0)

struct XcdBarrier { unsigned* bar; unsigned x; volatile LAS unsigned* st; };

__device__ __forceinline__ XcdBarrier xcd_barrier_post(unsigned* bar, volatile LAS unsigned* st) {
    XcdBarrier b; b.bar = bar; b.x = xb_xcc_id(); b.st = st;
    if (threadIdx.x == 0) (void)xb_add(&bar[XB_XCNT(b.x)], 1u);
    return b;
}
__device__ __forceinline__ void xcd_barrier_complete(unsigned* bar, unsigned x, unsigned& nloc, unsigned& nx) {
    const unsigned G = gridDim.x * gridDim.y * gridDim.z;
    unsigned sum, cnt, mine, sp = 0u;
    for (;;) {
        sum = 0u; cnt = 0u; mine = 0u;
#pragma unroll
        for (unsigned j = 0; j < 16; ++j) { const unsigned c = xb_ld(&bar[XB_XCNT(j)]); sum += c; cnt += (c > 0u) ? 1u : 0u; mine = (j == x) ? c : mine; }
        if (sum == G) break;
        __builtin_amdgcn_s_sleep(1);
        if ((++sp & 255u) == 0u) { if (xb_ld(&bar[XB_TMO])) break; if (sp > XB_SPIN_CAP) { atomicAdd(&bar[XB_TMO], 1u); break; } }
    }
    nloc = mine > 0u ? mine : 1u; nx = cnt > 0u ? cnt : 1u;
}
__device__ __forceinline__ void xcd_barrier(const XcdBarrier& b) {
    asm volatile("s_waitcnt vmcnt(0)" ::: "memory");
    __syncthreads();
    if (threadIdx.x == 0) {
        unsigned* bar = b.bar;
        __builtin_amdgcn_s_waitcnt(0);
        unsigned nloc = b.st[0], nx = b.st[1];
        if (nloc == 0u) { xcd_barrier_complete(bar, b.x, nloc, nx); b.st[0] = nloc; b.st[1] = nx; }
        const unsigned old = xb_add(&bar[XB_XSUB(b.x)], 1u);
        const unsigned gen = old / nloc;
        if (old + 1u == (gen + 1u) * nloc) {
            __builtin_amdgcn_fence(__ATOMIC_RELEASE, "agent");
            asm volatile("s_waitcnt vmcnt(0)" ::: "memory");
            const unsigned og = xb_add(&bar[XB_TOP], 1u);
            const unsigned tg = og / nx;
            if (og + 1u == (tg + 1u) * nx) xb_add(&bar[XB_TOPGEN], 1u);
            else XB_SPIN(xb_ld(&bar[XB_TOPGEN]) == tg, bar);
            __builtin_amdgcn_fence(__ATOMIC_ACQUIRE, "agent");
            xb_add(&bar[XB_XGEN(b.x)], 1u);
            asm volatile("s_waitcnt vmcnt(0)" ::: "memory");
        } else {
            XB_SPIN(xb_ld(&bar[XB_XGEN(b.x)]) == gen, bar);
            __builtin_amdgcn_fence(__ATOMIC_ACQUIRE, "agent");
            asm volatile("s_waitcnt vmcnt(0)" ::: "memory");
        }
    }
    __syncthreads();
}

namespace fa {
typedef short bf16x8 __attribute__((ext_vector_type(8)));
typedef short s16x4 __attribute__((ext_vector_type(4)));
typedef float f32x16 __attribute__((ext_vector_type(16)));
typedef __bf16 bf16x2_t __attribute__((ext_vector_type(2)));
typedef float f32x2_t __attribute__((ext_vector_type(2)));
constexpr int KP = 144, TILEB = 64 * KP;
constexpr int BT = 768;
constexpr int L_K = 0, L_V = 2 * TILEB, L_BT = 4 * TILEB, L_B32 = L_BT + 4 * BT * 4, L_IMPA = L_B32 + 512, L_IMPB = L_IMPA + 64 * 64 * 4, L_SEL = L_IMPB + 64 * 64 * 4, L_TICKET = L_SEL + 512, L_OACC = L_TICKET + 512, L_END = L_OACC + 16 * 512 * 4;
static_assert(L_END <= 131072, "attention LDS map");
constexpr float LOG2E = 1.4426950408889634f, SC2 = 0.125f * LOG2E, LN2 = 0.6931471805599453f;
#define FA_MFMA(a, b, c) __builtin_amdgcn_mfma_f32_32x32x16_bf16((a), (b), (c), 0, 0, 0)
DI unsigned cvtpk(float lo, float hi) { f32x2_t v = {lo, hi}; bf16x2_t b = __builtin_convertvector(v, bf16x2_t); return __builtin_bit_cast(unsigned, b); }
DI s16x4 vtr(const LAS char* p) { return __builtin_bit_cast(s16x4, __builtin_amdgcn_ds_read_tr16_b64_v4i16((LAS s16x4*)p)); }
DI float xhalf(float v) { return __shfl_xor(v, 32); }
DI float quad_sum(float v) {
    v += __builtin_bit_cast(float, __builtin_amdgcn_update_dpp(0, __builtin_bit_cast(int, v), 0xB1, 0xF, 0xF, true));
    v += __builtin_bit_cast(float, __builtin_amdgcn_update_dpp(0, __builtin_bit_cast(int, v), 0x4E, 0xF, 0xF, true));
    return v;
}

struct Pass {
    const bf16_t* kb; const bf16_t* vb;
    int kpitch, kstride, nkeys;
    int t_lo, t_hi;
    int W;
    int msh;
};
typedef unsigned u32x4 __attribute__((ext_vector_type(4)));
DI void stage_load(const Pass& ps, int jt, int tid, u32x4& kreg, u32x4& vreg) {
    const int key = tid >> 3, chunk = tid & 7;
    int kidx = jt * 64 + key; kidx = kidx < 0 ? 0 : (kidx >= ps.nkeys ? ps.nkeys - 1 : kidx);
    const size_t off = (size_t)(kidx * ps.kstride) * ps.kpitch + chunk * 8;
    kreg = *(const u32x4*)(ps.kb + off); vreg = *(const u32x4*)(ps.vb + off);
}
DI void stage_store(LAS char* base, int buf, int tid, const u32x4& kreg, const u32x4& vreg) {
    const int key = tid >> 3, chunk = tid & 7;
    *(LAS u32x4*)(base + L_K + buf * TILEB + key * KP + chunk * 16) = kreg;
    *(LAS u32x4*)(base + L_V + buf * TILEB + key * KP + chunk * 16) = vreg;
}
template <int MODE>
DI void flash_pass(LAS char* base, const Pass& ps, const bf16x8 (&qf)[4], int qidx, int tg, unsigned long long selmask, int wq_lo, int wq_hi,
                   f32x16 (&o)[2], float& m, float& l, float pscale, int qloc) {
    constexpr bool BAND = MODE & 1, MASKED = MODE & 2, BIAS = MODE & 4, STATS = MODE & 8, IMP = MODE & 16;
    const int tid = tidx(), lane = tid & 63, r = lane & 31, h = lane >> 5;
    const int n = ps.t_hi - ps.t_lo;
    if (n <= 0) return;
    u32x4 kreg, vreg;
    stage_load(ps, ps.t_lo, tid, kreg, vreg);
    stage_store(base, 0, tid, kreg, vreg);
    __syncthreads();
    const LAS float* bt = (const LAS float*)(base + L_BT) + tg * BT;
    const LAS float* b32 = (const LAS float*)(base + L_B32) + tg * 32;
    for (int it = 0; it < n; ++it) {
        const int jt = ps.t_lo + it, buf = it & 1;
        if (it + 1 < n) stage_load(ps, jt + 1, tid, kreg, vreg);
        const int k0 = jt * 64;
        bool lane_ok = true;
        if constexpr (MASKED) lane_ok = (selmask >> (jt >> ps.msh)) & 1ull;
        bool need;
        if constexpr (BAND) need = (k0 <= wq_hi) && (k0 + 63 >= wq_lo - ps.W);
        else need = (k0 <= wq_hi);
        if constexpr (MASKED) need = need && (__builtin_amdgcn_ballot_w64(lane_ok) != 0ull);
        if (need) {
            const LAS char* Kt = base + L_K + buf * TILEB; const LAS char* Vt = base + L_V + buf * TILEB;
            f32x16 st[2];
#pragma unroll
            for (int kb = 0; kb < 2; ++kb) {
#pragma unroll
                for (int i = 0; i < 16; ++i) st[kb][i] = 0.f;
#pragma unroll
                for (int s = 0; s < 4; ++s) { const bf16x8 kf = *(const LAS bf16x8*)(Kt + (kb * 32 + r) * KP + (2 * s + h) * 16); st[kb] = FA_MFMA(kf, qf[s], st[kb]); }
            }
            const int d0 = qidx - k0 - 4 * h;
            const bool full = BAND ? (wq_hi - k0 <= ps.W && wq_lo - (k0 + 63) >= 0) : (wq_lo - (k0 + 63) >= 0);
            float bv0 = 0.f, bv1 = 0.f; int t1 = 0x7fffffff; bool far = false;
            if constexpr (BIAS) {
                far = (wq_hi - k0) >= BT;
                if (far) {
                    int dmin = wq_lo - (k0 + 63); dmin = dmin < 0 ? 0 : dmin;
                    const int b0 = 28 + (dmin >= 825) + (dmin >= 1117) + (dmin >= 1513);
                    t1 = b0 == 28 ? 825 : (b0 == 29 ? 1117 : (b0 == 30 ? 1513 : 0x7fffffff));
                    bv0 = b32[b0]; bv1 = b32[b0 < 31 ? b0 + 1 : 31];
                }
            }
            float mx = -INFINITY;
#pragma unroll
            for (int kb = 0; kb < 2; ++kb)
#pragma unroll
                for (int i = 0; i < 16; ++i) {
                    const int d = d0 - (32 * kb + (i & 3) + 8 * (i >> 2));
                    float v = st[kb][i] * SC2;
                    if constexpr (BIAS) {
                        if (far) v += (d >= t1) ? bv1 : bv0;
                        else { const unsigned dc = (unsigned)d < (unsigned)BT ? (unsigned)d : (unsigned)(BT - 1); v += bt[dc]; }
                    }
                    bool ok = lane_ok;
                    if (!full) { if constexpr (BAND) ok = ok && ((unsigned)d <= (unsigned)ps.W); else ok = ok && (d >= 0); }
                    v = ok ? v : -INFINITY;
                    st[kb][i] = v; mx = fmaxf(mx, v);
                }
            mx = fmaxf(mx, xhalf(mx));
            const float mn = fmaxf(m, mx), alpha = __builtin_amdgcn_exp2f(m - mn);
            m = mn;
            float ls = 0.f;
#pragma unroll
            for (int kb = 0; kb < 2; ++kb)
#pragma unroll
                for (int i = 0; i < 16; ++i) { const float pe = __builtin_amdgcn_exp2f(st[kb][i] - mn); st[kb][i] = pe; ls += pe; }
            l = l * alpha + ls;
            if constexpr (IMP) {
                LAS float* impA = (LAS float*)(base + L_IMPA) + qloc * 64; LAS float* impB = (LAS float*)(base + L_IMPB) + qloc * 64;
#pragma unroll
                for (int kb = 0; kb < 2; ++kb)
#pragma unroll
                    for (int c4 = 0; c4 < 4; ++c4) {
                        const float s4 = quad_sum((st[kb][4 * c4] + st[kb][4 * c4 + 1]) + (st[kb][4 * c4 + 2] + st[kb][4 * c4 + 3]));
                        const float sp = quad_sum(st[kb][4 * c4 + 3]);
                        const int j = 16 * jt + 8 * kb + 2 * c4 + h;
                        if ((lane & 3) == 0) { impA[j] = s4 * pscale; if (j + 1 < 64) impB[j + 1] = sp * pscale; }
                    }
            }
            if constexpr (!STATS) {
                if (__builtin_amdgcn_ballot_w64(alpha != 1.0f) != 0ull) {
#pragma unroll
                    for (int i = 0; i < 16; ++i) { o[0][i] *= alpha; o[1][i] *= alpha; }
                }
                bf16x8 pf[2][2];
#pragma unroll
                for (int kb = 0; kb < 2; ++kb)
#pragma unroll
                    for (int s = 0; s < 2; ++s) {
                        uint4 pk; pk.x = cvtpk(st[kb][8 * s], st[kb][8 * s + 1]); pk.y = cvtpk(st[kb][8 * s + 2], st[kb][8 * s + 3]);
                        pk.z = cvtpk(st[kb][8 * s + 4], st[kb][8 * s + 5]); pk.w = cvtpk(st[kb][8 * s + 6], st[kb][8 * s + 7]);
                        pf[kb][s] = __builtin_bit_cast(bf16x8, pk);
                    }
                const int i16 = lane & 15, q = i16 >> 2, pp = i16 & 3, g16 = (lane >> 4) & 1;
                const LAS char* vbase = Vt + (4 * h + q) * KP + g16 * 32 + 8 * pp;
#pragma unroll
                for (int dh = 0; dh < 2; ++dh)
#pragma unroll
                    for (int kb = 0; kb < 2; ++kb)
#pragma unroll
                        for (int s = 0; s < 2; ++s) {
                            const LAS char* va = vbase + (kb * 32 + 16 * s) * KP + dh * 64;
                            const s16x4 lo = vtr(va), hi = vtr(va + 8 * KP);
                            const bf16x8 vf = __builtin_shufflevector(lo, hi, 0, 1, 2, 3, 4, 5, 6, 7);
                            o[dh] = FA_MFMA(vf, pf[kb][s], o[dh]);
                        }
            }
        }
        if (it + 1 < n) stage_store(base, buf ^ 1, tid, kreg, vreg);
        __syncthreads();
    }
}
DI void load_q(const bf16_t* qrow, int h, bf16x8 (&qf)[4]) {
#pragma unroll
    for (int s = 0; s < 4; ++s) qf[s] = __builtin_bit_cast(bf16x8, *(const uint4*)(qrow + 16 * s + 8 * h));
}
DI void store_o(bf16_t* orow, int h, const f32x16 (&o)[2], float inv) {
#pragma unroll
    for (int dh = 0; dh < 2; ++dh)
#pragma unroll
        for (int c4 = 0; c4 < 4; ++c4) {
            uint2 pk; pk.x = cvtpk(o[dh][4 * c4] * inv, o[dh][4 * c4 + 1] * inv); pk.y = cvtpk(o[dh][4 * c4 + 2] * inv, o[dh][4 * c4 + 3] * inv);
            *(uint2*)(orow + dh * 32 + 8 * c4 + 4 * h) = pk;
        }
}
DI void build_bias(LAS char* base, const float* relb, int col0, int ng, int dscale) {
    const int tid = tidx();
    LAS float* bt = (LAS float*)(base + L_BT); LAS float* b32 = (LAS float*)(base + L_B32);
    for (int e = tid; e < ng * BT; e += NTHR) { const int g = e / BT, d = e % BT; bt[e] = relb[t5_bucket(d * dscale) * 32 + col0 + g] * LOG2E; }
    if (tid < ng * 32) { const int g = tid >> 5, bk = tid & 31; b32[tid] = relb[bk * 32 + col0 + g] * LOG2E; }
    __syncthreads();
}

DI void item_band(const P& p, LAS char* base, const bf16_t* qb_, int qtok_stride, int q0, const Pass& ps, const float* relb, int col, int dscale,
                  bool has_sink, float sink, bf16_t* ob, float* lse_out  , int lse_stride) {
    const int tid = tidx(), lane = tid & 63, w = tid >> 6, r = lane & 31, h = lane >> 5;
    build_bias(base, relb, col, 1, dscale);
    const int qidx = q0 + w * 32 + r;
    bf16x8 qf[4]; load_q(qb_ + (size_t)qidx * qtok_stride * LDP, h, qf);
    f32x16 o[2];
#pragma unroll
    for (int i = 0; i < 16; ++i) { o[0][i] = 0.f; o[1][i] = 0.f; }
    float m = has_sink ? sink * LOG2E : -1e30f, l = (has_sink && h == 0) ? 1.f : 0.f;
    flash_pass<1 | 4>(base, ps, qf, qidx, 0, 0ull, q0 + w * 32, q0 + w * 32 + 31, o, m, l, 1.f, 0);
    l += xhalf(l);
    const float lt = fmaxf(l, 1.17549435e-38f);
    store_o(ob + (size_t)qidx * qtok_stride * 512, h, o, 1.f / lt);
    if (lse_out && h == 0) lse_out[(size_t)qidx * qtok_stride * lse_stride] = (m + __builtin_amdgcn_logf(lt)) * LN2;
}
DI void item_moba(const P& p, LAS char* base, int b, int hd, int qb) {
    const int tid = tidx(), lane = tid & 63, w = tid >> 6, r = lane & 31, h = lane >> 5;
    build_bias(base, p.in[2], 16 + hd, 1, 1);
    const int qidx = qb * 256 + w * 32 + r;
    const size_t row = (size_t)b * S + qidx;
    bf16x8 qf[4]; load_q(p.proj + row * LDP + OFF_QC + hd * 64, h, qf);
    f32x16 ga;
#pragma unroll
    for (int i = 0; i < 16; ++i) ga[i] = 0.f;
    const float* km = p.kmean + (((size_t)b * 8 + hd) * 16 + (r & 15)) * 64;
#pragma unroll
    for (int s = 0; s < 4; ++s) {
        const float4 a = *(const float4*)(km + 16 * s + 8 * h), c = *(const float4*)(km + 16 * s + 8 * h + 4);
        const float f[8] = {a.x, a.y, a.z, a.w, c.x, c.y, c.z, c.w};
        unsigned hi[4], lo[4];
#pragma unroll
        for (int j = 0; j < 4; ++j) {
            const float x0 = r < 16 ? f[2 * j] : 0.f, x1 = r < 16 ? f[2 * j + 1] : 0.f;
            const unsigned ph = cvtpk(x0, x1); hi[j] = ph;
            lo[j] = cvtpk(x0 - __uint_as_float(ph << 16), x1 - __uint_as_float(ph & 0xffff0000u));
        }
        uint4 uh; uh.x = hi[0]; uh.y = hi[1]; uh.z = hi[2]; uh.w = hi[3];
        uint4 ul; ul.x = lo[0]; ul.y = lo[1]; ul.z = lo[2]; ul.w = lo[3];
        ga = FA_MFMA(__builtin_bit_cast(bf16x8, uh), qf[s], ga);
        ga = FA_MFMA(__builtin_bit_cast(bf16x8, ul), qf[s], ga);
    }
    float gv[16];
#pragma unroll
    for (int i = 0; i < 8; ++i) {
        const float mine = ga[i], other = xhalf(mine);
        const int c = i >> 2, e = i & 3;
        gv[8 * c + e] = h ? other : mine; gv[8 * c + 4 + e] = h ? mine : other;
    }
    unsigned msk = 1u << qb;
#pragma unroll
    for (int k = 0; k < 3; ++k) {
        float best = -INFINITY; int bi = -1;
#pragma unroll
        for (int nn = 0; nn < 16; ++nn) if (nn < qb && gv[nn] > best) { best = gv[nn]; bi = nn; }
#pragma unroll
        for (int nn = 0; nn < 16; ++nn) if (nn == bi) gv[nn] = -INFINITY;
        if (bi >= 0) msk |= 1u << bi;
    }
    Pass ps{p.proj + (size_t)b * S * LDP + OFF_KC + hd * 64, p.proj + (size_t)b * S * LDP + OFF_VC + hd * 64, LDP, 1, S, 0, 4 * (qb + 1), 0, 2};
    f32x16 o[2];
#pragma unroll
    for (int i = 0; i < 16; ++i) { o[0][i] = 0.f; o[1][i] = 0.f; }
    float m = -1e30f, l = 0.f;
    flash_pass<2 | 4>(base, ps, qf, qidx, 0, (unsigned long long)msk, qb * 256 + w * 32, qb * 256 + w * 32 + 31, o, m, l, 1.f, 0);
    l += xhalf(l);
    store_o(p.oC + row * 512 + hd * 64, h, o, 1.f / fmaxf(l, 1.17549435e-38f));
}
DI void item_nsa(const P& p, LAS char* base, int b, int hk, int c) {
    const int tid = tidx(), lane = tid & 63, w = tid >> 6, r = lane & 31, h = lane >> 5, qq = r >> 2, g = r & 3;
    const int qloc = 8 * w + qq, qpos = c * 64 + qloc, hq = hk * 4 + g;
    const size_t row = (size_t)b * S + qpos;
    { LAS float* z = (LAS float*)(base + L_IMPA); for (int e = tid; e < 2 * 64 * 64; e += NTHR) z[e] = 0.f; }
    build_bias(base, p.in[2], 24 + hk * 4, 4, 1);
    bf16x8 qf[4]; load_q(p.proj + row * LDP + OFF_QD + hq * 64, h, qf);
    const bf16_t* gd = p.proj + row * LDP + OFF_GD + hq * 3;
    LAS unsigned* oacc = (LAS unsigned*)(base + L_OACC) + tid;
    f32x16 o[2];
    const int wq_lo = c * 64 + 8 * w, wq_hi = wq_lo + 7;
    {
        int nmax = (qpos - 31) >> 4; nmax = nmax > 254 ? 254 : nmax;
        const int wn_lo = (wq_lo - 31) >> 4, wn_hi = (wq_hi - 31) >> 4;
        int thi = ((c * 64 + 63 - 31) >> 4) / 64 + 1; thi = thi > 4 ? 4 : thi;
        Pass ps{p.kc + ((size_t)b * 2 + hk) * 256 * 64, p.vc + ((size_t)b * 2 + hk) * 256 * 64, 64, 1, 255, 0, thi, 0, 0};
        float m = -1e30f, l = 0.f;
        flash_pass<8>(base, ps, qf, nmax, 0, 0ull, wn_lo, wn_hi, o, m, l, 1.f, qloc);
        l += xhalf(l);
        const float inv = 1.f / fmaxf(l, 1.17549435e-38f);
#pragma unroll
        for (int i = 0; i < 16; ++i) { o[0][i] = 0.f; o[1][i] = 0.f; }
        float l2 = 0.f;
        flash_pass<16>(base, ps, qf, nmax, 0, 0ull, wn_lo, wn_hi, o, m, l2, inv, qloc);
        const float sc = sigmoidf_(bf2f(gd[0])) * inv;
#pragma unroll
        for (int dh = 0; dh < 2; ++dh)
#pragma unroll
            for (int i = 0; i < 8; ++i) oacc[(dh * 8 + i) * 512] = cvtpk(o[dh][2 * i] * sc, o[dh][2 * i + 1] * sc);
    }
    {
        const LAS float* impA = (const LAS float*)(base + L_IMPA); const LAS float* impB = (const LAS float*)(base + L_IMPB);
        LAS unsigned long long* sel = (LAS unsigned long long*)(base + L_SEL);
        for (int k = 0; k < 8; ++k) {
            const int ql = 8 * w + k, j = lane;
            const float val = (j == 0 || j == c || j == c - 1) ? 1e30f : (j <= c ? impA[ql * 64 + j] + impB[ql * 64 + j] : -1e30f);
            int rank = 0;
#pragma unroll 8
            for (int jj = 0; jj < 64; ++jj) { const float ov = __builtin_bit_cast(float, __builtin_amdgcn_readlane(__builtin_bit_cast(int, val), jj)); rank += (ov > val || (ov == val && jj < j)) ? 1 : 0; }
            const unsigned long long mk = __builtin_amdgcn_ballot_w64(rank < 16 && val > -1e29f);
            if (lane == 0) sel[ql] = mk;
        }
        __syncthreads();
    }
    const unsigned long long selmask = ((const LAS unsigned long long*)(base + L_SEL))[qloc];
    {
        Pass ps{p.proj + (size_t)b * S * LDP + OFF_KDS + hk * 64, p.proj + (size_t)b * S * LDP + OFF_VDS + hk * 64, LDP, 1, S, 0, c + 1, 0, 0};
#pragma unroll
        for (int i = 0; i < 16; ++i) { o[0][i] = 0.f; o[1][i] = 0.f; }
        float m = -1e30f, l = 0.f;
        flash_pass<2 | 4>(base, ps, qf, qpos, g, selmask, wq_lo, wq_hi, o, m, l, 1.f, qloc);
        l += xhalf(l);
        const float sc = sigmoidf_(bf2f(gd[1])) / fmaxf(l, 1.17549435e-38f);
#pragma unroll
        for (int dh = 0; dh < 2; ++dh)
#pragma unroll
            for (int i = 0; i < 8; ++i) { const unsigned pv = oacc[(dh * 8 + i) * 512];
                oacc[(dh * 8 + i) * 512] = cvtpk(__uint_as_float(pv << 16) + o[dh][2 * i] * sc, __uint_as_float(pv & 0xffff0000u) + o[dh][2 * i + 1] * sc); }
    }
    {
        Pass ps{p.proj + (size_t)b * S * LDP + OFF_KDW + hk * 64, p.proj + (size_t)b * S * LDP + OFF_VDW + hk * 64, LDP, 1, S, (c - 8 > 0 ? c - 8 : 0), c + 1, 511, 0};
#pragma unroll
        for (int i = 0; i < 16; ++i) { o[0][i] = 0.f; o[1][i] = 0.f; }
        float m = -1e30f, l = 0.f;
        flash_pass<1 | 4>(base, ps, qf, qpos, g, 0ull, wq_lo, wq_hi, o, m, l, 1.f, qloc);
        l += xhalf(l);
        const float sc = sigmoidf_(bf2f(gd[2])) / fmaxf(l, 1.17549435e-38f);
        bf16_t* orow = p.oD + row * 512 + hq * 64;
#pragma unroll
        for (int dh = 0; dh < 2; ++dh)
#pragma unroll
            for (int c4 = 0; c4 < 4; ++c4) {
                uint2 pk; const unsigned p0 = oacc[(dh * 8 + 2 * c4) * 512], p1 = oacc[(dh * 8 + 2 * c4 + 1) * 512];
                pk.x = cvtpk(__uint_as_float(p0 << 16) + o[dh][4 * c4] * sc, __uint_as_float(p0 & 0xffff0000u) + o[dh][4 * c4 + 1] * sc);
                pk.y = cvtpk(__uint_as_float(p1 << 16) + o[dh][4 * c4 + 2] * sc, __uint_as_float(p1 & 0xffff0000u) + o[dh][4 * c4 + 3] * sc);
                *(uint2*)(orow + dh * 32 + 8 * c4 + 4 * h) = pk;
            }
    }
}
constexpr int N_ITEMS = 3072;
DI void run_item(const P& p, int l, LAS char* base, int f) {
    if (f < 1024) {
        const int k = f >> 4, slot = f & 15;
        if (slot < 8) item_nsa(p, base, slot >> 1, slot & 1, 63 - k);
        else { const int idx = k * 8 + (slot - 8); item_moba(p, base, (idx & 31) >> 3, idx & 7, 15 - (idx >> 5)); }
    } else if (f < 1536) {
        const int i = f - 1024, qb = i & 15, hq = (i >> 4) & 7, b = i >> 7, kvh = hq >> 2;
        const bf16_t* bb = p.proj + (size_t)b * S * LDP;
        Pass ps{bb + OFF_KB + kvh * 64, bb + OFF_VB + kvh * 64, LDP, 1, S, (4 * qb - 2 > 0 ? 4 * qb - 2 : 0), 4 * qb + 4, 127, 0};
        item_band(p, base, bb + OFF_QB + hq * 64, 1, qb * 256, ps, p.in[2], 8 + hq, 1, true, p.in[16][l * 8 + hq], p.oB + (size_t)b * S * 512 + hq * 64, nullptr, 0);
    } else {
        const int i = f - 1536, cfg = i >> 9, j = i & 511, sub = j & 15, hd = (j >> 4) & 7, b = j >> 7;
        const int rr = cfg == 0 ? 1 : (cfg == 1 ? 4 : 16), nblk = 16 / rr;
        const int res = sub / nblk, blk = sub % nblk;
        const bf16_t* bb = p.proj + ((size_t)b * S + res) * LDP;
        Pass ps{bb + OFF_KA + hd * 64, bb + OFF_VA + hd * 64, LDP, rr, S / rr, (4 * blk - 2 > 0 ? 4 * blk - 2 : 0), 4 * blk + 4, 128, 0};
        item_band(p, base, bb + OFF_QA + hd * 64, rr, blk * 256, ps, p.in[2], hd, rr, false, 0.f,
                  p.oA + ((size_t)cfg * T + (size_t)b * S + res) * 512 + hd * 64, p.lseA + ((size_t)cfg * T + (size_t)b * S + res) * 8 + hd, 8);
    }
}
DI void phase_attention(const P& p, int l, float* lds) {
    LAS char* base = (LAS char*)lds;
    unsigned* ctr = p.ctl + CTL_Q + l;
    for (;;) {
        if (tidx() == 0) *(LAS int*)(base + L_TICKET) = (int)atomicAdd(ctr, 1u);
        __syncthreads();
        const int f = __builtin_amdgcn_readfirstlane(*(LAS int*)(base + L_TICKET));
        __syncthreads();
        if (f >= N_ITEMS) break;
        run_item(p, l, base, f);
    }
}
}

namespace pg8 {
#define PG8_LAS __attribute__((address_space(3)))
typedef short bf16x8 __attribute__((ext_vector_type(8)));
typedef float f32x4 __attribute__((ext_vector_type(4)));
typedef unsigned u32x4 __attribute__((ext_vector_type(4)));
constexpr int BM = 256, BK = 64, HALF = 128, HTB = HALF * BK * 2  , STAGE_BYTES = 8 * HTB, NXCD = 8, WGM = 8;

__device__ __forceinline__ int lds_byte(int r, int c) { const int st = (r >> 4) * 2 + (c >> 5), rr = r & 15, cc = c & 31, ob = rr * 64 + cc * 2; return st * 1024 + (ob ^ (((ob >> 9) & 1) << 5)); }
__device__ __forceinline__ void stage_rc(int b, int& R, int& C) { const int st = b / 1024, sb = b % 1024, swz = sb ^ (((sb >> 9) & 1) << 5); R = (st >> 1) * 16 + swz / 64; C = (st & 1) * 32 + (swz % 64) / 2; }
__device__ __forceinline__ int perm32(int rho) { const int n = rho >> 4, i = rho & 15; return 8 * (i >> 2) + 4 * n + (i & 3); }

struct Unit { int pm, pn; const char* A; const char* Ba; const char* Bb; int aux0, aux1, aux2; };
struct Shape { int K, lda, ldb, ksplit; };

__device__ __forceinline__ unsigned cvt_pk_bf16(float lo, float hi) { unsigned r; asm volatile("v_cvt_pk_bf16_f32 %0, %1, %2" : "=v"(r) : "v"(lo), "v"(hi)); return r; }

template <class Epi, class Sched, bool GATHER, bool ALIGN_EPI = true>
__device__ __forceinline__ void gemm_phase(PG8_LAS unsigned char* lds, const Shape g, const Sched& S, const Epi& E) {
    const int tid = tidx(), wid = __builtin_amdgcn_readfirstlane(tid >> 6), lane = tid & 63, wr = wid >> 2, wc = wid & 3, fr = lane & 15, fq = lane >> 4;
    const int nt = g.K / BK;
    unsigned voffA[2], voffA1[2], voffB[2];
#pragma unroll
    for (int i = 0; i < 2; ++i) { int R, C; stage_rc(tid * 16 + i * 8192, R, C); const int Rb = Epi::PERM ? ((R & ~31) + perm32(R & 31)) : R;
        voffA[i] = (unsigned)(R * g.lda + C) * 2u; voffA1[i] = voffA[i]; voffB[i] = (unsigned)(Rb * g.ldb + C) * 2u; }
    const size_t kstep = (size_t)(BK * 2);
    const size_t hstepA = GATHER ? 0 : (size_t)HALF * g.lda * 2;
    const size_t hstepB = (size_t)HALF * g.ldb * 2;
    const unsigned ldsw = (unsigned)wid * 1024u;
    const int aoff = lds_byte(wr * 64 + fr, fq * 8), boff = lds_byte(wc * 32 + fr, fq * 8);
#define PG8_SA(b, h) (((b) * 2 + (h)) * HTB)
#define PG8_SB(b, h) ((4 + (b) * 2 + (h)) * HTB)
#define PG8_STAGE(bufoff, gbase, voff) do { _Pragma("unroll") for (int _i = 0; _i < 2; ++_i) \
        __builtin_amdgcn_global_load_lds((const unsigned*)((const char*)(gbase) + (voff)[_i]), (PG8_LAS unsigned*)(lds + (bufoff) + ldsw + _i * 8192), 16, 0, 0); } while (0)
#define PG8_STAGE_A0(bufoff, gbase) PG8_STAGE(bufoff, gbase, voffA)
#define PG8_STAGE_A1(bufoff, gbase) do { if constexpr (GATHER) PG8_STAGE(bufoff, gbase, voffA1); else PG8_STAGE(bufoff, (gbase) + hstepA, voffA); } while (0)
#define PG8_LDA(dst, b, h) do { _Pragma("unroll") for (int m = 0; m < 4; ++m) _Pragma("unroll") for (int k = 0; k < 2; ++k) dst[m][k] = *(const PG8_LAS bf16x8*)(lds + PG8_SA(b, h) + aoff + m * 2048 + k * 1024); } while (0)
#define PG8_LDB(dst, b, h) do { _Pragma("unroll") for (int n = 0; n < 2; ++n) _Pragma("unroll") for (int k = 0; k < 2; ++k) dst[n][k] = *(const PG8_LAS bf16x8*)(lds + PG8_SB(b, h) + boff + n * 2048 + k * 1024); } while (0)
#define PG8_MMA(ai, bj, At, Bt) do { __builtin_amdgcn_s_setprio(1); _Pragma("unroll") for (int m = 0; m < 4; ++m) _Pragma("unroll") for (int n = 0; n < 2; ++n) _Pragma("unroll") for (int k = 0; k < 2; ++k) \
        acc[ai][bj][m][n] = __builtin_amdgcn_mfma_f32_16x16x32_bf16(Bt[n][k], At[m][k], acc[ai][bj][m][n], 0, 0, 0); __builtin_amdgcn_s_setprio(0); } while (0)
#define PG8_WAIT_V(n) asm volatile("s_waitcnt vmcnt(" #n ")" ::: "memory")
#define PG8_WAIT_L(n) asm volatile("s_waitcnt lgkmcnt(" #n ")" ::: "memory")
#define PG8_BAR __builtin_amdgcn_s_barrier()
#define PG8_SCHED __builtin_amdgcn_sched_barrier(0)
#define PG8_BK(u, t) (((t) < g.ksplit ? (u).Ba : (u).Bb) + (size_t)(t) * kstep)
    Unit cur, nxt; int ui = 0;
    if (!S.next(0, cur)) return;
    f32x4 acc[2][2][4][2];
#pragma unroll
    for (int a = 0; a < 2; ++a)
#pragma unroll
        for (int b = 0; b < 2; ++b)
#pragma unroll
            for (int m = 0; m < 4; ++m)
#pragma unroll
                for (int n = 0; n < 2; ++n) acc[a][b][m][n] = (f32x4){0.f, 0.f, 0.f, 0.f};
    bf16x8 At[4][2], B0[2][2], B1[2][2];
    const char* cA = cur.A; const char* cB = cur.Ba;
    if constexpr (GATHER) {
#pragma unroll
        for (int i = 0; i < 2; ++i) { int R, C; stage_rc(tidx() * 16 + i * 8192, R, C); voffA[i] = (unsigned)(S.gather_row(cur, R) * g.lda + C) * 2u; voffA1[i] = (unsigned)(S.gather_row(cur, R + HALF) * g.lda + C) * 2u; }
    }
    PG8_STAGE(PG8_SB(0, 0), cB, voffB); PG8_STAGE(PG8_SB(0, 1), cB + hstepB, voffB); PG8_STAGE_A0(PG8_SA(0, 0), cA); PG8_STAGE_A1(PG8_SA(0, 1), cA);
    if (wr == 1) PG8_BAR;
    PG8_WAIT_V(2); PG8_BAR;
    PG8_STAGE(PG8_SB(1, 0), cB + kstep, voffB); PG8_STAGE_A0(PG8_SA(1, 0), cA + kstep); PG8_STAGE(PG8_SB(1, 1), cB + hstepB + kstep, voffB);
    PG8_WAIT_V(6); PG8_BAR;
    for (;;) {
        const bool has_next = S.next(ui + 1, nxt);
        const char* nA = has_next ? nxt.A : cA; const char* nB = has_next ? nxt.Ba : cB;
        for (int t = 0; t < nt; t += 2) {
            const bool last = (t == nt - 2);
            const char* a1 = cA + (size_t)(t + 1) * kstep;
            const char* a2 = last ? nA : cA + (size_t)(t + 2) * kstep; const char* b2 = last ? nB : PG8_BK(cur, t + 2);
            const char* a3 = a2 + kstep; const char* b3 = b2 + kstep;
            PG8_LDB(B0, 0, 0); PG8_LDB(B1, 0, 1); PG8_SCHED; PG8_LDA(At, 0, 0); PG8_STAGE_A1(PG8_SA(1, 1), a1);
            if constexpr (GATHER) { if (last && has_next) {
#pragma unroll
                for (int i = 0; i < 2; ++i) { int R, C; stage_rc(tidx() * 16 + i * 8192, R, C); voffA[i] = (unsigned)(S.gather_row(nxt, R) * g.lda + C) * 2u; voffA1[i] = (unsigned)(S.gather_row(nxt, R + HALF) * g.lda + C) * 2u; } } }
            PG8_WAIT_V(8); PG8_WAIT_L(0); PG8_BAR; PG8_MMA(0, 0, At, B0); PG8_MMA(0, 1, At, B1); PG8_BAR; PG8_SCHED;
            PG8_LDA(At, 0, 1); PG8_STAGE(PG8_SB(0, 0), b2, voffB); PG8_STAGE(PG8_SB(0, 1), b2 + hstepB, voffB); PG8_STAGE_A0(PG8_SA(0, 0), a2);
            PG8_WAIT_V(8); PG8_WAIT_L(0); PG8_BAR; PG8_MMA(1, 0, At, B0); PG8_MMA(1, 1, At, B1); PG8_BAR; PG8_SCHED;
            PG8_LDB(B0, 1, 0); PG8_LDB(B1, 1, 1); PG8_SCHED; PG8_LDA(At, 1, 0); PG8_STAGE_A1(PG8_SA(0, 1), a2);
            PG8_WAIT_V(8); PG8_WAIT_L(0); PG8_BAR; PG8_MMA(0, 0, At, B0); PG8_MMA(0, 1, At, B1); PG8_BAR; PG8_SCHED;
            PG8_LDA(At, 1, 1); PG8_STAGE(PG8_SB(1, 0), b3, voffB); PG8_STAGE(PG8_SB(1, 1), b3 + hstepB, voffB); PG8_STAGE_A0(PG8_SA(1, 0), a3);
            PG8_WAIT_V(8); PG8_WAIT_L(0); PG8_BAR; PG8_MMA(1, 0, At, B0); PG8_MMA(1, 1, At, B1); PG8_BAR; PG8_SCHED;
        }
        if constexpr (ALIGN_EPI) { if (wr == 0) PG8_BAR; }
        { int fr_ = fr, fq_ = fq; asm volatile("" : "+v"(fr_), "+v"(fq_));
          E(acc, cur, wr, wc, fr_, fq_); }
        if (!has_next) break;
#pragma unroll
        for (int a = 0; a < 2; ++a)
#pragma unroll
            for (int b = 0; b < 2; ++b)
#pragma unroll
                for (int m = 0; m < 4; ++m)
#pragma unroll
                    for (int n = 0; n < 2; ++n) acc[a][b][m][n] = (f32x4){0.f, 0.f, 0.f, 0.f};
        cur = nxt; cA = nA; cB = nB; ++ui;
        if constexpr (ALIGN_EPI) { if (wr == 1) PG8_BAR; }
    }
    PG8_WAIT_V(0);
    if constexpr (!ALIGN_EPI) { if (wr == 0) PG8_BAR; }
    PG8_BAR;
#undef PG8_SA
#undef PG8_SB
#undef PG8_STAGE
#undef PG8_STAGE_A0
#undef PG8_STAGE_A1
#undef PG8_LDA
#undef PG8_LDB
#undef PG8_MMA
#undef PG8_WAIT_V
#undef PG8_WAIT_L
#undef PG8_BAR
#undef PG8_SCHED
#undef PG8_BK
}

struct GridOrder {
    int nM, nN, nwg, G, c;
    __device__ __forceinline__ void init(int M, int N, int G_, int c_) { nM = M / BM; nN = N / BM; nwg = nM * nN; G = G_; c = c_; }
    __device__ __forceinline__ bool flat(int i, int& pm, int& pn) const {
        const long L = (long)i * G + c; if (L >= nwg) return false;
        int wgid = (int)L; { const int q = nwg / NXCD, r = nwg % NXCD, xcd = wgid % NXCD, off = wgid / NXCD; wgid = (xcd < r ? xcd * (q + 1) : r * (q + 1) + (xcd - r) * q) + off; }
        const int nig = WGM * nN, gid = wgid / nig, fm = gid * WGM, gsz = (nM - fm) < WGM ? (nM - fm) : WGM;
        pm = fm + ((wgid % nig) % gsz); pn = (wgid % nig) / gsz; return true;
    }
};
}

struct DenseSched {
    pg8::GridOrder go; const char* A; const char* Bt; size_t a_tile, b_tile;
    DI bool next(int i, pg8::Unit& u) const { int pm, pn; if (!go.flat(i, pm, pn)) return false; u.pm = pm; u.pn = pn; u.A = A + (size_t)pm * a_tile; u.Ba = Bt + (size_t)pn * b_tile; u.Bb = u.Ba; u.aux0 = u.aux1 = u.aux2 = 0; return true; }
    DI int gather_row(const pg8::Unit&, int r) const { return r; }
};
struct EpiProj {
    static constexpr bool PERM = true;
    bf16_t* O;
    DI void operator()(const pg8::f32x4 (&acc)[2][2][4][2], const pg8::Unit& u, int wr, int wc, int fr, int fq) const {
        const int row0 = u.pm * 256 + wr * 64 + fr, col0 = u.pn * 256 + wc * 32 + 8 * fq;
#pragma unroll
        for (int ai = 0; ai < 2; ++ai)
#pragma unroll
            for (int m = 0; m < 4; ++m) { bf16_t* rowp = O + (size_t)(row0 + ai * 128 + m * 16) * LDP + col0;
#pragma unroll
                for (int bj = 0; bj < 2; ++bj) { const pg8::f32x4 v0 = acc[ai][bj][m][0], v1 = acc[ai][bj][m][1];
                    pg8::u32x4 w; w.x = pg8::cvt_pk_bf16(v0[0], v0[1]); w.y = pg8::cvt_pk_bf16(v0[2], v0[3]); w.z = pg8::cvt_pk_bf16(v1[0], v1[1]); w.w = pg8::cvt_pk_bf16(v1[2], v1[3]);
                    *(pg8::u32x4*)(rowp + bj * 128) = w; } }
    }
};
struct EpiResid {
    static constexpr bool PERM = true;
    const float* xs; float* xd; const float* gate;
    DI void operator()(const pg8::f32x4 (&acc)[2][2][4][2], const pg8::Unit& u, int wr, int wc, int fr, int fq) const {
        const int row0 = u.pm * 256 + wr * 64 + fr, col0 = u.pn * 256 + wc * 32 + 8 * fq;
        const float* gp = gate + (size_t)((u.pm * 256) / S) * 12288 + col0;
        pg8::f32x4 gv[2][2];
#pragma unroll
        for (int bj = 0; bj < 2; ++bj)
#pragma unroll
            for (int n = 0; n < 2; ++n) gv[bj][n] = *(const pg8::f32x4*)(gp + bj * 128 + 4 * n);
#pragma unroll
        for (int ai = 0; ai < 2; ++ai)
#pragma unroll
            for (int m = 0; m < 4; ++m) { const size_t ro = (size_t)(row0 + ai * 128 + m * 16) * D + col0;
#pragma unroll
                for (int bj = 0; bj < 2; ++bj)
#pragma unroll
                    for (int n = 0; n < 2; ++n) { const pg8::f32x4 xv = *(const pg8::f32x4*)(xs + ro + bj * 128 + 4 * n);
                        *(pg8::f32x4*)(xd + ro + bj * 128 + 4 * n) = xv + gv[bj][n] * acc[ai][bj][m][n]; } }
    }
};

constexpr int LDS_MOE_TAB = 132096 / 4;
DI void moe_build_table(const P& p, int l, float* lds) {
    int* tab = (int*)(lds + LDS_MOE_TAB);
    unsigned* cnt = p.ctl + CTL_CNT + l * 32;
    const int tid = tidx();
    if (tid < 96) { int cls = 0, mt = 0, sb = 0; const bool ok = cls_find(cnt, tid, cls, mt, sb);
        tab[4 + 4 * tid] = ok ? cls : 0; tab[5 + 4 * tid] = mt; tab[6 + 4 * tid] = sb; tab[7 + 4 * tid] = ok ? (int)__hip_atomic_load(cnt + cls, __ATOMIC_RELAXED, __HIP_MEMORY_SCOPE_AGENT) : 0; }
    if (tid == 0) tab[0] = cls_total_tiles(cnt);
    __syncthreads();
}
DI int rfl(int v) { return __builtin_amdgcn_readfirstlane(v); }
struct MoeSched1 {
    const int* tab; int G, c; const char* hb; const char* wgu; const int* cls_tok;
    DI bool next(int i, pg8::Unit& u) const {
        const int L = i * G + c, nt = rfl(tab[0]); if (L >= nt * 8) return false;
        const int ft = L >> 3, pn = L & 7;
        const int cls = rfl(tab[4 + 4 * ft]), mt = rfl(tab[5 + 4 * ft]), sb = rfl(tab[6 + 4 * ft]), n = rfl(tab[7 + 4 * ft]);
        int ea, eb; cls_experts(cls, ea, eb); const int e = pn < 4 ? ea : eb;
        u.pm = (sb >> 8) + mt; u.pn = pn; u.A = hb; u.Ba = wgu + ((size_t)e * 1024 + (pn & 3) * 256) * 2048 * 2; u.Bb = u.Ba; u.aux0 = cls; u.aux1 = mt * 256; u.aux2 = n; return true;
    }
    DI int gather_row(const pg8::Unit& u, int r) const { const int ri = u.aux1 + r; return cls_tok[(size_t)u.aux0 * CLS_CAP + (ri < u.aux2 ? ri : 0)]; }
};
struct MoeSched2 {
    const int* tab; int G, c; const char* hid; const char* wd;
    DI bool next(int i, pg8::Unit& u) const {
        const int L = i * G + c, nt = rfl(tab[0]); if (L >= nt * 8) return false;
        const int ft = L >> 3, pn = L & 7;
        const int cls = rfl(tab[4 + 4 * ft]), mt = rfl(tab[5 + 4 * ft]), sb = rfl(tab[6 + 4 * ft]), n = rfl(tab[7 + 4 * ft]);
        int ea, eb; cls_experts(cls, ea, eb);
        u.pm = (sb >> 8) + mt; u.pn = pn; u.A = hid + (size_t)(sb + mt * 256) * 1024 * 2;
        u.Ba = wd + ((size_t)ea * 2048 + pn * 256) * 512 * 2; u.Bb = wd + ((size_t)eb * 2048 + pn * 256) * 512 * 2 - (size_t)8 * 128;
        u.aux0 = cls; u.aux1 = mt * 256; u.aux2 = n; return true;
    }
    DI int gather_row(const pg8::Unit&, int r) const { return r; }
};
struct EpiMoe1 {
    static constexpr bool PERM = true;
    bf16_t* hid; const int* cls_tok; const float* tokw;
    DI void operator()(const pg8::f32x4 (&acc)[2][2][4][2], const pg8::Unit& u, int wr, int wc, int fr, int fq) const {
        const int which = u.pn >> 2, q = u.pn & 3;
        const int* toks = cls_tok + (size_t)u.aux0 * CLS_CAP;
        bf16_t* hb = hid + (size_t)u.pm * 256 * 1024 + which * 512 + q * 128 + wc * 32 + 8 * fq;
#pragma unroll
        for (int ai = 0; ai < 2; ++ai)
#pragma unroll
            for (int m = 0; m < 4; ++m) {
                const int r = wr * 64 + fr + ai * 128 + m * 16, ri = u.aux1 + r;
                if (ri < u.aux2) {
                    const float w = tokw[(size_t)toks[ri] * 2 + which];
                    const pg8::f32x4 g0 = acc[ai][0][m][0], g1 = acc[ai][0][m][1], u0 = acc[ai][1][m][0], u1 = acc[ai][1][m][1];
                    pg8::u32x4 o;
                    o.x = pg8::cvt_pk_bf16(siluf_(g0[0]) * u0[0] * w, siluf_(g0[1]) * u0[1] * w); o.y = pg8::cvt_pk_bf16(siluf_(g0[2]) * u0[2] * w, siluf_(g0[3]) * u0[3] * w);
                    o.z = pg8::cvt_pk_bf16(siluf_(g1[0]) * u1[0] * w, siluf_(g1[1]) * u1[1] * w); o.w = pg8::cvt_pk_bf16(siluf_(g1[2]) * u1[2] * w, siluf_(g1[3]) * u1[3] * w);
                    *(pg8::u32x4*)(hb + (size_t)r * 1024) = o;
                }
                asm volatile("" ::: "memory");
            }
    }
};
struct EpiMoe2 {
    static constexpr bool PERM = true;
    float* x; const int* cls_tok; const float* g2;
    DI void operator()(const pg8::f32x4 (&acc)[2][2][4][2], const pg8::Unit& u, int wr, int wc, int fr, int fq) const {
        const int* toks = cls_tok + (size_t)u.aux0 * CLS_CAP;
        const int col0 = u.pn * 256 + wc * 32 + 8 * fq;
#pragma unroll
        for (int ai = 0; ai < 2; ++ai)
#pragma unroll
            for (int m = 0; m < 4; ++m) {
                const int r = wr * 64 + fr + ai * 128 + m * 16, ri = u.aux1 + r;
                if (ri < u.aux2) {
                    const int tok = toks[ri];
                    float* xr = x + (size_t)tok * D + col0;
                    const float* gp = g2 + (size_t)(tok / S) * 12288 + col0;
#pragma unroll
                    for (int bj = 0; bj < 2; ++bj)
#pragma unroll
                        for (int n = 0; n < 2; ++n) { const pg8::f32x4 xv = *(const pg8::f32x4*)(xr + bj * 128 + 4 * n), gv = *(const pg8::f32x4*)(gp + bj * 128 + 4 * n);
                            *(pg8::f32x4*)(xr + bj * 128 + 4 * n) = xv + gv * acc[ai][bj][m][n]; }
                }
            }
    }
};

constexpr int LDS_BYTES = 147456;
constexpr int LDS_MISC = 131072 / 4, LDS_TAB = 131328 / 4;
DI unsigned long long ld_tab(const float* lds, int i) {
    const unsigned lo = __builtin_amdgcn_readfirstlane(__float_as_uint(lds[LDS_TAB + 2 * i])), hi = __builtin_amdgcn_readfirstlane(__float_as_uint(lds[LDS_TAB + 2 * i + 1]));
    return ((unsigned long long)hi << 32) | lo;
}
DI P load_P(const float* lds) {
    asm volatile("" ::: "memory");
    P p;
#pragma unroll
    for (int i = 0; i < 23; ++i) p.in[i] = (const float*)ld_tab(lds, i);
    p.out = (float*)ld_tab(lds, 23);
    unsigned char* ws = (unsigned char*)ld_tab(lds, 24);
    p.ctl = (unsigned*)(ws + O_CTL); p.mod = (float*)(ws + O_MOD); p.xres = (float*)(ws + O_XRES); p.hbuf = (bf16_t*)(ws + O_HBUF); p.proj = (bf16_t*)(ws + O_PROJ);
    p.oA = (bf16_t*)(ws + O_OA); p.lseA = (float*)(ws + O_LSEA); p.oB = (bf16_t*)(ws + O_OB); p.oC = (bf16_t*)(ws + O_OC); p.oD = (bf16_t*)(ws + O_OD);
    p.kmean = (float*)(ws + O_KMEAN); p.kc = (bf16_t*)(ws + O_KC); p.vc = (bf16_t*)(ws + O_VC); p.cls_tok = (int*)(ws + O_CLSTOK); p.tokw = (float*)(ws + O_TOKW);
    p.hid = (bf16_t*)(ws + O_HID); p.winT = (bf16_t*)(ws + O_WINT); p.woutT = (bf16_t*)(ws + O_WOUTT); p.wguT = (bf16_t*)(ws + O_WGUT); p.wdT = (bf16_t*)(ws + O_WDT);
    p.cw1T = (bf16_t*)(ws + O_CW1T); p.cw2T = (bf16_t*)(ws + O_CW2T); p.cgT = (bf16_t*)(ws + O_CGT); p.crT = (bf16_t*)(ws + O_CRT); p.hlo = (bf16_t*)(ws + O_HLO);
    return p;
}
__global__ void __launch_bounds__(NTHR, 2) mk_fwd(KArgs ka) {
    extern __shared__ __attribute__((aligned(16))) float lds[];
    const int bid = blockIdx.x, nb = gridDim.x;
#define w (tidx() >> 6)
    volatile LAS unsigned* xbw = (volatile LAS unsigned*)(lds + LDS_MISC);
    if (threadIdx.x == 0) { xbw[0] = 0u; xbw[1] = 0u; xbw[2] = 0u; xbw[3] = 0u; }
    if (threadIdx.x < 25) {
        const unsigned long long v = (threadIdx.x < 23) ? (unsigned long long)ka.in[threadIdx.x < 23 ? threadIdx.x : 0] : (threadIdx.x == 23 ? (unsigned long long)ka.out : (unsigned long long)ka.ws);
        lds[LDS_TAB + 2 * threadIdx.x] = __uint_as_float((unsigned)v); lds[LDS_TAB + 2 * threadIdx.x + 1] = __uint_as_float((unsigned)(v >> 32));
    }
    __syncthreads();
    XcdBarrier bar = xcd_barrier_post((unsigned*)(ka.ws + O_CTL), xbw);

    { const P p = load_P(lds);
      for (int it = bid; it < N_MOD_ITEMS + N_TR_ITEMS; it += nb) { if (it < N_MOD_ITEMS) phase_mod_item(p, it, lds); else phase_transpose_item(p, it - N_MOD_ITEMS, lds); } }
    xcd_barrier(bar);
    for (int l = 0; l < DEPTH; ++l) {
        { const P p = load_P(lds); for (int it = bid; it < N_NORM_GROUPS; it += nb) phase_norm_group(p, l, 0, it, lds); }
        xcd_barrier(bar);
        { const P p = load_P(lds);
          DenseSched sc; sc.go.init(T, 5120, nb, bid); sc.A = (const char*)p.hbuf; sc.Bt = (const char*)(p.winT + (size_t)l * NPAD_IN * 2048); sc.a_tile = (size_t)256 * D * 2; sc.b_tile = (size_t)256 * 2048 * 2;
          const pg8::Shape g{2048, D, 2048, 1 << 20};
          const EpiProj E{p.proj};
          pg8::gemm_phase<EpiProj, DenseSched, false>((PG8_LAS unsigned char*)lds, g, sc, E); }
        xcd_barrier(bar);
        { const P p = load_P(lds); for (int it = bid; it < N_KMEAN_ITEMS; it += nb) phase_kmean_item(p, it, lds);
          for (int it = w * nb + ((bid + 128) % nb); it < N_CMP_WITEMS; it += 8 * nb) phase_cmp_wave(p, l, it); }
        xcd_barrier(bar);
        { const P p = load_P(lds); fa::phase_attention(p, l, lds); }
        xcd_barrier(bar);
        { const P p = load_P(lds); for (int it = bid * 8 + w; it < N_MIXN_WAVE_ITEMS; it += nb * 8) phase_mixnorm_wave(p, it); }
        xcd_barrier(bar);
        { const P p = load_P(lds);
          DenseSched sc; sc.go.init(T, 2048, nb, bid); sc.A = (const char*)p.hbuf; sc.Bt = (const char*)(p.woutT + (size_t)l * 2048 * 2048); sc.a_tile = (size_t)256 * D * 2; sc.b_tile = (size_t)256 * 2048 * 2;
          const pg8::Shape g{2048, D, 2048, 1 << 20};
          const EpiResid E{l == 0 ? p.in[0] : p.xres, p.xres, p.mod + (size_t)l * 4 * 12288 + 2 * D};
          pg8::gemm_phase<EpiResid, DenseSched, false>((PG8_LAS unsigned char*)lds, g, sc, E); }
        xcd_barrier(bar);
        { const P p = load_P(lds); for (int it = bid; it < N_NORM_GROUPS; it += nb) phase_norm_group(p, l, 1, it, lds); }
        xcd_barrier(bar);
        { const P p = load_P(lds); moe_build_table(p, l, lds);
          const MoeSched1 sc{(const int*)(lds + LDS_MOE_TAB), nb, bid, (const char*)p.hbuf, (const char*)(p.wguT + (size_t)l * 16 * 1024 * 2048), p.cls_tok};
          const pg8::Shape g{2048, D, 2048, 1 << 20};
          const EpiMoe1 E{p.hid, p.cls_tok, p.tokw};
          pg8::gemm_phase<EpiMoe1, MoeSched1, true>((PG8_LAS unsigned char*)lds, g, sc, E); }
        xcd_barrier(bar);
        { const P p = load_P(lds);
          const MoeSched2 sc{(const int*)(lds + LDS_MOE_TAB), nb, bid, (const char*)p.hid, (const char*)(p.wdT + (size_t)l * 16 * 2048 * 512)};
          const pg8::Shape g{1024, 1024, 512, 8};
          const EpiMoe2 E{p.xres, p.cls_tok, p.mod + (size_t)l * 4 * 12288 + 5 * D};
          pg8::gemm_phase<EpiMoe2, MoeSched2, false>((PG8_LAS unsigned char*)lds, g, sc, E); }
        xcd_barrier(bar);
    }
    { const P p = load_P(lds);
      const bool tmo = xb_ld(p.ctl + XB_TMO) != 0u;
      for (int it = bid * 8 + w; it < T; it += nb * 8) phase_final_wave(p, it, tmo); }
#undef w
}

extern "C" void kernel_launch(void* const* d_in, const int* in_sizes, int n_in, void* d_out, int out_size, void* d_ws, size_t ws_size, hipStream_t stream) {
    KArgs ka{};
    for (int i = 0; i < 23; ++i) ka.in[i] = (const float*)d_in[i];
    ka.out = (float*)d_out;
    ka.ws = (unsigned char*)d_ws;
    if (WS_NEED > ws_size) { fprintf(stderr, "workspace too small: need %zu have %zu\n", (size_t)WS_NEED, ws_size); return; }
    static int grid = 0;
    if (!grid) {
        int dev = 0, cus = 0, per_cu = 0;
        (void)hipGetDevice(&dev);
        (void)hipDeviceGetAttribute(&cus, hipDeviceAttributeMultiprocessorCount, dev);
        (void)hipFuncSetAttribute((const void*)mk_fwd, hipFuncAttributeMaxDynamicSharedMemorySize, LDS_BYTES);
        (void)hipOccupancyMaxActiveBlocksPerMultiprocessor(&per_cu, (const void*)mk_fwd, NTHR, LDS_BYTES);
        if (per_cu < 1) fprintf(stderr, "occupancy query reports %d blocks per CU\n", per_cu);
        (void)hipGetLastError();
        grid = cus;
    }
    (void)hipMemsetAsync(ka.ws + O_CTL, 0, 1 << 20, stream);
    mk_fwd<<<grid, NTHR, LDS_BYTES, stream>>>(ka);
}
```

```cpp
#include <hip/hip_runtime.h>
#ifndef PROBE_MASK
#define PROBE_MASK 0
#endif
#if PROBE_MASK
#define SUBSTAMP(id) do { if (blockIdx.x == 0 && threadIdx.x == 0) { volatile __attribute__((address_space(3))) unsigned long long* tq = (volatile __attribute__((address_space(3))) unsigned long long*)(lds + 32768 + 8); \
    const unsigned long long now_ = __builtin_amdgcn_s_memrealtime(); if ((PROBE_MASK >> (id)) & 1) tq[1] += now_ - tq[0]; tq[0] = now_; } } while (0)
#else
#define SUBSTAMP(id) do { } while (0)
#endif
#include <stdint.h>
#include <stdio.h>

typedef unsigned short bf16_t;
#define DI __device__ __forceinline__
#define LAS __attribute__((address_space(3)))

constexpr int D = 2048, NBATCH = 4, S = 4096, T = NBATCH * S, DEPTH = 4;
constexpr int NTHR = 512;
constexpr int LDP = 5184;
constexpr int NPAD_IN = 5120;
constexpr int OFF_QA = 0, OFF_KA = 512, OFF_VA = 1024, OFF_QB = 1536, OFF_KB = 2048, OFF_VB = 2176, OFF_QC = 2304, OFF_KC = 2816,
              OFF_VC = 3328, OFF_QD = 3840, OFF_KDC = 4352, OFF_VDC = 4480, OFF_KDS = 4608, OFF_VDS = 4736, OFF_KDW = 4864,
              OFF_VDW = 4992, OFF_GD = 5120;
constexpr int NCLS = 24, CLS_CAP = T, HID_ROWS = T + NCLS * 256;
constexpr float NEGF = -1e30f;
constexpr float EPS = 1e-6f;

struct P {
    const float* in[23];
    float* out;
    unsigned* ctl;
    float* mod;
    float* xres;
    bf16_t* hbuf;
    bf16_t* proj;
    bf16_t* oA;
    float* lseA;
    bf16_t* oB; bf16_t* oC; bf16_t* oD;
    float* kmean;
    bf16_t* kc; bf16_t* vc;
    int* cls_tok;
    float* tokw;
    bf16_t* hid;
    bf16_t* winT;
    bf16_t* woutT;
    bf16_t* wguT;
    bf16_t* wdT;
    bf16_t* cw1T;
    bf16_t* cw2T;
    bf16_t* cgT;
    bf16_t* crT;
    bf16_t* hlo;
};
constexpr size_t al256(size_t x) { return (x + 255) & ~(size_t)255; }
constexpr size_t O_CTL = 0;
constexpr size_t O_MOD = O_CTL + al256((size_t)1 << 20);
constexpr size_t O_XRES = O_MOD + al256((size_t)4 * 4 * 12288 * 4);
constexpr size_t O_HBUF = O_XRES + al256((size_t)T * D * 4);
constexpr size_t O_PROJ = O_HBUF + al256((size_t)T * D * 2);
constexpr size_t O_OA = O_PROJ + al256((size_t)T * LDP * 2);
constexpr size_t O_LSEA = O_OA + al256((size_t)3 * T * 512 * 2);
constexpr size_t O_OB = O_LSEA + al256((size_t)3 * T * 8 * 4);
constexpr size_t O_OC = O_OB + al256((size_t)T * 512 * 2);
constexpr size_t O_OD = O_OC + al256((size_t)T * 512 * 2);
constexpr size_t O_KMEAN = O_OD + al256((size_t)T * 512 * 2);
constexpr size_t O_KC = O_KMEAN + al256((size_t)4 * 8 * 16 * 64 * 4);
constexpr size_t O_VC = O_KC + al256((size_t)4 * 2 * 256 * 64 * 2);
constexpr size_t O_CLSTOK = O_VC + al256((size_t)4 * 2 * 256 * 64 * 2);
constexpr size_t O_TOKW = O_CLSTOK + al256((size_t)NCLS * CLS_CAP * 4);
constexpr size_t O_HID = O_TOKW + al256((size_t)T * 2 * 4);
constexpr size_t O_WINT = O_HID + al256((size_t)HID_ROWS * 1024 * 2);
constexpr size_t O_WOUTT = O_WINT + al256((size_t)4 * NPAD_IN * 2048 * 2);
constexpr size_t O_WGUT = O_WOUTT + al256((size_t)4 * 2048 * 2048 * 2);
constexpr size_t O_WDT = O_WGUT + al256((size_t)4 * 16 * 1024 * 2048 * 2);
constexpr size_t O_CW1T = O_WDT + al256((size_t)4 * 16 * 2048 * 512 * 2);
constexpr size_t O_CW2T = O_CW1T + al256((size_t)4 * 2 * 128 * 2048 * 2);
constexpr size_t O_CGT = O_CW2T + al256((size_t)4 * 2 * 64 * 128 * 2);
constexpr size_t O_CRT = O_CGT + al256((size_t)4 * 32 * 2048 * 2);
constexpr size_t O_HLO = O_CRT + al256((size_t)2 * 32 * 2048 * 2);
constexpr size_t WS_NEED = O_HLO + al256((size_t)T * D * 2);
struct KArgs { const float* in[23]; float* out; unsigned char* ws; };
constexpr int CTL_CNT = 8192;
constexpr int CTL_Q = 8192 + 256;

DI int tidx() { int t = threadIdx.x; asm volatile("" : "+v"(t)); return t; }
DI float bf2f(bf16_t v) { return __uint_as_float(((unsigned)v) << 16); }
DI bf16_t f2bf(float f) { unsigned u = __float_as_uint(f); u += 0x7fffu + ((u >> 16) & 1u); return (bf16_t)(u >> 16); }
DI float wave_sum(float v) { for (int o = 32; o > 0; o >>= 1) v += __shfl_xor(v, o); return v; }
DI float wave_sum_dpp(float v) {
    v += __builtin_bit_cast(float, __builtin_amdgcn_update_dpp(0, __builtin_bit_cast(int, v), 0xB1, 0xF, 0xF, true));
    v += __builtin_bit_cast(float, __builtin_amdgcn_update_dpp(0, __builtin_bit_cast(int, v), 0x4E, 0xF, 0xF, true));
    v += __builtin_bit_cast(float, __builtin_amdgcn_update_dpp(0, __builtin_bit_cast(int, v), 0x141, 0xF, 0xF, true));
    v += __builtin_bit_cast(float, __builtin_amdgcn_update_dpp(0, __builtin_bit_cast(int, v), 0x140, 0xF, 0xF, true));
    const int vi = __builtin_bit_cast(int, v);
    const float a = __builtin_bit_cast(float, __builtin_amdgcn_readlane(vi, 0)), b = __builtin_bit_cast(float, __builtin_amdgcn_readlane(vi, 16));
    const float c = __builtin_bit_cast(float, __builtin_amdgcn_readlane(vi, 32)), d = __builtin_bit_cast(float, __builtin_amdgcn_readlane(vi, 48));
    return (a + b) + (c + d);
}
DI float wave_max(float v) { for (int o = 32; o > 0; o >>= 1) v = fmaxf(v, __shfl_xor(v, o)); return v; }
DI void wave_lds_sync() { asm volatile("s_waitcnt lgkmcnt(0)" ::: "memory"); __builtin_amdgcn_wave_barrier(); }
DI float sigmoidf_(float x) { return 1.f / (1.f + __expf(-x)); }
DI float siluf_(float x) { return x / (1.f + __expf(-x)); }
DI float gelu_tanh(float x) { float u = 0.7978845608028654f * (x + 0.044715f * x * x * x); return 0.5f * x * (1.f + tanhf(u)); }
DI int t5_bucket(int d) {
    if (d < 16) return d < 0 ? 0 : d;
    return 16 + (d >= 22) + (d >= 30) + (d >= 40) + (d >= 54) + (d >= 73) + (d >= 99) + (d >= 134) + (d >= 182) + (d >= 246) + (d >= 332) +
           (d >= 450) + (d >= 609) + (d >= 825) + (d >= 1117) + (d >= 1513);
}

DI void phase_mod_item(const P& p, int item, float* lds) {
    const int l = item / 192, jb = item % 192, tid = tidx(), w = __builtin_amdgcn_readfirstlane(tid >> 6), lane = tid & 63, c4 = lane & 15, kq = lane >> 4;
    float* cact = lds;
    float* red = lds + 8192;
    const float* c = p.in[1];
    for (int i = tid; i < 4 * 2048; i += NTHR) cact[i] = siluf_(c[i]);
    __syncthreads();
    const float* wp = p.in[7] + (size_t)l * 2048 * 12288 + (size_t)(w * 256 + kq) * 12288 + jb * 64 + 4 * c4;
    float4 a[4];
#pragma unroll
    for (int b = 0; b < 4; ++b) a[b] = make_float4(0.f, 0.f, 0.f, 0.f);
#pragma unroll 8
    for (int i = 0; i < 64; ++i) {
        const float4 wv = *(const float4*)(wp + (size_t)(4 * i) * 12288);
        const int kk = w * 256 + 4 * i + kq;
#pragma unroll
        for (int b = 0; b < 4; ++b) { const float cv = cact[b * 2048 + kk]; a[b].x += cv * wv.x; a[b].y += cv * wv.y; a[b].z += cv * wv.z; a[b].w += cv * wv.w; }
    }
#pragma unroll
    for (int b = 0; b < 4; ++b) {
        a[b].x += __shfl_xor(a[b].x, 16); a[b].y += __shfl_xor(a[b].y, 16); a[b].z += __shfl_xor(a[b].z, 16); a[b].w += __shfl_xor(a[b].w, 16);
        a[b].x += __shfl_xor(a[b].x, 32); a[b].y += __shfl_xor(a[b].y, 32); a[b].z += __shfl_xor(a[b].z, 32); a[b].w += __shfl_xor(a[b].w, 32);
    }
    if (kq == 0) {
#pragma unroll
        for (int b = 0; b < 4; ++b) *(float4*)(red + (w * 4 + b) * 64 + 4 * c4) = a[b];
    }
    __syncthreads();
    if (tid < 256) {
        const int b = tid >> 6, col = tid & 63;
        float v = 0.f;
#pragma unroll
        for (int q = 0; q < 8; ++q) v += red[(q * 4 + b) * 64 + col];
        p.mod[((size_t)l * 4 + b) * 12288 + jb * 64 + col] = v + p.in[8][(size_t)l * 12288 + jb * 64 + col];
    }
    __syncthreads();
}
constexpr int N_MOD_ITEMS = 4 * 192;

struct TrDesc { const float* src; int ld, k0, n0, N; bf16_t* dst; int lddst, dst_row0; const float* kscale; bf16_t* dst_lo; };
DI void tr_load(const TrDesc& d, float4 (&v)[4]) {
    const int tid = tidx();
#pragma unroll
    for (int i = 0; i < 4; ++i) {
        const int e = tid + i * NTHR, kk = e >> 4, c4 = e & 15, n = d.n0 + 4 * c4;
        const float* sp = d.src + (size_t)(d.k0 + kk) * d.ld + n;
        if (n + 3 < d.N) v[i] = *(const float4*)sp;
        else { v[i].x = (n < d.N) ? sp[0] : 0.f; v[i].y = (n + 1 < d.N) ? sp[1] : 0.f; v[i].z = (n + 2 < d.N) ? sp[2] : 0.f; v[i].w = 0.f; }
    }
}
DI void tr_finish(const TrDesc& d, const float4 (&v)[4], float* lds) {
    float(*tl)[65] = (float(*)[65])lds;
    const int tid = tidx();
#pragma unroll
    for (int i = 0; i < 4; ++i) {
        const int e = tid + i * NTHR, kk = e >> 4, c4 = e & 15;
        float4 x = v[i];
        if (d.kscale) { const float ks = d.kscale[d.k0 + kk]; x.x *= ks; x.y *= ks; x.z *= ks; x.w *= ks; }
        tl[kk][4 * c4] = x.x; tl[kk][4 * c4 + 1] = x.y; tl[kk][4 * c4 + 2] = x.z; tl[kk][4 * c4 + 3] = x.w;
    }
    __syncthreads();
#pragma unroll
    for (int i = 0; i < 2; ++i) {
        const int e = tid + i * NTHR, nn = e >> 4, kc = e & 15, n = d.n0 + nn;
        if (n < d.N) {
            float f[8];
#pragma unroll
            for (int j = 0; j < 8; ++j) f[j] = tl[kc * 8 + j][nn];
            const size_t di = (size_t)(d.dst_row0 + nn) * d.lddst + d.k0 + kc * 8;
            uint4 hi;
            hi.x = (unsigned)f2bf(f[0]) | ((unsigned)f2bf(f[1]) << 16); hi.y = (unsigned)f2bf(f[2]) | ((unsigned)f2bf(f[3]) << 16);
            hi.z = (unsigned)f2bf(f[4]) | ((unsigned)f2bf(f[5]) << 16); hi.w = (unsigned)f2bf(f[6]) | ((unsigned)f2bf(f[7]) << 16);
            *(uint4*)(d.dst + di) = hi;
            if (d.dst_lo) {
                uint4 lo;
                lo.x = (unsigned)f2bf(f[0] - __uint_as_float(hi.x << 16)) | ((unsigned)f2bf(f[1] - __uint_as_float(hi.x & 0xffff0000u)) << 16);
                lo.y = (unsigned)f2bf(f[2] - __uint_as_float(hi.y << 16)) | ((unsigned)f2bf(f[3] - __uint_as_float(hi.y & 0xffff0000u)) << 16);
                lo.z = (unsigned)f2bf(f[4] - __uint_as_float(hi.z << 16)) | ((unsigned)f2bf(f[5] - __uint_as_float(hi.z & 0xffff0000u)) << 16);
                lo.w = (unsigned)f2bf(f[6] - __uint_as_float(hi.w << 16)) | ((unsigned)f2bf(f[7] - __uint_as_float(hi.w & 0xffff0000u)) << 16);
                *(uint4*)(d.dst_lo + di) = lo;
            }
        }
    }
    __syncthreads();
}
constexpr int TR0 = 4 * 16 * 80, TR1 = 4 * 16 * 32, TR2 = 4 * 16 * 16 * 8, TR3 = TR2, TR4 = 4 * 16 * 4 * 32, TR5 = 4 * 16 * 2, TR6 = TR5, TR7 = 4, TR8 = TR7, TR9 = 4 * 16, TR10 = 16;
constexpr int N_TR_ITEMS = TR0 + TR1 + TR2 + TR3 + TR4 + TR5 + TR6 + TR7 + TR8 + TR9 + TR10;
DI TrDesc tr_desc(const P& p, int item) {
    int i = item;
    if (i < TR0) { const int l = i / (16 * 80), r = i % (16 * 80), kt = r / 80, nt = r % 80;
        return TrDesc{p.in[9] + (size_t)l * 2048 * 5144, 5144, kt * 128, nt * 64, 5144, p.winT + (size_t)l * NPAD_IN * 2048, 2048, nt * 64, nullptr, nullptr}; }
    i -= TR0;
    if (i < TR1) { const int l = i / 512, r = i % 512, kt = r / 32, nt = r % 32;
        return TrDesc{p.in[18] + (size_t)l * 2048 * 2048, 2048, kt * 128, nt * 64, 2048, p.woutT + (size_t)l * 2048 * 2048, 2048, nt * 64, p.in[17] + (size_t)l * 2048, nullptr}; }
    i -= TR1;
    if (i < TR2 + TR3) { const int up = i >= TR2; if (up) i -= TR2; const int le = i / 128, r = i % 128, kt = r / 8, nt = r % 8;
        return TrDesc{(up ? p.in[20] : p.in[19]) + (size_t)le * 2048 * 512, 512, kt * 128, nt * 64, 512, p.wguT + (size_t)le * 1024 * 2048, 2048, (nt >> 1) * 256 + (nt & 1) * 64 + (up ? 128 : 0), nullptr, nullptr}; }
    i -= TR2 + TR3;
    if (i < TR4) { const int le = i / 128, r = i % 128, kt = r / 32, nt = r % 32;
        return TrDesc{p.in[21] + (size_t)le * 512 * 2048, 2048, kt * 128, nt * 64, 2048, p.wdT + (size_t)le * 2048 * 512, 512, nt * 64, nullptr, nullptr}; }
    i -= TR4;
    if (i < TR5 + TR6) { const int v = i >= TR5; if (v) i -= TR5; const int l = i / 32, r = i % 32, kt = r / 2, nt = r % 2;
        return TrDesc{(v ? p.in[14] : p.in[12]) + (size_t)l * 2048 * 128, 128, kt * 128, nt * 64, 128, p.cw1T + (size_t)(l * 2 + v) * 128 * 2048, 2048, nt * 64, nullptr, nullptr}; }
    i -= TR5 + TR6;
    if (i < TR7 + TR8) { const int v = i >= TR7; if (v) i -= TR7; const int l = i;
        return TrDesc{(v ? p.in[15] : p.in[13]) + (size_t)l * 128 * 64, 64, 0, 0, 64, p.cw2T + (size_t)(l * 2 + v) * 64 * 128, 128, 0, nullptr, nullptr}; }
    i -= TR7 + TR8;
    if (i < TR9) { const int l = i / 16, kt = i % 16;
        return TrDesc{p.in[9] + (size_t)l * 2048 * 5144 + 5120, 5144, kt * 128, 0, 24, p.cgT + (size_t)l * 32 * 2048, 2048, 0, nullptr, nullptr}; }
    i -= TR9;
    return TrDesc{p.in[3], 16, i * 128, 0, 16, p.crT, 2048, 0, nullptr, p.crT + 32 * 2048};
}
DI void phase_transposes(const P& p, int bid, int nb, float* lds) {
    int it = bid;
    if (it >= N_TR_ITEMS) return;
    TrDesc cur = tr_desc(p, it);
    float4 v[4], v1[4];
    tr_load(cur, v);
    TrDesc d1 = cur;
    if (it + nb < N_TR_ITEMS) { d1 = tr_desc(p, it + nb); tr_load(d1, v1); }
    for (;;) {
        const int n2 = it + 2 * nb;
        TrDesc d2 = d1;
        float4 v2[4];
#pragma unroll
        for (int i = 0; i < 4; ++i) v2[i] = v1[i];
        if (n2 < N_TR_ITEMS) { d2 = tr_desc(p, n2); tr_load(d2, v2); }
        tr_finish(cur, v, lds);
        it += nb;
        if (it >= N_TR_ITEMS) break;
        cur = d1; d1 = d2;
#pragma unroll
        for (int i = 0; i < 4; ++i) { v[i] = v1[i]; v1[i] = v2[i]; }
    }
}

DI int route_token(const P& p, int l, int row, const float (&lg)[16]) {
    {
        float aff[16], sc[16];
#pragma unroll
        for (int e = 0; e < 16; ++e) { aff[e] = sigmoidf_(lg[e]); sc[e] = aff[e] + p.in[4][e]; }
        int bg = 0; float bgs = -3e38f;
#pragma unroll
        for (int g = 0; g < 4; ++g) {
            float m1 = -3e38f, m2 = -3e38f;
#pragma unroll
            for (int j = 0; j < 4; ++j) { const float v = sc[g * 4 + j]; if (v > m1) { m2 = m1; m1 = v; } else if (v > m2) m2 = v; }
            const float gs = m1 + m2;
            if (gs > bgs) { bgs = gs; bg = g; }
        }
        float s4[4], a4[4];
#pragma unroll
        for (int g = 0; g < 4; ++g)
#pragma unroll
            for (int j = 0; j < 4; ++j) if (g == bg) { s4[j] = sc[g * 4 + j]; a4[j] = aff[g * 4 + j]; }
        int i1 = 0; float b1 = s4[0];
#pragma unroll
        for (int j = 1; j < 4; ++j) if (s4[j] > b1) { b1 = s4[j]; i1 = j; }
        int i2 = -1; float b2 = -3e38f;
#pragma unroll
        for (int j = 0; j < 4; ++j) if (j != i1 && s4[j] > b2) { b2 = s4[j]; i2 = j; }
        float w1 = 0.f, w2 = 0.f;
#pragma unroll
        for (int j = 0; j < 4; ++j) { if (j == i1) w1 = a4[j]; if (j == i2) w2 = a4[j]; }
        const float inv = 1.f / (w1 + w2);
        w1 *= inv; w2 *= inv;
        const int a = i1 < i2 ? i1 : i2, bb = i1 < i2 ? i2 : i1;
        const float wa = i1 < i2 ? w1 : w2, wb = i1 < i2 ? w2 : w1;
        const int pidx = (a == 0) ? (bb - 1) : (a == 1 ? (bb + 1) : 5);
        const int cls = bg * 6 + pidx;
        p.tokw[(size_t)row * 2 + 0] = wa; p.tokw[(size_t)row * 2 + 1] = wb;
        return cls;
    }
}


constexpr int N_NORM_ITEMS = T / 64;
DI void phase_norm_item(const P& p, int l, int which, int item, float* lds) {
    typedef short bf16x8 __attribute__((ext_vector_type(8)));
    typedef float f32x16 __attribute__((ext_vector_type(16)));
    const int tid = tidx(), w = __builtin_amdgcn_readfirstlane(tid >> 6), lane = tid & 63, r = lane & 31, h = lane >> 5;
    const int R0 = item * 64, b = R0 / S;
    float* cm = lds;
    float* cs = lds + 2048;
    float* red = lds + 4096;
    float* fin = lds + 4096 + 16384;
    {
        const float* xb = ((l == 0 && which == 0) ? p.in[0] : p.xres) + lane * 4;
        float4 xv[3][8];
#define NROW(q) (R0 + ((q) < 4 ? 4 * w + (q) : 32 + 4 * w + (q) - 4))
#pragma unroll
        for (int j = 0; j < 2; ++j)
#pragma unroll
            for (int i = 0; i < 8; ++i) xv[j][i] = *(const float4*)(xb + (size_t)NROW(j) * D + i * 256);
        {
            const float* g = p.in[which ? 6 : 5] + (size_t)l * D;
            const float* sh = p.mod + ((size_t)l * 4 + b) * 12288 + (which ? 3 * D : 0);
            const float4 gv = *(const float4*)(g + tid * 4), shv = *(const float4*)(sh + tid * 4), scv = *(const float4*)(sh + D + tid * 4);
            float4 mv; mv.x = gv.x * (1.f + scv.x); mv.y = gv.y * (1.f + scv.y); mv.z = gv.z * (1.f + scv.z); mv.w = gv.w * (1.f + scv.w);
            *(float4*)(cm + tid * 4) = mv; *(float4*)(cs + tid * 4) = shv;
        }
        __syncthreads();
#pragma unroll
        for (int bt = 0; bt < 8; ++bt) {
            if (bt < 6) {
#pragma unroll
                for (int i = 0; i < 8; ++i) xv[(bt + 2) % 3][i] = *(const float4*)(xb + (size_t)NROW(bt + 2) * D + i * 256);
            }
            asm volatile("" ::: "memory");
            float ss0 = 0.f;
#pragma unroll
            for (int i = 0; i < 8; ++i) { const float4 a = xv[bt % 3][i]; ss0 += a.x * a.x + a.y * a.y + a.z * a.z + a.w * a.w; }
            ss0 = wave_sum_dpp(ss0);
            const float rr = rsqrtf(ss0 * (1.f / D) + EPS);
#pragma unroll
            for (int i = 0; i < 8; ++i) {
                const float4 mv = *(const float4*)(cm + i * 256 + lane * 4), shv = *(const float4*)(cs + i * 256 + lane * 4);
                const float4 x = xv[bt % 3][i];
                const float h0 = x.x * rr * mv.x + shv.x, h1 = x.y * rr * mv.y + shv.y, h2 = x.z * rr * mv.z + shv.z, h3 = x.w * rr * mv.w + shv.w;
                uint2 pk;
                pk.x = (unsigned)f2bf(h0) | ((unsigned)f2bf(h1) << 16); pk.y = (unsigned)f2bf(h2) | ((unsigned)f2bf(h3) << 16);
                const size_t off = (size_t)NROW(bt) * D + i * 256 + lane * 4;
                *(uint2*)(p.hbuf + off) = pk;
                if (which) {
                    uint2 lo;
                    lo.x = (unsigned)f2bf(h0 - __uint_as_float(pk.x << 16)) | ((unsigned)f2bf(h1 - __uint_as_float(pk.x & 0xffff0000u)) << 16);
                    lo.y = (unsigned)f2bf(h2 - __uint_as_float(pk.y << 16)) | ((unsigned)f2bf(h3 - __uint_as_float(pk.y & 0xffff0000u)) << 16);
                    *(uint2*)(p.hlo + off) = lo;
                }
            }
        }
#undef NROW
    }
    if (which) SUBSTAMP(11);
    asm volatile("s_waitcnt vmcnt(0)" ::: "memory");
    __syncthreads();
    if (which) SUBSTAMP(12);
    f32x16 acc[2];
#pragma unroll
    for (int i = 0; i < 16; ++i) { acc[0][i] = 0.f; acc[1][i] = 0.f; }
    {
        typedef unsigned u32x4n __attribute__((ext_vector_type(4)));
        constexpr int CP = 272;
        constexpr int OB_HI = 0, OB_LO = 64 * CP, OA_HI = 128 * CP, OA_LO = 160 * CP;
        LAS char* cb = (LAS char*)lds;
        const bf16_t* ag = which ? p.crT : p.cgT + (size_t)l * 32 * 2048;
        const int prow = tid >> 4, pc16 = tid & 15;
        const bf16_t* gb = p.hbuf + (size_t)(R0 + prow) * D + pc16 * 8;
        const bf16_t* gl = p.hlo + (size_t)(R0 + prow) * D + pc16 * 8;
        const bf16_t* ga = ag + (size_t)prow * 2048 + pc16 * 8;
        u32x4n rg[4][6];
#define NRM_LOAD(c, sl) do { \
        rg[sl][0] = *(const u32x4n*)(gb + (c) * 128); rg[sl][1] = *(const u32x4n*)(gb + (size_t)32 * D + (c) * 128); rg[sl][4] = *(const u32x4n*)(ga + (c) * 128); \
        if (which) { rg[sl][2] = *(const u32x4n*)(gl + (c) * 128); rg[sl][3] = *(const u32x4n*)(gl + (size_t)32 * D + (c) * 128); rg[sl][5] = *(const u32x4n*)(ga + (size_t)32 * 2048 + (c) * 128); } } while (0)
        NRM_LOAD(0, 0); NRM_LOAD(1, 1); NRM_LOAD(2, 2);
        const int ko = (16 * w + 8 * h) * 2;
        for (int c4 = 0; c4 < 16; c4 += 4) {
#pragma unroll
            for (int sl = 0; sl < 4; ++sl) {
                const int c = c4 + sl;
                if (c + 3 < 16) NRM_LOAD(c + 3, (sl + 3) & 3);
                *(LAS u32x4n*)(cb + OB_HI + prow * CP + pc16 * 16) = rg[sl][0]; *(LAS u32x4n*)(cb + OB_HI + (prow + 32) * CP + pc16 * 16) = rg[sl][1];
                *(LAS u32x4n*)(cb + OA_HI + prow * CP + pc16 * 16) = rg[sl][4];
                if (which) { *(LAS u32x4n*)(cb + OB_LO + prow * CP + pc16 * 16) = rg[sl][2]; *(LAS u32x4n*)(cb + OB_LO + (prow + 32) * CP + pc16 * 16) = rg[sl][3];
                             *(LAS u32x4n*)(cb + OA_LO + prow * CP + pc16 * 16) = rg[sl][5]; }
                __syncthreads();
                const bf16x8 aq = *(const LAS bf16x8*)(cb + OA_HI + r * CP + ko);
                const bf16x8 b0 = *(const LAS bf16x8*)(cb + OB_HI + r * CP + ko), b1 = *(const LAS bf16x8*)(cb + OB_HI + (32 + r) * CP + ko);
                acc[0] = __builtin_amdgcn_mfma_f32_32x32x16_bf16(aq, b0, acc[0], 0, 0, 0);
                acc[1] = __builtin_amdgcn_mfma_f32_32x32x16_bf16(aq, b1, acc[1], 0, 0, 0);
                if (which) {
                    const bf16x8 al = *(const LAS bf16x8*)(cb + OA_LO + r * CP + ko);
                    const bf16x8 l0 = *(const LAS bf16x8*)(cb + OB_LO + r * CP + ko), l1 = *(const LAS bf16x8*)(cb + OB_LO + (32 + r) * CP + ko);
                    acc[0] = __builtin_amdgcn_mfma_f32_32x32x16_bf16(al, b0, acc[0], 0, 0, 0);
                    acc[0] = __builtin_amdgcn_mfma_f32_32x32x16_bf16(aq, l0, acc[0], 0, 0, 0);
                    acc[1] = __builtin_amdgcn_mfma_f32_32x32x16_bf16(al, b1, acc[1], 0, 0, 0);
                    acc[1] = __builtin_amdgcn_mfma_f32_32x32x16_bf16(aq, l1, acc[1], 0, 0, 0);
                }
                __syncthreads();
            }
        }
#undef NRM_LOAD
    }
#pragma unroll
    for (int g = 0; g < 2; ++g)
#pragma unroll
        for (int i = 0; i < 16; ++i) red[((g * 8 + w) * 16 + i) * 64 + lane] = acc[g][i];
    __syncthreads();
#pragma unroll
    for (int j = 0; j < 4; ++j) {
        const int idx = tid + NTHR * j, g = idx >> 10, i = (idx >> 6) & 15, ln = idx & 63;
        float v = 0.f;
#pragma unroll
        for (int ww = 0; ww < 8; ++ww) v += red[((g * 8 + ww) * 16 + i) * 64 + ln];
        const int e = (i & 3) + 8 * (i >> 2) + 4 * (ln >> 5);
        fin[(g * 32 + e) * 33 + (ln & 31)] = v;
    }
    __syncthreads();
    if (which) SUBSTAMP(13);
    if (!which) {
        for (int idx = tid; idx < 64 * 24; idx += NTHR) { const int row = idx / 24, e = idx % 24; p.proj[(size_t)(R0 + row) * LDP + OFF_GD + e] = f2bf(fin[((row >> 5) * 32 + e) * 33 + (row & 31)]); }
    } else {
        int* lcnt = (int*)(fin + 2 * 32 * 33);
        if (tid < 64) lcnt[tid] = 0;
        __syncthreads();
        int cls = 0, rank = 0;
        if (tid < 64) {
            float lg[16];
#pragma unroll
            for (int e = 0; e < 16; ++e) lg[e] = fin[((tid >> 5) * 32 + e) * 33 + (tid & 31)];
            cls = route_token(p, l, R0 + tid, lg);
            rank = atomicAdd(&lcnt[cls], 1);
        }
        __syncthreads();
        if (tid < NCLS) { const int c = lcnt[tid]; lcnt[32 + tid] = c ? (int)atomicAdd(p.ctl + CTL_CNT + l * 32 + tid, (unsigned)c) : 0; }
        __syncthreads();
        if (tid < 64) p.cls_tok[(size_t)cls * CLS_CAP + lcnt[32 + cls] + rank] = R0 + tid;
    }
    __syncthreads();
}

DI void cls_experts(int cls, int& ea, int& eb) {
    const int g = cls / 6, pi = cls % 6;
    const int a = pi < 3 ? 0 : (pi < 5 ? 1 : 2);
    const int b = pi < 3 ? pi + 1 : (pi < 5 ? pi - 1 : 3);
    ea = g * 4 + a; eb = g * 4 + b;
}
DI bool cls_find(unsigned* cnt, int ft, int& cls, int& mt, int& slot_base) {
    int base = 0;
    for (int c = 0; c < NCLS; ++c) {
        const int nt = ((int)__hip_atomic_load(cnt + c, __ATOMIC_RELAXED, __HIP_MEMORY_SCOPE_AGENT) + 255) >> 8;
        if (ft < base + nt) { cls = c; mt = ft - base; slot_base = base * 256; return true; }
        base += nt;
    }
    return false;
}
DI int cls_total_tiles(unsigned* cnt) { int base = 0; for (int c = 0; c < NCLS; ++c) base += ((int)__hip_atomic_load(cnt + c, __ATOMIC_RELAXED, __HIP_MEMORY_SCOPE_AGENT) + 255) >> 8; return base; }

constexpr int N_KMEAN_GROUPS = 4 * 8 * 4;
DI void phase_kmean_group(const P& p, int g, float* lds) {
    typedef unsigned u32x4n __attribute__((ext_vector_type(4)));
    const int tid = tidx(), pc = tid & 7, ri = tid >> 3;
    const int item0 = g * 4, b = item0 / 128, h = (item0 / 16) % 8, blk0 = item0 % 16;
    const bf16_t* k = p.proj + ((size_t)b * S + blk0 * 256 + ri) * LDP + OFF_KC + h * 64 + pc * 8;
    u32x4n v[16];
#pragma unroll
    for (int j = 0; j < 16; ++j) v[j] = *(const u32x4n*)(k + (size_t)(j * 64) * LDP);
#pragma unroll
    for (int it = 0; it < 4; ++it) {
        float a[8];
#pragma unroll
        for (int e = 0; e < 8; ++e) a[e] = 0.f;
#pragma unroll
        for (int jj = 0; jj < 4; ++jj) {
            const u32x4n x = v[it * 4 + jj];
            a[0] += __uint_as_float(x.x << 16); a[1] += __uint_as_float(x.x & 0xffff0000u); a[2] += __uint_as_float(x.y << 16); a[3] += __uint_as_float(x.y & 0xffff0000u);
            a[4] += __uint_as_float(x.z << 16); a[5] += __uint_as_float(x.z & 0xffff0000u); a[6] += __uint_as_float(x.w << 16); a[7] += __uint_as_float(x.w & 0xffff0000u);
        }
        float* dst = lds + (it * 64 + ri) * 64 + pc * 8;
        *(float4*)dst = make_float4(a[0], a[1], a[2], a[3]); *(float4*)(dst + 4) = make_float4(a[4], a[5], a[6], a[7]);
    }
    __syncthreads();
    if (tid < 256) {
        const int it = tid >> 6, d = tid & 63;
        float sum = 0.f;
#pragma unroll 8
        for (int q = 0; q < 64; ++q) sum += lds[(it * 64 + q) * 64 + d];
        p.kmean[(size_t)(item0 + it) * 64 + d] = sum * (1.f / 256.f);
    }
    __syncthreads();
}
namespace fa { DI unsigned cvtpk(float lo, float hi); typedef float f32x16 __attribute__((ext_vector_type(16))); DI void store_o(bf16_t* orow, int h, const f32x16 (&o)[2], float inv); }
constexpr int N_CMP_ITEMS = 2 * 64;
DI void phase_cmp_item(const P& p, int l, int item, float* lds) {
    typedef short bf16x8 __attribute__((ext_vector_type(8)));
    typedef float f32x16 __attribute__((ext_vector_type(16)));
    typedef unsigned u32x4n __attribute__((ext_vector_type(4)));
    typedef float f32x4n __attribute__((ext_vector_type(4)));
    typedef __attribute__((address_space(3))) char LC;
    const int tid = tidx(), w = __builtin_amdgcn_readfirstlane(tid >> 6), lane = tid & 63, r = lane & 31, h = lane >> 5;
    const int v = item >> 6, rb = item & 63;
    int R = rb * 32 + r; const bool valid = R < 2040; if (!valid) R = 2039;
    const int b = R / 510, hk = (R / 255) & 1, n = R % 255;
    constexpr int CP = 272, OA = 0, OBX = 128 * CP;
    LC* cb = (LC*)lds;
    const int prow = tid >> 4, pc16 = tid & 15;
    int PR = rb * 32 + prow; if (PR >= 2040) PR = 2039;
    const int pb = PR / 510, phk = (PR / 255) & 1, pn = PR % 255;
    const bf16_t* xsrc = p.proj + ((size_t)pb * S + 16 * pn + (pc16 >> 3)) * LDP + (v ? OFF_VDC : OFF_KDC) + phk * 64 + (pc16 & 7) * 8;
    const int peo = (pc16 >> 3) * 64 + (pc16 & 7) * 8;
    const bf16_t* w1s = p.cw1T + (size_t)(l * 2 + v) * 128 * 2048 + (size_t)prow * 2048 + pc16 * 8;
    constexpr int OPE = 160 * CP;
    { const float* pe = p.in[v ? 11 : 10] + (size_t)l * 2048; *(__attribute__((address_space(3))) f32x4n*)(cb + OPE + tid * 16) = *(const f32x4n*)(pe + tid * 4); }
    u32x4n ra[4][4], rx[4];
#define CMP_LOAD(c, sl) do { \
    _Pragma("unroll") for (int j = 0; j < 4; ++j) ra[sl][j] = *(const u32x4n*)(w1s + (size_t)(32 * j) * 2048 + (c) * 128); \
    rx[sl] = *(const u32x4n*)(xsrc + (size_t)(2 * (c)) * LDP); } while (0)
    CMP_LOAD(0, 0); CMP_LOAD(1, 1); CMP_LOAD(2, 2);
    __syncthreads();
    f32x16 acc[4];
#pragma unroll
    for (int hb = 0; hb < 4; ++hb)
#pragma unroll
        for (int i = 0; i < 16; ++i) acc[hb][i] = 0.f;
    const int ko = (16 * w + 8 * h) * 2;
    for (int c4 = 0; c4 < 16; c4 += 4) {
#pragma unroll
        for (int sl = 0; sl < 4; ++sl) {
            const int c = c4 + sl;
            if (c + 3 < 16) CMP_LOAD(c + 3, (sl + 3) & 3);
#pragma unroll
            for (int j = 0; j < 4; ++j) *(__attribute__((address_space(3))) u32x4n*)(cb + OA + (prow + 32 * j) * CP + pc16 * 16) = ra[sl][j];
            {
                const u32x4n xa = rx[sl]; const f32x4n p0 = *(const __attribute__((address_space(3))) f32x4n*)(cb + OPE + (peo + c * 128) * 4), p1 = *(const __attribute__((address_space(3))) f32x4n*)(cb + OPE + (peo + c * 128 + 4) * 4);
                u32x4n xb;
                xb.x = fa::cvtpk(__uint_as_float(xa.x << 16) + p0.x, __uint_as_float(xa.x & 0xffff0000u) + p0.y);
                xb.y = fa::cvtpk(__uint_as_float(xa.y << 16) + p0.z, __uint_as_float(xa.y & 0xffff0000u) + p0.w);
                xb.z = fa::cvtpk(__uint_as_float(xa.z << 16) + p1.x, __uint_as_float(xa.z & 0xffff0000u) + p1.y);
                xb.w = fa::cvtpk(__uint_as_float(xa.w << 16) + p1.z, __uint_as_float(xa.w & 0xffff0000u) + p1.w);
                *(__attribute__((address_space(3))) u32x4n*)(cb + OBX + prow * CP + pc16 * 16) = xb;
            }
            __syncthreads();
            const bf16x8 xf = *(const __attribute__((address_space(3))) bf16x8*)(cb + OBX + r * CP + ko);
#pragma unroll
            for (int hb = 0; hb < 4; ++hb) {
                const bf16x8 wa = *(const __attribute__((address_space(3))) bf16x8*)(cb + OA + (hb * 32 + r) * CP + ko);
                acc[hb] = __builtin_amdgcn_mfma_f32_32x32x16_bf16(wa, xf, acc[hb], 0, 0, 0);
            }
            __syncthreads();
        }
    }
#undef CMP_LOAD
    float* red = lds;
#pragma unroll
    for (int hb = 0; hb < 4; ++hb)
#pragma unroll
        for (int i = 0; i < 16; ++i) red[((w * 4 + hb) * 16 + i) * 64 + lane] = acc[hb][i];
    __syncthreads();
    f32x16 o[2];
    if (w < 4) {
        f32x16 hsum;
#pragma unroll
        for (int i = 0; i < 16; ++i) { float t = 0.f;
#pragma unroll
            for (int ww = 0; ww < 8; ++ww) t += red[((ww * 4 + w) * 16 + i) * 64 + lane];
            hsum[i] = gelu_tanh(t); o[0][i] = 0.f; o[1][i] = 0.f; }
        const bf16_t* w2 = p.cw2T + (size_t)(l * 2 + v) * 64 * 128 + (size_t)r * 128 + 4 * h;
#pragma unroll
        for (int s2 = 0; s2 < 2; ++s2) {
            uint4 pk;
            pk.x = fa::cvtpk(hsum[8 * s2], hsum[8 * s2 + 1]); pk.y = fa::cvtpk(hsum[8 * s2 + 2], hsum[8 * s2 + 3]); pk.z = fa::cvtpk(hsum[8 * s2 + 4], hsum[8 * s2 + 5]); pk.w = fa::cvtpk(hsum[8 * s2 + 6], hsum[8 * s2 + 7]);
            const bf16x8 pb = __builtin_bit_cast(bf16x8, pk);
#pragma unroll
            for (int dh = 0; dh < 2; ++dh) {
                const bf16_t* wp = w2 + (size_t)dh * 32 * 128 + w * 32 + 16 * s2;
                const uint2 lo = *(const uint2*)wp, hi = *(const uint2*)(wp + 8);
                uint4 wv; wv.x = lo.x; wv.y = lo.y; wv.z = hi.x; wv.w = hi.y;
                o[dh] = __builtin_amdgcn_mfma_f32_32x32x16_bf16(__builtin_bit_cast(bf16x8, wv), pb, o[dh], 0, 0, 0);
            }
        }
    }
    __syncthreads();
    if (w < 4) {
#pragma unroll
        for (int dh = 0; dh < 2; ++dh)
#pragma unroll
            for (int i = 0; i < 16; ++i) red[((w * 2 + dh) * 16 + i) * 64 + lane] = o[dh][i];
    }
    __syncthreads();
    if (w == 0) {
#pragma unroll
        for (int dh = 0; dh < 2; ++dh)
#pragma unroll
            for (int i = 0; i < 16; ++i) o[dh][i] = (red[((0 * 2 + dh) * 16 + i) * 64 + lane] + red[((1 * 2 + dh) * 16 + i) * 64 + lane]) + (red[((2 * 2 + dh) * 16 + i) * 64 + lane] + red[((3 * 2 + dh) * 16 + i) * 64 + lane]);
        if (valid) fa::store_o((v ? p.vc : p.kc) + (((size_t)b * 2 + hk) * 256 + n) * 64, h, o, 1.f);
    }
    __syncthreads();
}


template <class C>
DI float attn_wave(const bf16_t* qrow, const C& cand, int ncand, bool has_sink, float sink, float* sl, float& lse_out) {
    const int lane = tidx() & 63;
    float q[64];
#pragma unroll
    for (int i = 0; i < 8; ++i) {
        const uint4 v = *(const uint4*)(qrow + i * 8);
        const unsigned u[4] = {v.x, v.y, v.z, v.w};
#pragma unroll
        for (int j = 0; j < 4; ++j) { q[i * 8 + 2 * j] = __uint_as_float(u[j] << 16); q[i * 8 + 2 * j + 1] = __uint_as_float(u[j] & 0xffff0000u); }
    }
    float mx = NEGF;
    for (int c0 = 0; c0 < ncand; c0 += 64) {
        const int c = c0 + lane;
        float s = NEGF;
        if (c < ncand) {
            const bf16_t *kr, *vr; float bias;
            if (cand.get(c, kr, vr, bias)) {
                float dot = 0.f;
#pragma unroll
                for (int i = 0; i < 8; ++i) {
                    const uint4 v = *(const uint4*)(kr + i * 8);
                    const unsigned u[4] = {v.x, v.y, v.z, v.w};
#pragma unroll
                    for (int j = 0; j < 4; ++j) { dot += q[i * 8 + 2 * j] * __uint_as_float(u[j] << 16); dot += q[i * 8 + 2 * j + 1] * __uint_as_float(u[j] & 0xffff0000u); }
                }
                s = dot * 0.125f + bias;
            }
            sl[c] = s;
        }
        mx = fmaxf(mx, s);
    }
    mx = wave_max(mx);
    if (has_sink) mx = fmaxf(mx, sink);
    float sum = 0.f;
    for (int c0 = 0; c0 < ncand; c0 += 64) {
        const int c = c0 + lane;
        if (c < ncand) { const float s = sl[c]; const float e = (s > -1e29f) ? __expf(s - mx) : 0.f; sl[c] = e; sum += e; }
    }
    sum = wave_sum(sum);
    if (has_sink) sum += __expf(sink - mx);
    sum = fmaxf(sum, 1.17549435e-38f);
    lse_out = mx + logf(sum);
    const float inv = 1.f / sum;
    for (int c0 = 0; c0 < ncand; c0 += 64) { const int c = c0 + lane; if (c < ncand) sl[c] *= inv; }
    wave_lds_sync();
    float o = 0.f;
    for (int c = 0; c < ncand; ++c) {
        const float pr = sl[c];
        if (pr != 0.f) { const bf16_t *kr, *vr; float bias; cand.get(c, kr, vr, bias); o += pr * bf2f(vr[lane]); }
    }
    return o;
}

struct BandCand {
    const bf16_t *kb, *vb; int t, r; const float* tab;
    DI bool get(int c, const bf16_t*& kr, const bf16_t*& vr, float& bias) const {
        const int kp = t - c * r; if (kp < 0) return false;
        kr = kb + (size_t)kp * LDP; vr = vb + (size_t)kp * LDP; bias = tab[t5_bucket(c * r) * 32]; return true;
    }
};
struct MobaCand {
    const bf16_t *kb, *vb; int t; const int* sel; const float* tab;
    DI bool get(int c, const bf16_t*& kr, const bf16_t*& vr, float& bias) const {
        const int blk = sel[c >> 8], j = c & 255;
        if (blk < 0) return false;
        const int kp = blk * 256 + j; if (kp > t) return false;
        kr = kb + (size_t)kp * LDP; vr = vb + (size_t)kp * LDP; bias = tab[t5_bucket(t - kp) * 32]; return true;
    }
};
struct CmpCand {
    const bf16_t *kc, *vc; int t;
    DI bool get(int c, const bf16_t*& kr, const bf16_t*& vr, float& bias) const {
        if (16 * c + 31 > t) return false;
        kr = kc + (size_t)c * 64; vr = vc + (size_t)c * 64; bias = 0.f; return true;
    }
};
struct SlcCand {
    const bf16_t *kb, *vb; int t; const int* sel; const float* tab;
    DI bool get(int c, const bf16_t*& kr, const bf16_t*& vr, float& bias) const {
        const int blk = sel[c >> 6]; if (blk < 0) return false;
        const int kp = blk * 64 + (c & 63); if (kp > t) return false;
        kr = kb + (size_t)kp * LDP; vr = vb + (size_t)kp * LDP; bias = tab[t5_bucket(t - kp) * 32]; return true;
    }
};

constexpr int N_ATT_WAVE_ITEMS = 3 * T * 8 + T * 8 + T * 8;
DI void phase_attn_wave_item(const P& p, int l, int item, float* sl, int* selw) {
    const int lane = tidx() & 63;
    const float* relb = p.in[2];
    if (item < 3 * T * 8) {
        const int cfg = item / (T * 8), rem = item % (T * 8), row = rem >> 3, h = rem & 7, b = row / S, t = row % S;
        const int r = cfg == 0 ? 1 : (cfg == 1 ? 4 : 16);
        BandCand cd{p.proj + (size_t)b * S * LDP + OFF_KA + h * 64, p.proj + (size_t)b * S * LDP + OFF_VA + h * 64, t, r, relb + 0 + h};
        float lse;
        const float o = attn_wave(p.proj + (size_t)row * LDP + OFF_QA + h * 64, cd, 129, false, 0.f, sl, lse);
        p.oA[((size_t)cfg * T + row) * 512 + h * 64 + lane] = f2bf(o);
        if (lane == 0) p.lseA[((size_t)cfg * T + row) * 8 + h] = lse;
        return;
    }
    item -= 3 * T * 8;
    if (item < T * 8) {
        const int row = item >> 3, hq = item & 7, kvh = hq >> 2, b = row / S, t = row % S;
        BandCand cd{p.proj + (size_t)b * S * LDP + OFF_KB + kvh * 64, p.proj + (size_t)b * S * LDP + OFF_VB + kvh * 64, t, 1, relb + 8 + hq};
        float lse;
        const float o = attn_wave(p.proj + (size_t)row * LDP + OFF_QB + hq * 64, cd, 128, true, p.in[16][l * 8 + hq], sl, lse);
        p.oB[(size_t)row * 512 + hq * 64 + lane] = f2bf(o);
        return;
    }
    item -= T * 8;
    {
        const int row = item >> 3, h = item & 7, b = row / S, t = row % S, cur = t >> 8;
        const bf16_t* qrow = p.proj + (size_t)row * LDP + OFF_QC + h * 64;
        float gate = NEGF;
        if (lane < cur) {
            const float* km = p.kmean + (((size_t)b * 8 + h) * 16 + lane) * 64;
            float dot = 0.f;
            for (int d = 0; d < 64; ++d) dot += bf2f(qrow[d]) * km[d];
            gate = dot;
        }
        int s0, s1, s2;
        { float v = gate; int idx = lane;
          for (int o = 32; o > 0; o >>= 1) { const float ov = __shfl_xor(v, o); const int oi = __shfl_xor(idx, o); if (ov > v || (ov == v && oi < idx)) { v = ov; idx = oi; } }
          s0 = (v > -1e29f) ? idx : -1; if (lane == idx) gate = -3e38f; }
        { float v = gate; int idx = lane;
          for (int o = 32; o > 0; o >>= 1) { const float ov = __shfl_xor(v, o); const int oi = __shfl_xor(idx, o); if (ov > v || (ov == v && oi < idx)) { v = ov; idx = oi; } }
          s1 = (v > -1e29f) ? idx : -1; if (lane == idx) gate = -3e38f; }
        { float v = gate; int idx = lane;
          for (int o = 32; o > 0; o >>= 1) { const float ov = __shfl_xor(v, o); const int oi = __shfl_xor(idx, o); if (ov > v || (ov == v && oi < idx)) { v = ov; idx = oi; } }
          s2 = (v > -1e29f) ? idx : -1; if (lane == idx) gate = -3e38f; }
        if (lane == 0) { selw[0] = s0; selw[1] = s1; selw[2] = s2; selw[3] = cur; }
        wave_lds_sync();
        MobaCand cd{p.proj + (size_t)b * S * LDP + OFF_KC + h * 64, p.proj + (size_t)b * S * LDP + OFF_VC + h * 64, t, selw, relb + 16 + h};
        float lse;
        const float o = attn_wave(qrow, cd, 1024, false, 0.f, sl, lse);
        p.oC[(size_t)row * 512 + h * 64 + lane] = f2bf(o);
    }
}
constexpr int N_NSA_ITEMS = 4 * 2 * S;
DI void phase_nsa_item(const P& p, int l, int item0, float* lds) {
    const int tid = tidx(), grp = tid >> 8, g = (tid >> 6) & 3, lane = tid & 63;
    const int item = item0 + grp;
    const int b = item / (2 * S), hk = (item / S) % 2, t = item % S, hq = hk * 4 + g;
    const int row = b * S + t, cur = t >> 6;
    float* gl = lds + grp * 4096;
    float* sl = gl + g * 1024;
    int* sel = (int*)(lds + 8192) + grp * 16;
    const bf16_t* qrow = p.proj + (size_t)row * LDP + OFF_QD + hq * 64;
    const float* relb = p.in[2];
    float lse;
    CmpCand cc{p.kc + ((size_t)b * 2 + hk) * 256 * 64, p.vc + ((size_t)b * 2 + hk) * 256 * 64, t};
    const float o_cmp = attn_wave(qrow, cc, 255, false, 0.f, sl, lse);
    __syncthreads();
    if (g == 0) {
        const int j = lane;
        float imp = 0.f;
        for (int n = 4 * j - 1; n <= 4 * j + 3; ++n)
            if (n >= 0 && n < 255) imp += gl[n] + gl[1024 + n] + gl[2048 + n] + gl[3072 + n];
        float val = (j == 0 || j == cur || j == cur - 1) ? 1e30f : (j <= cur ? imp : NEGF);
        for (int k = 0; k < 16; ++k) {
            float v = val; int idx = lane;
            for (int o = 32; o > 0; o >>= 1) { const float ov = __shfl_xor(v, o); const int oi = __shfl_xor(idx, o); if (ov > v || (ov == v && oi < idx)) { v = ov; idx = oi; } }
            if (lane == 0) sel[k] = (v > -1e29f) ? idx : -1;
            if (lane == idx) val = -3e38f;
        }
    }
    __syncthreads();
    SlcCand sc{p.proj + (size_t)b * S * LDP + OFF_KDS + hk * 64, p.proj + (size_t)b * S * LDP + OFF_VDS + hk * 64, t, sel, relb + 24 + hq};
    const float o_slc = attn_wave(qrow, sc, 1024, false, 0.f, sl, lse);
    BandCand wc{p.proj + (size_t)b * S * LDP + OFF_KDW + hk * 64, p.proj + (size_t)b * S * LDP + OFF_VDW + hk * 64, t, 1, relb + 24 + hq};
    const float o_win = attn_wave(qrow, wc, 512, false, 0.f, sl, lse);
    const bf16_t* gd = p.proj + (size_t)row * LDP + OFF_GD + hq * 3;
    const float g0 = sigmoidf_(bf2f(gd[0])), g1 = sigmoidf_(bf2f(gd[1])), g2 = sigmoidf_(bf2f(gd[2]));
    p.oD[(size_t)row * 512 + hq * 64 + lane] = f2bf(g0 * o_cmp + g1 * o_slc + g2 * o_win);
    __syncthreads();
}

constexpr int N_MIXN_WAVE_ITEMS = T;
struct MixIn { float l0, l1, l2; uint4 a0, a1, a2, q0, q1, q2; };
DI void mixnorm_load(const P& p, int row, MixIn& in) {
    const int lane = tidx() & 63, h = lane >> 3;
    in.l0 = p.lseA[((size_t)0 * T + row) * 8 + h]; in.l1 = p.lseA[((size_t)1 * T + row) * 8 + h]; in.l2 = p.lseA[((size_t)2 * T + row) * 8 + h];
    in.a0 = *(const uint4*)(p.oA + ((size_t)0 * T + row) * 512 + lane * 8);
    in.a1 = *(const uint4*)(p.oA + ((size_t)1 * T + row) * 512 + lane * 8);
    in.a2 = *(const uint4*)(p.oA + ((size_t)2 * T + row) * 512 + lane * 8);
    in.q0 = *(const uint4*)(p.oB + (size_t)row * 512 + lane * 8); in.q1 = *(const uint4*)(p.oC + (size_t)row * 512 + lane * 8); in.q2 = *(const uint4*)(p.oD + (size_t)row * 512 + lane * 8);
}
DI void mixnorm_finish(const P& p, int row, const MixIn& in) {
    const int lane = tidx() & 63;
    const float l0 = in.l0, l1 = in.l1, l2 = in.l2;
    const uint4 a0 = in.a0, a1 = in.a1, a2 = in.a2;
    const uint4 gq[3] = {in.q0, in.q1, in.q2};
    float v[4][8];
    {
        const float m = fmaxf(l0, fmaxf(l1, l2));
        float w0 = __expf(l0 - m), w1 = __expf(l1 - m), w2 = __expf(l2 - m);
        const float inv = 1.f / (w0 + w1 + w2); w0 *= inv; w1 *= inv; w2 *= inv;
        const unsigned au[4] = {a0.x, a0.y, a0.z, a0.w}, bu[4] = {a1.x, a1.y, a1.z, a1.w}, cu[4] = {a2.x, a2.y, a2.z, a2.w};
#pragma unroll
        for (int j = 0; j < 4; ++j) {
            v[0][2 * j] = w0 * __uint_as_float(au[j] << 16) + w1 * __uint_as_float(bu[j] << 16) + w2 * __uint_as_float(cu[j] << 16);
            v[0][2 * j + 1] = w0 * __uint_as_float(au[j] & 0xffff0000u) + w1 * __uint_as_float(bu[j] & 0xffff0000u) + w2 * __uint_as_float(cu[j] & 0xffff0000u);
        }
    }
#pragma unroll
    for (int g = 0; g < 3; ++g) {
        const unsigned au[4] = {gq[g].x, gq[g].y, gq[g].z, gq[g].w};
#pragma unroll
        for (int j = 0; j < 4; ++j) { v[g + 1][2 * j] = __uint_as_float(au[j] << 16); v[g + 1][2 * j + 1] = __uint_as_float(au[j] & 0xffff0000u); }
    }
    float ss[4];
#pragma unroll
    for (int g = 0; g < 4; ++g) { ss[g] = 0.f;
#pragma unroll
        for (int j = 0; j < 8; ++j) ss[g] += v[g][j] * v[g][j]; }
#pragma unroll
    for (int g = 0; g < 4; ++g) ss[g] = wave_sum_dpp(ss[g]);
#pragma unroll
    for (int g = 0; g < 4; ++g) {
        const float r = rsqrtf(ss[g] * (1.f / 512.f) + EPS);
        uint4 o;
        o.x = (unsigned)f2bf(v[g][0] * r) | ((unsigned)f2bf(v[g][1] * r) << 16);
        o.y = (unsigned)f2bf(v[g][2] * r) | ((unsigned)f2bf(v[g][3] * r) << 16);
        o.z = (unsigned)f2bf(v[g][4] * r) | ((unsigned)f2bf(v[g][5] * r) << 16);
        o.w = (unsigned)f2bf(v[g][6] * r) | ((unsigned)f2bf(v[g][7] * r) << 16);
        *(uint4*)(p.hbuf + (size_t)row * D + g * 512 + lane * 8) = o;
    }
}
DI void phase_mixnorm(const P& p, int first, int step) {
    int it = first;
    MixIn cur;
    if (it < N_MIXN_WAVE_ITEMS) mixnorm_load(p, it, cur);
    while (it < N_MIXN_WAVE_ITEMS) {
        const int nx = it + step;
        MixIn nxt = cur;
        if (nx < N_MIXN_WAVE_ITEMS) mixnorm_load(p, nx, nxt);
        mixnorm_finish(p, it, cur);
        cur = nxt; it = nx;
    }
}

DI void phase_final(const P& p, int first, int step, bool poison) {
    const int lane = tidx() & 63;
    float4 g[8];
#pragma unroll
    for (int i = 0; i < 8; ++i) g[i] = *(const float4*)(p.in[22] + i * 256 + lane * 4);
    int it = first;
    float4 v[8];
    if (it < T) {
#pragma unroll
        for (int i = 0; i < 8; ++i) v[i] = *(const float4*)(p.xres + (size_t)it * D + i * 256 + lane * 4);
    }
    while (it < T) {
        const int nx = it + step;
        float4 vn[8];
#pragma unroll
        for (int i = 0; i < 8; ++i) vn[i] = v[i];
        if (nx < T) {
#pragma unroll
            for (int i = 0; i < 8; ++i) vn[i] = *(const float4*)(p.xres + (size_t)nx * D + i * 256 + lane * 4);
        }
        float ss = 0.f;
#pragma unroll
        for (int i = 0; i < 8; ++i) ss += v[i].x * v[i].x + v[i].y * v[i].y + v[i].z * v[i].z + v[i].w * v[i].w;
        ss = wave_sum_dpp(ss);
        const float r = rsqrtf(ss * (1.f / D) + EPS);
#pragma unroll
        for (int i = 0; i < 8; ++i) {
            float4 o; o.x = v[i].x * r * g[i].x; o.y = v[i].y * r * g[i].y; o.z = v[i].z * r * g[i].z; o.w = v[i].w * r * g[i].w;
            if (poison) { o.x = o.y = o.z = o.w = __uint_as_float(0x7fc00000u); }
            *(float4*)(p.out + (size_t)it * D + i * 256 + lane * 4) = o;
        }
#pragma unroll
        for (int i = 0; i < 8; ++i) v[i] = vn[i];
        it = nx;
    }
}

#define XB_TMO      128
#define XB_XCNT(j)  (256  + 64 * (j))
#define XB_XSUB(j)  (1280 + 64 * (j))
#define XB_XGEN(j)  (2304 + 64 * (j))
#define XB_TOP      3328
#define XB_TOPGEN   3392
#define XCD_BAR_WORDS 3456
#define XB_SPIN_CAP (1u << 21)

__device__ __forceinline__ unsigned xb_ld(unsigned* p)              { return __hip_atomic_load(p, __ATOMIC_RELAXED, __HIP_MEMORY_SCOPE_AGENT); }
__device__ __forceinline__ unsigned xb_add(unsigned* p, unsigned v) { return __hip_atomic_fetch_add(p, v, __ATOMIC_RELAXED, __HIP_MEMORY_SCOPE_AGENT); }
__device__ __forceinline__ unsigned xb_xcc_id() { return (unsigned)__builtin_amdgcn_s_getreg((3 << 11) | 20) & 0xFu; }
#define XB_SPIN(cond, bar) do { unsigned _sp = 0; while (cond) { __builtin_amdgcn_s_sleep(1); \
    if ((++_sp & 255u) == 0u) { if (xb_ld(&(bar)[XB_TMO])) break; if (_sp > XB_SPIN_CAP) { atomicAdd(&(bar)[XB_TMO], 1u); break; } } } } while (0)

struct XcdBarrier { unsigned* bar; unsigned x; volatile LAS unsigned* st; };

__device__ __forceinline__ XcdBarrier xcd_barrier_post(unsigned* bar, volatile LAS unsigned* st) {
    XcdBarrier b; b.bar = bar; b.x = xb_xcc_id(); b.st = st;
    if (threadIdx.x == 0) (void)xb_add(&bar[XB_XCNT(b.x)], 1u);
    return b;
}
__device__ __forceinline__ void xcd_barrier_complete(unsigned* bar, unsigned x, unsigned& nloc, unsigned& nx) {
    const unsigned G = gridDim.x * gridDim.y * gridDim.z;
    unsigned sum, cnt, mine, sp = 0u;
    for (;;) {
        sum = 0u; cnt = 0u; mine = 0u;
#pragma unroll
        for (unsigned j = 0; j < 16; ++j) { const unsigned c = xb_ld(&bar[XB_XCNT(j)]); sum += c; cnt += (c > 0u) ? 1u : 0u; mine = (j == x) ? c : mine; }
        if (sum == G) break;
        __builtin_amdgcn_s_sleep(1);
        if ((++sp & 255u) == 0u) { if (xb_ld(&bar[XB_TMO])) break; if (sp > XB_SPIN_CAP) { atomicAdd(&bar[XB_TMO], 1u); break; } }
    }
    nloc = mine > 0u ? mine : 1u; nx = cnt > 0u ? cnt : 1u;
}
__device__ __forceinline__ void xcd_barrier(const XcdBarrier& b) {
    asm volatile("s_waitcnt vmcnt(0)" ::: "memory");
    __syncthreads();
    if (threadIdx.x == 0) {
        unsigned* bar = b.bar;
        __builtin_amdgcn_s_waitcnt(0);
        unsigned nloc = b.st[0], nx = b.st[1];
        if (nloc == 0u) { xcd_barrier_complete(bar, b.x, nloc, nx); b.st[0] = nloc; b.st[1] = nx; }
        const unsigned old = xb_add(&bar[XB_XSUB(b.x)], 1u);
        const unsigned gen = old / nloc;
        if (old + 1u == (gen + 1u) * nloc) {
            __builtin_amdgcn_fence(__ATOMIC_RELEASE, "agent");
            asm volatile("s_waitcnt vmcnt(0)" ::: "memory");
            const unsigned og = xb_add(&bar[XB_TOP], 1u);
            const unsigned tg = og / nx;
            if (og + 1u == (tg + 1u) * nx) xb_add(&bar[XB_TOPGEN], 1u);
            else XB_SPIN(xb_ld(&bar[XB_TOPGEN]) == tg, bar);
            __builtin_amdgcn_fence(__ATOMIC_ACQUIRE, "agent");
            xb_add(&bar[XB_XGEN(b.x)], 1u);
            asm volatile("s_waitcnt vmcnt(0)" ::: "memory");
        } else {
            XB_SPIN(xb_ld(&bar[XB_XGEN(b.x)]) == gen, bar);
            __builtin_amdgcn_fence(__ATOMIC_ACQUIRE, "agent");
            asm volatile("s_waitcnt vmcnt(0)" ::: "memory");
        }
    }
    __syncthreads();
}

namespace fa {
typedef short bf16x8 __attribute__((ext_vector_type(8)));
typedef short s16x4 __attribute__((ext_vector_type(4)));
typedef float f32x16 __attribute__((ext_vector_type(16)));
typedef __bf16 bf16x2_t __attribute__((ext_vector_type(2)));
typedef float f32x2_t __attribute__((ext_vector_type(2)));
constexpr int KP = 144, TILEB = 64 * KP;
constexpr int BT = 768, TBL = 904;
constexpr int NBUF = 4;
constexpr int L_K = 0, L_V = NBUF * TILEB, L_BT = 2 * NBUF * TILEB, L_B32 = L_BT + 4 * TBL * 4, L_NINF = L_B32 + 512, L_IMPA = L_NINF + 256, L_IMPB = L_IMPA + 64 * 64 * 4, L_SEL = L_IMPB + 64 * 64 * 4, L_TICKET = L_SEL + 512,
              L_OACC = L_IMPA  , L_RELB = L_TICKET + 512  , L_END = L_RELB + 4096;
static_assert(16 * 512 * 4 <= 2 * 64 * 64 * 4, "L_OACC fits the importance arrays");
static_assert(L_END <= 131072, "attention LDS map");
constexpr float LOG2E = 1.4426950408889634f, SC2 = 0.125f * LOG2E, LN2 = 0.6931471805599453f;
#define FA_MFMA(a, b, c) __builtin_amdgcn_mfma_f32_32x32x16_bf16((a), (b), (c), 0, 0, 0)
DI unsigned cvtpk(float lo, float hi) { f32x2_t v = {lo, hi}; bf16x2_t b = __builtin_convertvector(v, bf16x2_t); return __builtin_bit_cast(unsigned, b); }
DI s16x4 vtr(const LAS char* p) { return __builtin_bit_cast(s16x4, __builtin_amdgcn_ds_read_tr16_b64_v4i16((LAS s16x4*)p)); }
DI float xhalf(float v) { return __shfl_xor(v, 32); }
DI float touch(float x) { asm("" : "+v"(x)); return x; }
DI float quad_sum(float v) {
    v += __builtin_bit_cast(float, __builtin_amdgcn_update_dpp(0, __builtin_bit_cast(int, v), 0xB1, 0xF, 0xF, true));
    v += __builtin_bit_cast(float, __builtin_amdgcn_update_dpp(0, __builtin_bit_cast(int, v), 0x4E, 0xF, 0xF, true));
    return v;
}

struct Pass {
    const bf16_t* kb; const bf16_t* vb;
    int kpitch, kstride, nkeys;
    int t_lo, t_hi;
    int W;
    int msh;
};
typedef unsigned u32x4 __attribute__((ext_vector_type(4)));
DI void stage_load(const Pass& ps, int jt, int tid, u32x4& kreg, u32x4& vreg) {
    const int key = tid >> 3, chunk = tid & 7;
    int kidx = jt * 64 + key; kidx = kidx < 0 ? 0 : (kidx >= ps.nkeys ? ps.nkeys - 1 : kidx);
    const size_t off = (size_t)(kidx * ps.kstride) * ps.kpitch + chunk * 8;
    kreg = *(const u32x4*)(ps.kb + off); vreg = *(const u32x4*)(ps.vb + off);
}
DI void stage_store(LAS char* base, int buf, int tid, const u32x4& kreg, const u32x4& vreg) {
    const int key = tid >> 3, chunk = tid & 7;
    *(LAS u32x4*)(base + L_K + buf * TILEB + key * KP + chunk * 16) = kreg;
    *(LAS u32x4*)(base + L_V + buf * TILEB + key * KP + chunk * 16) = vreg;
}
struct Pre { u32x4 k0, v0, k1, v1; };
DI void flash_preload(const Pass& ps, Pre& pr) {
    const int tid = tidx();
    stage_load(ps, ps.t_lo, tid, pr.k0, pr.v0);
    if (ps.t_hi - ps.t_lo > 1) stage_load(ps, ps.t_lo + 1, tid, pr.k1, pr.v1); else { pr.k1 = pr.k0; pr.v1 = pr.v0; }
}
template <int MODE>
DI void flash_pass(LAS char* base, const Pass& ps, const bf16x8 (&qf)[4], int qidx, int tg, unsigned long long selmask, int wq_lo, int wq_hi,
                   f32x16 (&o)[2], float& m, float& l, float pscale, int qloc, const Pre* pre = nullptr) {
    constexpr bool BAND = MODE & 1, MASKED = MODE & 2, BIAS = MODE & 4, STATS = MODE & 8, IMP = MODE & 16;
    const int tid = tidx(), lane = tid & 63, r = lane & 31, h = lane >> 5;
    const int n = ps.t_hi - ps.t_lo;
    if (n <= 0) return;
    u32x4 kreg, vreg;
    {
        Pre pr;
        if (pre) pr = *pre; else flash_preload(ps, pr);
        stage_store(base, 0, tid, pr.k0, pr.v0);
        if (n > 1) stage_store(base, 1, tid, pr.k1, pr.v1);
    }
    __syncthreads();
    const LAS float* bt = (const LAS float*)(base + L_BT) + tg * TBL;
    const LAS float* b32 = (const LAS float*)(base + L_B32) + tg * 32;
    float mr = m > -1e29f ? __builtin_ceilf(m) : 0.f;
    mr = fminf(fmaxf(mr, -256.f), 256.f);
    l *= __builtin_amdgcn_exp2f(m - mr);
    bool refnz = __builtin_amdgcn_ballot_w64(mr != 0.f) != 0ull, resc = false;
    float ovf = 0.f;
    u32x4 kxv; kxv.x = h ? 0u : 0x3F80BF80u; kxv.y = h ? 0u : 0x3F803F80u; kxv.z = 0u; kxv.w = 0u;
    const bf16x8 kx = __builtin_bit_cast(bf16x8, kxv);
    for (int it = 0; it < n; ++it) {
        const int jt = ps.t_lo + it, buf = it & (NBUF - 1);
        if (it + 2 < n) stage_load(ps, jt + 2, tid, kreg, vreg);
        const int k0 = jt * 64;
        bool lane_ok = true;
        if constexpr (MASKED) lane_ok = (selmask >> (jt >> ps.msh)) & 1ull;
        bool need;
        if constexpr (BAND) need = (k0 <= wq_hi) && (k0 + 63 >= wq_lo - ps.W);
        else need = (k0 <= wq_hi);
        if constexpr (MASKED) need = need && (__builtin_amdgcn_ballot_w64(lane_ok) != 0ull);
        if (need) {
            const LAS char* Kt = base + L_K + buf * TILEB; const LAS char* Vt = base + L_V + buf * TILEB;
            const int d0 = qidx - k0 - 4 * h;
            const bool full = BAND ? (wq_hi - k0 <= ps.W && wq_lo - (k0 + 63) >= 0) : (wq_lo - (k0 + 63) >= 0);
            if constexpr (!IMP) {
                if (resc) {
                    const float lt = l + xhalf(l);
                    float d = lt > 1.f ? __builtin_ceilf(__builtin_amdgcn_logf(lt)) : 0.f;
                    d = fminf(d, 256.f - mr);
                    const float alpha = __builtin_amdgcn_exp2f(-d);
                    l *= alpha; mr += d;
                    if constexpr (!STATS) {
#pragma unroll
                        for (int i = 0; i < 16; ++i) { o[0][i] *= alpha; o[1][i] *= alpha; }
                    }
                    refnz = __builtin_amdgcn_ballot_w64(mr != 0.f) != 0ull; resc = false; ovf = 0.f;
                }
            }
            int bmode = 0, t1 = 0x7fffffff; float bv0 = 0.f, bv1 = 0.f; const LAS float* tb = bt;
            if constexpr (BIAS) {
                if ((wq_hi - k0) >= BT) {
                    int dmin = wq_lo - (k0 + 63); dmin = dmin < 0 ? 0 : dmin;
                    const int b0 = 28 + (dmin >= 825) + (dmin >= 1117) + (dmin >= 1513);
                    t1 = b0 == 28 ? 825 : (b0 == 29 ? 1117 : (b0 == 30 ? 1513 : 0x7fffffff));
                    if (wq_hi - k0 < t1) { bmode = 1; bv0 = b32[b0]; } else { bmode = 2; bv0 = lane_ok ? b32[b0] : -INFINITY; bv1 = lane_ok ? b32[b0 < 31 ? b0 + 1 : 31] : -INFINITY; }
                } else { bmode = 3; tb = lane_ok ? bt + (BT - 1 - d0) : (const LAS float*)(base + L_NINF); }
            }
            f32x16 st[2];
            bf16x8 kf[2][4];
#pragma unroll
            for (int kb = 0; kb < 2; ++kb)
#pragma unroll
                for (int s = 0; s < 4; ++s) kf[kb][s] = *(const LAS bf16x8*)(Kt + (kb * 32 + r) * KP + (2 * s + h) * 16);
            u32x4 qxv; qxv.x = __float_as_uint(mr) >> 16; qxv.y = 0u; qxv.z = 0u; qxv.w = 0u;
            if (bmode == 1) {
                const unsigned b_hi = __float_as_uint(bv0) & 0xffff0000u; const float r1 = bv0 - __uint_as_float(b_hi);
                const unsigned b_mid = __float_as_uint(r1) & 0xffff0000u; const float r2 = r1 - __uint_as_float(b_mid);
                qxv.x |= lane_ok ? b_hi : 0xFF800000u; qxv.y = lane_ok ? ((b_mid >> 16) | (__float_as_uint(r2) & 0xffff0000u)) : 0u;
            }
            if (h) { qxv.x = 0u; qxv.y = 0u; }
            const bool useref = refnz || bmode == 1;
#pragma unroll
            for (int kb = 0; kb < 2; ++kb) {
                if (bmode == 3) {
#pragma unroll
                    for (int i = 0; i < 16; ++i) st[kb][i] = tb[32 * kb + (i & 3) + 8 * (i >> 2)];
                } else if (bmode == 2) {
#pragma unroll
                    for (int i = 0; i < 16; ++i) { const int d = d0 - (32 * kb + (i & 3) + 8 * (i >> 2)); st[kb][i] = (d >= t1) ? bv1 : bv0; }
                } else {
#pragma unroll
                    for (int i = 0; i < 16; ++i) st[kb][i] = 0.f;
                }
            }
            __builtin_amdgcn_s_setprio(1);
#pragma unroll
            for (int kb = 0; kb < 2; ++kb)
#pragma unroll
                for (int s = 0; s < 4; ++s) st[kb] = FA_MFMA(kf[kb][s], qf[s], st[kb]);
            if (useref) {
                const bf16x8 qx = __builtin_bit_cast(bf16x8, qxv);
                st[0] = FA_MFMA(kx, qx, st[0]); st[1] = FA_MFMA(kx, qx, st[1]);
            }
            __builtin_amdgcn_s_setprio(0);
            const int i16 = lane & 15, q = i16 >> 2, pp = i16 & 3, g16 = (lane >> 4) & 1;
            const LAS char* vbase = Vt + (4 * h + q) * KP + g16 * 32 + 8 * pp;
#pragma unroll
            for (int kb = 0; kb < 2; ++kb) {
                if (!full || (MASKED && !BIAS)) {
#pragma unroll
                    for (int i = 0; i < 16; ++i) {
                        const int d = d0 - (32 * kb + (i & 3) + 8 * (i >> 2));
                        bool ok = (MASKED && !BIAS) ? lane_ok : true;
                        if (!full) { if constexpr (BAND) ok = ok && ((unsigned)d <= (unsigned)ps.W); else ok = ok && (d >= 0); }
                        st[kb][i] = ok ? st[kb][i] : -INFINITY;
                    }
                }
                float ls = 0.f;
#pragma unroll
                for (int i = 0; i < 16; ++i) { const float pe = touch(__builtin_amdgcn_exp2f(st[kb][i])); st[kb][i] = pe; ls = touch(ls + pe); }
                l += ls;
                if constexpr (!IMP) ovf = fmaxf(ovf, ls);
                if constexpr (IMP) {
                    LAS float* impA = (LAS float*)(base + L_IMPA) + qloc * 64; LAS float* impB = (LAS float*)(base + L_IMPB) + qloc * 64;
#pragma unroll
                    for (int c4 = 0; c4 < 4; ++c4) {
                        const float s4 = quad_sum((st[kb][4 * c4] + st[kb][4 * c4 + 1]) + (st[kb][4 * c4 + 2] + st[kb][4 * c4 + 3]));
                        const float sp = quad_sum(st[kb][4 * c4 + 3]);
                        const int j = 16 * jt + 8 * kb + 2 * c4 + h;
                        if ((lane & 3) == 0) { impA[j] = s4 * pscale; if (j + 1 < 64) impB[j + 1] = sp * pscale; }
                    }
                }
                if constexpr (!STATS) {
#pragma unroll
                    for (int s = 0; s < 2; ++s) {
                        uint4 pk; pk.x = cvtpk(st[kb][8 * s], st[kb][8 * s + 1]); pk.y = cvtpk(st[kb][8 * s + 2], st[kb][8 * s + 3]);
                        pk.z = cvtpk(st[kb][8 * s + 4], st[kb][8 * s + 5]); pk.w = cvtpk(st[kb][8 * s + 6], st[kb][8 * s + 7]);
                        const bf16x8 pf = __builtin_bit_cast(bf16x8, pk);
#pragma unroll
                        for (int dh = 0; dh < 2; ++dh) {
                            const LAS char* va = vbase + (kb * 32 + 16 * s) * KP + dh * 64;
                            const s16x4 lo = vtr(va), hi = vtr(va + 8 * KP);
                            const bf16x8 vf = __builtin_shufflevector(lo, hi, 0, 1, 2, 3, 4, 5, 6, 7);
                            o[dh] = FA_MFMA(vf, pf, o[dh]);
                        }
                    }
                }
            }
            if constexpr (!IMP) { if (__builtin_amdgcn_ballot_w64(ovf > 0x1p40f) != 0ull) resc = true; }
        }
        if (it + 2 < n) stage_store(base, (it + 2) & (NBUF - 1), tid, kreg, vreg);
        if ((it & 1) || it + 1 == n) __syncthreads();
    }
    m = mr;
}
DI void load_q(const bf16_t* qrow, int h, bf16x8 (&qf)[4]) {
#pragma unroll
    for (int s = 0; s < 4; ++s) qf[s] = __builtin_bit_cast(bf16x8, *(const uint4*)(qrow + 16 * s + 8 * h));
}
DI void store_o(bf16_t* orow, int h, const f32x16 (&o)[2], float inv) {
#pragma unroll
    for (int dh = 0; dh < 2; ++dh)
#pragma unroll
        for (int c4 = 0; c4 < 4; ++c4) {
            uint2 pk; pk.x = cvtpk(o[dh][4 * c4] * inv, o[dh][4 * c4 + 1] * inv); pk.y = cvtpk(o[dh][4 * c4 + 2] * inv, o[dh][4 * c4 + 3] * inv);
            *(uint2*)(orow + dh * 32 + 8 * c4 + 4 * h) = pk;
        }
}
DI void build_bias(LAS char* base, const float* relb, int col0, int ng, int dscale) {
    const int tid = tidx();
    LAS float* bt = (LAS float*)(base + L_BT); LAS float* b32 = (LAS float*)(base + L_B32);
    if (tid < ng * 32) { const int g = tid >> 5, bk = tid & 31; b32[tid] = ((const LAS float*)(base + L_RELB))[bk * 32 + col0 + g]; }
    if (tid < 64) ((LAS float*)(base + L_NINF))[tid] = -INFINITY;
    __syncthreads();
    for (int e = tid; e < ng * TBL; e += NTHR) { const int g = e / TBL, j = e % TBL, d = BT - 1 - j; bt[e] = d >= 0 ? b32[g * 32 + t5_bucket(d * dscale)] : 0.f; }
    __syncthreads();
}

DI void item_band(const P& p, LAS char* base, const bf16_t* qb_, int qtok_stride, int q0, const Pass& ps, const float* relb, int col, int dscale,
                  bool has_sink, float sink, bf16_t* ob, float* lse_out  , int lse_stride) {
    const int tid = tidx(), lane = tid & 63, w = __builtin_amdgcn_readfirstlane(tid >> 6), r = lane & 31, h = lane >> 5;
    Pre pre; flash_preload(ps, pre);
    const int qidx = q0 + w * 32 + r;
    bf16x8 qf[4]; load_q(qb_ + (size_t)qidx * qtok_stride * LDP, h, qf);
    build_bias(base, relb, col, 1, dscale);
    f32x16 o[2];
#pragma unroll
    for (int i = 0; i < 16; ++i) { o[0][i] = 0.f; o[1][i] = 0.f; }
    float m = has_sink ? sink * LOG2E : -1e30f, l = (has_sink && h == 0) ? 1.f : 0.f;
    flash_pass<1 | 4>(base, ps, qf, qidx, 0, 0ull, q0 + w * 32, q0 + w * 32 + 31, o, m, l, 1.f, 0, &pre);
    l += xhalf(l);
    const float lt = fmaxf(l, 1.17549435e-38f);
    store_o(ob + (size_t)qidx * qtok_stride * 512, h, o, 1.f / lt);
    if (lse_out && h == 0) lse_out[(size_t)qidx * qtok_stride * lse_stride] = (m + __builtin_amdgcn_logf(lt)) * LN2;
}
DI void item_moba(const P& p, LAS char* base, int b, int hd, int qb) {
    const int tid = tidx(), lane = tid & 63, w = __builtin_amdgcn_readfirstlane(tid >> 6), r = lane & 31, h = lane >> 5;
    const Pass ps{p.proj + (size_t)b * S * LDP + OFF_KC + hd * 64, p.proj + (size_t)b * S * LDP + OFF_VC + hd * 64, LDP, 1, S, 0, 4 * (qb + 1), 0, 2};
    Pre pre; flash_preload(ps, pre);
    const int qidx = qb * 256 + w * 32 + r;
    const size_t row = (size_t)b * S + qidx;
    bf16x8 qf[4]; load_q(p.proj + row * LDP + OFF_QC + hd * 64, h, qf);
    build_bias(base, p.in[2], 16 + hd, 1, 1);
    f32x16 ga;
#pragma unroll
    for (int i = 0; i < 16; ++i) ga[i] = 0.f;
    const float* km = p.kmean + (((size_t)b * 8 + hd) * 16 + (r & 15)) * 64;
#pragma unroll
    for (int s = 0; s < 4; ++s) {
        const float4 a = *(const float4*)(km + 16 * s + 8 * h), c = *(const float4*)(km + 16 * s + 8 * h + 4);
        const float f[8] = {a.x, a.y, a.z, a.w, c.x, c.y, c.z, c.w};
        unsigned hi[4], lo[4];
#pragma unroll
        for (int j = 0; j < 4; ++j) {
            const float x0 = r < 16 ? f[2 * j] : 0.f, x1 = r < 16 ? f[2 * j + 1] : 0.f;
            const unsigned ph = cvtpk(x0, x1); hi[j] = ph;
            lo[j] = cvtpk(x0 - __uint_as_float(ph << 16), x1 - __uint_as_float(ph & 0xffff0000u));
        }
        uint4 uh; uh.x = hi[0]; uh.y = hi[1]; uh.z = hi[2]; uh.w = hi[3];
        uint4 ul; ul.x = lo[0]; ul.y = lo[1]; ul.z = lo[2]; ul.w = lo[3];
        ga = FA_MFMA(__builtin_bit_cast(bf16x8, uh), qf[s], ga);
        ga = FA_MFMA(__builtin_bit_cast(bf16x8, ul), qf[s], ga);
    }
    float gv[16];
#pragma unroll
    for (int i = 0; i < 8; ++i) {
        const float mine = ga[i], other = xhalf(mine);
        const int c = i >> 2, e = i & 3;
        gv[8 * c + e] = h ? other : mine; gv[8 * c + 4 + e] = h ? mine : other;
    }
    unsigned msk = 1u << qb;
#pragma unroll
    for (int k = 0; k < 3; ++k) {
        float best = -INFINITY; int bi = -1;
#pragma unroll
        for (int nn = 0; nn < 16; ++nn) if (nn < qb && gv[nn] > best) { best = gv[nn]; bi = nn; }
#pragma unroll
        for (int nn = 0; nn < 16; ++nn) if (nn == bi) gv[nn] = -INFINITY;
        if (bi >= 0) msk |= 1u << bi;
    }
    f32x16 o[2];
#pragma unroll
    for (int i = 0; i < 16; ++i) { o[0][i] = 0.f; o[1][i] = 0.f; }
    float m = -1e30f, l = 0.f;
    flash_pass<2 | 4>(base, ps, qf, qidx, 0, (unsigned long long)msk, qb * 256 + w * 32, qb * 256 + w * 32 + 31, o, m, l, 1.f, 0, &pre);
    l += xhalf(l);
    store_o(p.oC + row * 512 + hd * 64, h, o, 1.f / fmaxf(l, 1.17549435e-38f));
}
DI void item_nsa(const P& p, LAS char* base, int b, int hk, int c) {
    const int tid = tidx(), lane = tid & 63, w = __builtin_amdgcn_readfirstlane(tid >> 6), r = lane & 31, h = lane >> 5, qq = r >> 2, g = r & 3;
    const int qloc = 8 * w + qq, qpos = c * 64 + qloc, hq = hk * 4 + g;
    const size_t row = (size_t)b * S + qpos;
    int thi = ((c * 64 + 63 - 31) >> 4) / 64 + 1; thi = thi > 4 ? 4 : thi;
    const Pass psc{p.kc + ((size_t)b * 2 + hk) * 256 * 64, p.vc + ((size_t)b * 2 + hk) * 256 * 64, 64, 1, 255, 0, thi, 0, 0};
    Pre pre; flash_preload(psc, pre);
    { LAS float* z = (LAS float*)(base + L_IMPA); for (int e = tid; e < 2 * 64 * 64; e += NTHR) z[e] = 0.f; }
    bf16x8 qf[4]; load_q(p.proj + row * LDP + OFF_QD + hq * 64, h, qf);
    const bf16_t* gd = p.proj + row * LDP + OFF_GD + hq * 3;
    const unsigned gpk01 = (unsigned)gd[0] | ((unsigned)gd[1] << 16), gpk2 = (unsigned)gd[2];
    build_bias(base, p.in[2], 24 + hk * 4, 4, 1);
    LAS unsigned* oacc = (LAS unsigned*)(base + L_OACC) + tid;
    f32x16 o[2];
    const int wq_lo = c * 64 + 8 * w, wq_hi = wq_lo + 7;
    {
        int nmax = (qpos - 31) >> 4; nmax = nmax > 254 ? 254 : nmax;
        const int wn_lo = (wq_lo - 31) >> 4, wn_hi = (wq_hi - 31) >> 4;
        const Pass& ps = psc;
        float m = -1e30f, l = 0.f;
        flash_pass<8>(base, ps, qf, nmax, 0, 0ull, wn_lo, wn_hi, o, m, l, 1.f, qloc, &pre);
        l += xhalf(l);
        const float inv = 1.f / fmaxf(l, 1.17549435e-38f);
#pragma unroll
        for (int i = 0; i < 16; ++i) { o[0][i] = 0.f; o[1][i] = 0.f; }
        float l2 = 0.f;
        flash_pass<16>(base, ps, qf, nmax, 0, 0ull, wn_lo, wn_hi, o, m, l2, inv, qloc);
        const float sc = sigmoidf_(__uint_as_float(gpk01 << 16)) * inv;
#pragma unroll
        for (int i = 0; i < 16; ++i) { o[0][i] *= sc; o[1][i] *= sc; }
    }
    const Pass pss{p.proj + (size_t)b * S * LDP + OFF_KDS + hk * 64, p.proj + (size_t)b * S * LDP + OFF_VDS + hk * 64, LDP, 1, S, 0, c + 1, 0, 0};
    Pre pre2; flash_preload(pss, pre2);
    {
        const LAS float* impA = (const LAS float*)(base + L_IMPA); const LAS float* impB = (const LAS float*)(base + L_IMPB);
        LAS unsigned long long* sel = (LAS unsigned long long*)(base + L_SEL);
        for (int k = 0; k < 8; ++k) {
            const int ql = 8 * w + k, j = lane;
            const float val = (j == 0 || j == c || j == c - 1) ? 1e30f : (j <= c ? impA[ql * 64 + j] + impB[ql * 64 + j] : -1e30f);
            int rank = 0;
#pragma unroll 8
            for (int jj = 0; jj < 64; ++jj) { const float ov = __builtin_bit_cast(float, __builtin_amdgcn_readlane(__builtin_bit_cast(int, val), jj)); rank += (ov > val || (ov == val && jj < j)) ? 1 : 0; }
            const unsigned long long mk = __builtin_amdgcn_ballot_w64(rank < 16 && val > -1e29f);
            if (lane == 0) sel[ql] = mk;
        }
        __syncthreads();
    }
#pragma unroll
    for (int dh = 0; dh < 2; ++dh)
#pragma unroll
        for (int i = 0; i < 8; ++i) oacc[(dh * 8 + i) * 512] = cvtpk(o[dh][2 * i], o[dh][2 * i + 1]);
    const unsigned long long selmask = ((const LAS unsigned long long*)(base + L_SEL))[qloc];
    {
        const Pass& ps = pss;
#pragma unroll
        for (int i = 0; i < 16; ++i) { o[0][i] = 0.f; o[1][i] = 0.f; }
        float m = -1e30f, l = 0.f;
        flash_pass<2 | 4>(base, ps, qf, qpos, g, selmask, wq_lo, wq_hi, o, m, l, 1.f, qloc, &pre2);
        l += xhalf(l);
        const float sc = sigmoidf_(__uint_as_float(gpk01 & 0xffff0000u)) / fmaxf(l, 1.17549435e-38f);
#pragma unroll
        for (int dh = 0; dh < 2; ++dh)
#pragma unroll
            for (int i = 0; i < 8; ++i) { const unsigned pv = oacc[(dh * 8 + i) * 512];
                oacc[(dh * 8 + i) * 512] = cvtpk(__uint_as_float(pv << 16) + o[dh][2 * i] * sc, __uint_as_float(pv & 0xffff0000u) + o[dh][2 * i + 1] * sc); }
    }
    {
        Pass ps{p.proj + (size_t)b * S * LDP + OFF_KDW + hk * 64, p.proj + (size_t)b * S * LDP + OFF_VDW + hk * 64, LDP, 1, S, (c - 8 > 0 ? c - 8 : 0), c + 1, 511, 0};
#pragma unroll
        for (int i = 0; i < 16; ++i) { o[0][i] = 0.f; o[1][i] = 0.f; }
        float m = -1e30f, l = 0.f;
        flash_pass<1 | 4>(base, ps, qf, qpos, g, 0ull, wq_lo, wq_hi, o, m, l, 1.f, qloc);
        l += xhalf(l);
        const float sc = sigmoidf_(__uint_as_float(gpk2 << 16)) / fmaxf(l, 1.17549435e-38f);
        bf16_t* orow = p.oD + row * 512 + hq * 64;
#pragma unroll
        for (int dh = 0; dh < 2; ++dh)
#pragma unroll
            for (int c4 = 0; c4 < 4; ++c4) {
                uint2 pk; const unsigned p0 = oacc[(dh * 8 + 2 * c4) * 512], p1 = oacc[(dh * 8 + 2 * c4 + 1) * 512];
                pk.x = cvtpk(__uint_as_float(p0 << 16) + o[dh][4 * c4] * sc, __uint_as_float(p0 & 0xffff0000u) + o[dh][4 * c4 + 1] * sc);
                pk.y = cvtpk(__uint_as_float(p1 << 16) + o[dh][4 * c4 + 2] * sc, __uint_as_float(p1 & 0xffff0000u) + o[dh][4 * c4 + 3] * sc);
                *(uint2*)(orow + dh * 32 + 8 * c4 + 4 * h) = pk;
            }
    }
}
constexpr int N_QITEMS = 384;
DI void run_item(const P& p, int l, LAS char* base, int x, int t) {
    if (t < 128) {
        const int k = t >> 1;
        if ((t & 1) == 0) item_nsa(p, base, x >> 1, x & 1, 63 - k);
        else { const int bh = 4 * x + (k & 3); item_moba(p, base, bh >> 3, bh & 7, 15 - (k >> 2)); }
    } else if (t < 192) {
        const int i = t - 128, qb = i & 15, b = x >> 1, kvh = x & 1, hq = kvh * 4 + (i >> 4);
        const bf16_t* bb = p.proj + (size_t)b * S * LDP;
        Pass ps{bb + OFF_KB + kvh * 64, bb + OFF_VB + kvh * 64, LDP, 1, S, (4 * qb - 2 > 0 ? 4 * qb - 2 : 0), 4 * qb + 4, 127, 0};
        item_band(p, base, bb + OFF_QB + hq * 64, 1, qb * 256, ps, p.in[2], 8 + hq, 1, true, p.in[16][l * 8 + hq], p.oB + (size_t)b * S * 512 + hq * 64, nullptr, 0);
    } else {
        const int i = t - 192, bh = 4 * x + (i / 48), j = i % 48, cfg = j >> 4, sub = j & 15, hd = bh & 7, b = bh >> 3;
        const int rr = cfg == 0 ? 1 : (cfg == 1 ? 4 : 16), nblk = 16 / rr;
        const int res = sub / nblk, blk = sub % nblk;
        const bf16_t* bb = p.proj + ((size_t)b * S + res) * LDP;
        Pass ps{bb + OFF_KA + hd * 64, bb + OFF_VA + hd * 64, LDP, rr, S / rr, (4 * blk - 2 > 0 ? 4 * blk - 2 : 0), 4 * blk + 4, 128, 0};
        item_band(p, base, bb + OFF_QA + hd * 64, rr, blk * 256, ps, p.in[2], hd, rr, false, 0.f,
                  p.oA + ((size_t)cfg * T + (size_t)b * S + res) * 512 + hd * 64, p.lseA + ((size_t)cfg * T + (size_t)b * S + res) * 8 + hd, 8);
    }
}
DI void phase_attention(const P& p, int l, float* lds) {
    LAS char* base = (LAS char*)lds;
    LAS int* tk = (LAS int*)(base + L_TICKET);
    const int x0 = (int)(xb_xcc_id() & 7u);
    for (int e = tidx(); e < 1024; e += NTHR) ((LAS float*)(base + L_RELB))[e] = p.in[2][e] * LOG2E;
    for (int step = 0; step < 8; ++step) {
        const int x = (x0 + step) & 7;
        unsigned* ctr = p.ctl + CTL_Q + (l * 8 + x) * 64;
        if (tidx() == 0) *tk = (int)atomicAdd(ctr, 1u);
        __syncthreads();
        int t = __builtin_amdgcn_readfirstlane(*tk);
        __syncthreads();
        while (t < N_QITEMS) {
            int nxt = 0;
            if (tidx() == 0) nxt = (int)atomicAdd(ctr, 1u);
            run_item(p, l, base, x, t);
            if (tidx() == 0) *tk = nxt;
            __syncthreads();
            t = __builtin_amdgcn_readfirstlane(*tk);
            __syncthreads();
        }
    }
}
}

namespace pg8 {
#define PG8_LAS __attribute__((address_space(3)))
typedef short bf16x8 __attribute__((ext_vector_type(8)));
typedef float f32x4 __attribute__((ext_vector_type(4)));
typedef unsigned u32x4 __attribute__((ext_vector_type(4)));
constexpr int BM = 256, BK = 64, HALF = 128, HTB = HALF * BK * 2  , STAGE_BYTES = 8 * HTB, NXCD = 8, WGM = 8;

__device__ __forceinline__ int lds_byte(int r, int c) { const int st = (r >> 4) * 2 + (c >> 5), rr = r & 15, cc = c & 31, ob = rr * 64 + cc * 2; return st * 1024 + (ob ^ (((ob >> 9) & 1) << 5)); }
__device__ __forceinline__ void stage_rc(int b, int& R, int& C) { const int st = b / 1024, sb = b % 1024, swz = sb ^ (((sb >> 9) & 1) << 5); R = (st >> 1) * 16 + swz / 64; C = (st & 1) * 32 + (swz % 64) / 2; }
__device__ __forceinline__ int perm32(int rho) { const int n = rho >> 4, i = rho & 15; return 8 * (i >> 2) + 4 * n + (i & 3); }

struct Unit { int pm, pn; const char* A; const char* Ba; const char* Bb; int aux0, aux1, aux2; };
struct Shape { int K, lda, ldb, ksplit; };

__device__ __forceinline__ unsigned cvt_pk_bf16(float lo, float hi) { unsigned r; asm volatile("v_cvt_pk_bf16_f32 %0, %1, %2" : "=v"(r) : "v"(lo), "v"(hi)); return r; }

template <class Epi, class Sched, bool GATHER, bool HALFSKIP = false, bool ALIGN_EPI = true>
__device__ __forceinline__ void gemm_phase(PG8_LAS unsigned char* lds, const Shape g, const Sched& S, const Epi& E) {
    const int tid = tidx(), wid = __builtin_amdgcn_readfirstlane(tid >> 6), lane = tid & 63, wr = wid >> 2, wc = wid & 3, fr = lane & 15, fq = lane >> 4;
    const int nt = g.K / BK;
    unsigned voffA[2], voffA1[2], voffB[2];
#pragma unroll
    for (int i = 0; i < 2; ++i) { int R, C; stage_rc(tid * 16 + i * 8192, R, C); const int Rb = Epi::PERM ? ((R & ~31) + perm32(R & 31)) : R;
        voffA[i] = (unsigned)(R * g.lda + C) * 2u; voffA1[i] = voffA[i]; voffB[i] = (unsigned)(Rb * g.ldb + C) * 2u; }
    const size_t kstep = (size_t)(BK * 2);
    const size_t hstepA = GATHER ? 0 : (size_t)HALF * g.lda * 2;
    const size_t hstepB = (size_t)HALF * g.ldb * 2;
    const unsigned ldsw = (unsigned)wid * 1024u;
    const int aoff = lds_byte(wr * 64 + fr, fq * 8), boff = lds_byte(wc * 32 + fr, fq * 8);
#define PG8_SA(b, h) (((b) * 2 + (h)) * HTB)
#define PG8_SB(b, h) ((4 + (b) * 2 + (h)) * HTB)
#define PG8_STAGE(bufoff, gbase, voff) do { _Pragma("unroll") for (int _i = 0; _i < 2; ++_i) \
        __builtin_amdgcn_global_load_lds((const unsigned*)((const char*)(gbase) + (voff)[_i]), (PG8_LAS unsigned*)(lds + (bufoff) + ldsw + _i * 8192), 16, 0, 0); } while (0)
#define PG8_STAGE_A0(bufoff, gbase) PG8_STAGE(bufoff, gbase, voffA)
#define PG8_STAGE_A1(bufoff, gbase) do { if constexpr (GATHER) PG8_STAGE(bufoff, gbase, voffA1); else PG8_STAGE(bufoff, (gbase) + hstepA, voffA); } while (0)
#define PG8_LDA(dst, b, h) do { _Pragma("unroll") for (int m = 0; m < 4; ++m) _Pragma("unroll") for (int k = 0; k < 2; ++k) dst[m][k] = *(const PG8_LAS bf16x8*)(lds + PG8_SA(b, h) + aoff + m * 2048 + k * 1024); } while (0)
#define PG8_LDB(dst, b, h) do { _Pragma("unroll") for (int n = 0; n < 2; ++n) _Pragma("unroll") for (int k = 0; k < 2; ++k) dst[n][k] = *(const PG8_LAS bf16x8*)(lds + PG8_SB(b, h) + boff + n * 2048 + k * 1024); } while (0)
#define PG8_MMA(ai, bj, At, Bt) do { __builtin_amdgcn_s_setprio(1); _Pragma("unroll") for (int m = 0; m < 4; ++m) _Pragma("unroll") for (int n = 0; n < 2; ++n) _Pragma("unroll") for (int k = 0; k < 2; ++k) \
        acc[ai][bj][m][n] = __builtin_amdgcn_mfma_f32_16x16x32_bf16(Bt[n][k], At[m][k], acc[ai][bj][m][n], 0, 0, 0); __builtin_amdgcn_s_setprio(0); } while (0)
#define PG8_WAIT_V(n) asm volatile("s_waitcnt vmcnt(" #n ")" ::: "memory")
#define PG8_WAIT_L(n) asm volatile("s_waitcnt lgkmcnt(" #n ")" ::: "memory")
#define PG8_BAR __builtin_amdgcn_s_barrier()
#define PG8_SCHED __builtin_amdgcn_sched_barrier(0)
#define PG8_BK(u, t) (((t) < g.ksplit ? (u).Ba : (u).Bb) + (size_t)(t) * kstep)
    Unit cur, nxt; int ui = 0;
    if (!S.next(0, cur)) return;
    f32x4 acc[2][2][4][2];
#pragma unroll
    for (int a = 0; a < 2; ++a)
#pragma unroll
        for (int b = 0; b < 2; ++b)
#pragma unroll
            for (int m = 0; m < 4; ++m)
#pragma unroll
                for (int n = 0; n < 2; ++n) acc[a][b][m][n] = (f32x4){0.f, 0.f, 0.f, 0.f};
    bf16x8 At[4][2], B0[2][2], B1[2][2];
    const char* cA = cur.A; const char* cB = cur.Ba;
    if constexpr (GATHER) {
#pragma unroll
        for (int i = 0; i < 2; ++i) { int R, C; stage_rc(tidx() * 16 + i * 8192, R, C); voffA[i] = (unsigned)(S.gather_row(cur, R) * g.lda + C) * 2u; voffA1[i] = (unsigned)(S.gather_row(cur, R + HALF) * g.lda + C) * 2u; }
    }
    PG8_STAGE(PG8_SB(0, 0), cB, voffB); PG8_STAGE(PG8_SB(0, 1), cB + hstepB, voffB); PG8_STAGE_A0(PG8_SA(0, 0), cA); PG8_STAGE_A1(PG8_SA(0, 1), cA);
    if (wr == 1) PG8_BAR;
    PG8_WAIT_V(2); PG8_BAR;
    PG8_STAGE(PG8_SB(1, 0), cB + kstep, voffB); PG8_STAGE_A0(PG8_SA(1, 0), cA + kstep); PG8_STAGE(PG8_SB(1, 1), cB + hstepB + kstep, voffB);
    PG8_WAIT_V(6); PG8_BAR;
    for (;;) {
        const bool has_next = S.next(ui + 1, nxt);
        const char* nA = has_next ? nxt.A : cA; const char* nB = has_next ? nxt.Ba : cB;
        const bool skip1 = HALFSKIP && (cur.aux2 - cur.aux1 <= HALF);
        for (int t = 0; t < nt; t += 2) {
            const bool last = (t == nt - 2);
            const char* a1 = cA + (size_t)(t + 1) * kstep;
            const char* a2 = last ? nA : cA + (size_t)(t + 2) * kstep; const char* b2 = last ? nB : PG8_BK(cur, t + 2);
            const char* a3 = a2 + kstep; const char* b3 = b2 + kstep;
            PG8_LDB(B0, 0, 0); PG8_LDB(B1, 0, 1); PG8_SCHED; PG8_LDA(At, 0, 0); PG8_STAGE_A1(PG8_SA(1, 1), a1);
            if constexpr (GATHER) { if (last && has_next) {
#pragma unroll
                for (int i = 0; i < 2; ++i) { int R, C; stage_rc(tidx() * 16 + i * 8192, R, C); voffA[i] = (unsigned)(S.gather_row(nxt, R) * g.lda + C) * 2u; voffA1[i] = (unsigned)(S.gather_row(nxt, R + HALF) * g.lda + C) * 2u; } } }
            PG8_WAIT_V(8); PG8_WAIT_L(0); PG8_BAR; PG8_MMA(0, 0, At, B0); PG8_MMA(0, 1, At, B1); PG8_BAR; PG8_SCHED;
            if (!skip1) PG8_LDA(At, 0, 1); PG8_STAGE(PG8_SB(0, 0), b2, voffB); PG8_STAGE(PG8_SB(0, 1), b2 + hstepB, voffB); PG8_STAGE_A0(PG8_SA(0, 0), a2);
            PG8_WAIT_V(8); PG8_WAIT_L(0); PG8_BAR; if (!skip1) { PG8_MMA(1, 0, At, B0); PG8_MMA(1, 1, At, B1); } PG8_BAR; PG8_SCHED;
            PG8_LDB(B0, 1, 0); PG8_LDB(B1, 1, 1); PG8_SCHED; PG8_LDA(At, 1, 0); PG8_STAGE_A1(PG8_SA(0, 1), a2);
            PG8_WAIT_V(8); PG8_WAIT_L(0); PG8_BAR; PG8_MMA(0, 0, At, B0); PG8_MMA(0, 1, At, B1); PG8_BAR; PG8_SCHED;
            if (!skip1) PG8_LDA(At, 1, 1); PG8_STAGE(PG8_SB(1, 0), b3, voffB); PG8_STAGE(PG8_SB(1, 1), b3 + hstepB, voffB); PG8_STAGE_A0(PG8_SA(1, 0), a3);
            PG8_WAIT_V(8); PG8_WAIT_L(0); PG8_BAR; if (!skip1) { PG8_MMA(1, 0, At, B0); PG8_MMA(1, 1, At, B1); } PG8_BAR; PG8_SCHED;
        }
        if constexpr (ALIGN_EPI) { if (wr == 0) PG8_BAR; }
        { int fr_ = fr, fq_ = fq; asm volatile("" : "+v"(fr_), "+v"(fq_));
          E(acc, cur, wr, wc, fr_, fq_); }
        if (!has_next) break;
#pragma unroll
        for (int a = 0; a < 2; ++a)
#pragma unroll
            for (int b = 0; b < 2; ++b)
#pragma unroll
                for (int m = 0; m < 4; ++m)
#pragma unroll
                    for (int n = 0; n < 2; ++n) acc[a][b][m][n] = (f32x4){0.f, 0.f, 0.f, 0.f};
        cur = nxt; cA = nA; cB = nB; ++ui;
        if constexpr (ALIGN_EPI) { if (wr == 1) PG8_BAR; }
    }
    PG8_WAIT_V(0);
    if constexpr (!ALIGN_EPI) { if (wr == 0) PG8_BAR; }
    PG8_BAR;
#undef PG8_SA
#undef PG8_SB
#undef PG8_STAGE
#undef PG8_STAGE_A0
#undef PG8_STAGE_A1
#undef PG8_LDA
#undef PG8_LDB
#undef PG8_MMA
#undef PG8_WAIT_V
#undef PG8_WAIT_L
#undef PG8_BAR
#undef PG8_SCHED
#undef PG8_BK
}

struct GridOrder {
    int nM, nN, nwg, G, c;
    __device__ __forceinline__ void init(int M, int N, int G_, int c_) { nM = M / BM; nN = N / BM; nwg = nM * nN; G = G_; c = c_; }
    __device__ __forceinline__ bool flat(int i, int& pm, int& pn) const {
        const long L = (long)i * G + c; if (L >= nwg) return false;
        int wgid = (int)L; { const int q = nwg / NXCD, r = nwg % NXCD, xcd = wgid % NXCD, off = wgid / NXCD; wgid = (xcd < r ? xcd * (q + 1) : r * (q + 1) + (xcd - r) * q) + off; }
        const int nig = WGM * nN, gid = wgid / nig, fm = gid * WGM, gsz = (nM - fm) < WGM ? (nM - fm) : WGM;
        pm = fm + ((wgid % nig) % gsz); pn = (wgid % nig) / gsz; return true;
    }
};
}

struct DenseSched {
    pg8::GridOrder go; const char* A; const char* Bt; size_t a_tile, b_tile;
    DI bool next(int i, pg8::Unit& u) const { int pm, pn; if (!go.flat(i, pm, pn)) return false; u.pm = pm; u.pn = pn; u.A = A + (size_t)pm * a_tile; u.Ba = Bt + (size_t)pn * b_tile; u.Bb = u.Ba; u.aux0 = u.aux1 = u.aux2 = 0; return true; }
    DI int gather_row(const pg8::Unit&, int r) const { return r; }
};
struct EpiProj {
    static constexpr bool PERM = true;
    bf16_t* O;
    DI void operator()(const pg8::f32x4 (&acc)[2][2][4][2], const pg8::Unit& u, int wr, int wc, int fr, int fq) const {
        const int row0 = u.pm * 256 + wr * 64 + fr, col0 = u.pn * 256 + wc * 32 + 8 * fq;
#pragma unroll
        for (int ai = 0; ai < 2; ++ai)
#pragma unroll
            for (int m = 0; m < 4; ++m) { bf16_t* rowp = O + (size_t)(row0 + ai * 128 + m * 16) * LDP + col0;
#pragma unroll
                for (int bj = 0; bj < 2; ++bj) {
                    const int c128 = u.pn * 2 + bj;
                    const float sc = (c128 < 4 || (c128 >= 12 && c128 < 16) || (c128 >= 18 && c128 < 22) || (c128 >= 30 && c128 < 34)) ? fa::SC2 : 1.f;
                    const pg8::f32x4 v0 = acc[ai][bj][m][0] * sc, v1 = acc[ai][bj][m][1] * sc;
                    pg8::u32x4 w; w.x = pg8::cvt_pk_bf16(v0[0], v0[1]); w.y = pg8::cvt_pk_bf16(v0[2], v0[3]); w.z = pg8::cvt_pk_bf16(v1[0], v1[1]); w.w = pg8::cvt_pk_bf16(v1[2], v1[3]);
                    *(pg8::u32x4*)(rowp + bj * 128) = w; } }
    }
};
struct EpiResid {
    static constexpr bool PERM = true;
    const float* xs; float* xd; const float* gate;
    DI void operator()(const pg8::f32x4 (&acc)[2][2][4][2], const pg8::Unit& u, int wr, int wc, int fr, int fq) const {
        const int row0 = u.pm * 256 + wr * 64 + fr, col0 = u.pn * 256 + wc * 32 + 8 * fq;
        const float* gp = gate + (size_t)((u.pm * 256) / S) * 12288 + col0;
        pg8::f32x4 gv[2][2];
#pragma unroll
        for (int bj = 0; bj < 2; ++bj)
#pragma unroll
            for (int n = 0; n < 2; ++n) gv[bj][n] = *(const pg8::f32x4*)(gp + bj * 128 + 4 * n);
        pg8::f32x4 xv[2][2][2];
#define RES_LOAD(k, sl) do { const size_t ro_ = (size_t)(row0 + ((k) >> 2) * 128 + ((k) & 3) * 16) * D + col0; \
        xv[sl][0][0] = *(const pg8::f32x4*)(xs + ro_); xv[sl][0][1] = *(const pg8::f32x4*)(xs + ro_ + 4); xv[sl][1][0] = *(const pg8::f32x4*)(xs + ro_ + 128); xv[sl][1][1] = *(const pg8::f32x4*)(xs + ro_ + 132); } while (0)
        RES_LOAD(0, 0);
#pragma unroll
        for (int k = 0; k < 8; ++k) {
            if (k + 1 < 8) RES_LOAD(k + 1, (k + 1) & 1);
            const int ai = k >> 2, m = k & 3; const size_t ro = (size_t)(row0 + ai * 128 + m * 16) * D + col0;
#pragma unroll
            for (int bj = 0; bj < 2; ++bj)
#pragma unroll
                for (int n = 0; n < 2; ++n) *(pg8::f32x4*)(xd + ro + bj * 128 + 4 * n) = xv[k & 1][bj][n] + gv[bj][n] * acc[ai][bj][m][n];
        }
#undef RES_LOAD
    }
};

constexpr int LDS_MOE_TAB = 132096 / 4;
DI void moe_build_table(const P& p, int l, float* lds) {
    int* tab = (int*)(lds + LDS_MOE_TAB);
    unsigned* cnt = p.ctl + CTL_CNT + l * 32;
    if (tidx() < 64) {
        const int lane = tidx();
        const int myn = lane < NCLS ? (int)__hip_atomic_load(cnt + lane, __ATOMIC_RELAXED, __HIP_MEMORY_SCOPE_AGENT) : 0;
        int nt = 0, base = 0;
        for (int pass = 0; pass < 2; ++pass) {
            base = 0;
            for (int c = 0; c < NCLS; ++c) {
                const int n = __builtin_amdgcn_readlane(myn, c), ntc = (n + 255) >> 8;
                for (int mt = 0; mt < ntc; ++mt) {
                    const bool small = (n - mt * 256) <= 128;
                    if (small == (pass == 1)) { if (lane == 0) { tab[4 + 4 * nt] = c; tab[5 + 4 * nt] = mt; tab[6 + 4 * nt] = base * 256; tab[7 + 4 * nt] = n; } ++nt; }
                }
                base += ntc;
            }
        }
        if (lane == 0) tab[0] = nt;
    }
    __syncthreads();
}
DI int rfl(int v) { return __builtin_amdgcn_readfirstlane(v); }
struct MoeSched1 {
    const int* tab; int G, c; const char* hb; const char* wgu; const int* cls_tok;
    DI bool next(int i, pg8::Unit& u) const {
        const int L = i * G + c, nt = rfl(tab[0]); if (L >= nt * 8) return false;
        const int ft = L >> 3, pn = L & 7;
        const int cls = rfl(tab[4 + 4 * ft]), mt = rfl(tab[5 + 4 * ft]), sb = rfl(tab[6 + 4 * ft]), n = rfl(tab[7 + 4 * ft]);
        int ea, eb; cls_experts(cls, ea, eb); const int e = pn < 4 ? ea : eb;
        u.pm = (sb >> 8) + mt; u.pn = pn; u.A = hb; u.Ba = wgu + ((size_t)e * 1024 + (pn & 3) * 256) * 2048 * 2; u.Bb = u.Ba; u.aux0 = cls; u.aux1 = mt * 256; u.aux2 = n; return true;
    }
    DI int gather_row(const pg8::Unit& u, int r) const { const int ri = u.aux1 + r; return cls_tok[(size_t)u.aux0 * CLS_CAP + (ri < u.aux2 ? ri : 0)]; }
};
struct MoeSched2 {
    const int* tab; int G, c; const char* hid; const char* wd;
    DI bool next(int i, pg8::Unit& u) const {
        const int L = i * G + c, nt = rfl(tab[0]); if (L >= nt * 8) return false;
        const int ft = L >> 3, pn = L & 7;
        const int cls = rfl(tab[4 + 4 * ft]), mt = rfl(tab[5 + 4 * ft]), sb = rfl(tab[6 + 4 * ft]), n = rfl(tab[7 + 4 * ft]);
        int ea, eb; cls_experts(cls, ea, eb);
        u.pm = (sb >> 8) + mt; u.pn = pn; u.A = hid + (size_t)(sb + mt * 256) * 1024 * 2;
        u.Ba = wd + ((size_t)ea * 2048 + pn * 256) * 512 * 2; u.Bb = wd + ((size_t)eb * 2048 + pn * 256) * 512 * 2 - (size_t)8 * 128;
        u.aux0 = cls; u.aux1 = mt * 256; u.aux2 = n; return true;
    }
    DI int gather_row(const pg8::Unit&, int r) const { return r; }
};
struct EpiMoe1 {
    static constexpr bool PERM = true;
    bf16_t* hid; const int* cls_tok; const float* tokw;
    DI void operator()(const pg8::f32x4 (&acc)[2][2][4][2], const pg8::Unit& u, int wr, int wc, int fr, int fq) const {
        const int which = u.pn >> 2, q = u.pn & 3;
        const int* toks = cls_tok + (size_t)u.aux0 * CLS_CAP;
        bf16_t* hb = hid + (size_t)u.pm * 256 * 1024 + which * 512 + q * 128 + wc * 32 + 8 * fq;
        int tk[8]; float wv[8];
#pragma unroll
        for (int k = 0; k < 8; ++k) { const int ri = u.aux1 + wr * 64 + fr + (k >> 2) * 128 + (k & 3) * 16; tk[k] = toks[ri < u.aux2 ? ri : u.aux2 - 1]; }
#pragma unroll
        for (int k = 0; k < 8; ++k) wv[k] = tokw[(size_t)tk[k] * 2 + which];
#pragma unroll
        for (int ai = 0; ai < 2; ++ai)
#pragma unroll
            for (int m = 0; m < 4; ++m) {
                const int r = wr * 64 + fr + ai * 128 + m * 16, ri = u.aux1 + r;
                if (ri < u.aux2) {
                    const float w = wv[ai * 4 + m];
                    const pg8::f32x4 g0 = acc[ai][0][m][0], g1 = acc[ai][0][m][1], u0 = acc[ai][1][m][0], u1 = acc[ai][1][m][1];
                    pg8::u32x4 o;
                    o.x = pg8::cvt_pk_bf16(siluf_(g0[0]) * u0[0] * w, siluf_(g0[1]) * u0[1] * w); o.y = pg8::cvt_pk_bf16(siluf_(g0[2]) * u0[2] * w, siluf_(g0[3]) * u0[3] * w);
                    o.z = pg8::cvt_pk_bf16(siluf_(g1[0]) * u1[0] * w, siluf_(g1[1]) * u1[1] * w); o.w = pg8::cvt_pk_bf16(siluf_(g1[2]) * u1[2] * w, siluf_(g1[3]) * u1[3] * w);
                    *(pg8::u32x4*)(hb + (size_t)r * 1024) = o;
                }
            }
    }
};
struct EpiMoe2 {
    static constexpr bool PERM = true;
    float* x; const int* cls_tok; const float* g2;
    DI void operator()(const pg8::f32x4 (&acc)[2][2][4][2], const pg8::Unit& u, int wr, int wc, int fr, int fq) const {
        const int* toks = cls_tok + (size_t)u.aux0 * CLS_CAP;
        const int col0 = u.pn * 256 + wc * 32 + 8 * fq;
        int tk[8];
#pragma unroll
        for (int k = 0; k < 8; ++k) { const int ri = u.aux1 + wr * 64 + fr + (k >> 2) * 128 + (k & 3) * 16; tk[k] = toks[ri < u.aux2 ? ri : u.aux2 - 1]; }
        pg8::f32x4 xv[2][2][2], gv[2][2][2];
#define M2_LOAD(k, sl) do { const int tok_ = tk[k]; const float* xr_ = x + (size_t)tok_ * D + col0; const float* gp_ = g2 + (size_t)(tok_ / S) * 12288 + col0; \
        xv[sl][0][0] = *(const pg8::f32x4*)(xr_); xv[sl][0][1] = *(const pg8::f32x4*)(xr_ + 4); xv[sl][1][0] = *(const pg8::f32x4*)(xr_ + 128); xv[sl][1][1] = *(const pg8::f32x4*)(xr_ + 132); \
        gv[sl][0][0] = *(const pg8::f32x4*)(gp_); gv[sl][0][1] = *(const pg8::f32x4*)(gp_ + 4); gv[sl][1][0] = *(const pg8::f32x4*)(gp_ + 128); gv[sl][1][1] = *(const pg8::f32x4*)(gp_ + 132); } while (0)
        M2_LOAD(0, 0);
#pragma unroll
        for (int k = 0; k < 8; ++k) {
            if (k + 1 < 8) M2_LOAD(k + 1, (k + 1) & 1);
            const int ai = k >> 2, m = k & 3;
            const int ri = u.aux1 + wr * 64 + fr + ai * 128 + m * 16;
            if (ri < u.aux2) {
                float* xr = x + (size_t)tk[k] * D + col0;
#pragma unroll
                for (int bj = 0; bj < 2; ++bj)
#pragma unroll
                    for (int n = 0; n < 2; ++n) *(pg8::f32x4*)(xr + bj * 128 + 4 * n) = xv[k & 1][bj][n] + gv[k & 1][bj][n] * acc[ai][bj][m][n];
            }
        }
#undef M2_LOAD
    }
};

constexpr int LDS_BYTES = 147456;
constexpr int LDS_MISC = 131072 / 4, LDS_TAB = 131328 / 4;
DI unsigned long long ld_tab(const float* lds, int i) {
    const unsigned lo = __builtin_amdgcn_readfirstlane(__float_as_uint(lds[LDS_TAB + 2 * i])), hi = __builtin_amdgcn_readfirstlane(__float_as_uint(lds[LDS_TAB + 2 * i + 1]));
    return ((unsigned long long)hi << 32) | lo;
}
#define GAS __attribute__((address_space(1)))
template <class T> DI T* gptr(unsigned long long v) { return (T*)(GAS T*)v; }
DI P load_P(const float* lds) {
    asm volatile("" ::: "memory");
    P p;
#pragma unroll
    for (int i = 0; i < 23; ++i) p.in[i] = gptr<const float>(ld_tab(lds, i));
    p.out = gptr<float>(ld_tab(lds, 23));
    const unsigned long long ws = ld_tab(lds, 24);
    p.ctl = gptr<unsigned>(ws + O_CTL); p.mod = gptr<float>(ws + O_MOD); p.xres = gptr<float>(ws + O_XRES); p.hbuf = gptr<bf16_t>(ws + O_HBUF); p.proj = gptr<bf16_t>(ws + O_PROJ);
    p.oA = gptr<bf16_t>(ws + O_OA); p.lseA = gptr<float>(ws + O_LSEA); p.oB = gptr<bf16_t>(ws + O_OB); p.oC = gptr<bf16_t>(ws + O_OC); p.oD = gptr<bf16_t>(ws + O_OD);
    p.kmean = gptr<float>(ws + O_KMEAN); p.kc = gptr<bf16_t>(ws + O_KC); p.vc = gptr<bf16_t>(ws + O_VC); p.cls_tok = gptr<int>(ws + O_CLSTOK); p.tokw = gptr<float>(ws + O_TOKW);
    p.hid = gptr<bf16_t>(ws + O_HID); p.winT = gptr<bf16_t>(ws + O_WINT); p.woutT = gptr<bf16_t>(ws + O_WOUTT); p.wguT = gptr<bf16_t>(ws + O_WGUT); p.wdT = gptr<bf16_t>(ws + O_WDT);
    p.cw1T = gptr<bf16_t>(ws + O_CW1T); p.cw2T = gptr<bf16_t>(ws + O_CW2T); p.cgT = gptr<bf16_t>(ws + O_CGT); p.crT = gptr<bf16_t>(ws + O_CRT); p.hlo = gptr<bf16_t>(ws + O_HLO);
    return p;
}
#if PROBE_MASK
#define STAMP(id) do { if (blockIdx.x == 0 && threadIdx.x == 0) { volatile LAS unsigned long long* tq = (volatile LAS unsigned long long*)(lds + LDS_MISC + 8); \
    const unsigned long long now_ = __builtin_amdgcn_s_memrealtime(); if ((PROBE_MASK >> (id)) & 1) tq[1] += now_ - tq[0]; tq[0] = now_; } } while (0)
#else
#define STAMP(id) do { } while (0)
#endif
__global__ void __launch_bounds__(NTHR, 2) mk_fwd(KArgs ka) {
    extern __shared__ __attribute__((aligned(16))) float lds[];
    const int bid = blockIdx.x, nb = gridDim.x;
#define w (__builtin_amdgcn_readfirstlane(tidx() >> 6))
    volatile LAS unsigned* xbw = (volatile LAS unsigned*)(lds + LDS_MISC);
    if (threadIdx.x == 0) { xbw[0] = 0u; xbw[1] = 0u; xbw[2] = 0u; xbw[3] = 0u; }
    if (threadIdx.x < 25) {
        const unsigned long long v = (threadIdx.x < 23) ? (unsigned long long)ka.in[threadIdx.x < 23 ? threadIdx.x : 0] : (threadIdx.x == 23 ? (unsigned long long)ka.out : (unsigned long long)ka.ws);
        lds[LDS_TAB + 2 * threadIdx.x] = __uint_as_float((unsigned)v); lds[LDS_TAB + 2 * threadIdx.x + 1] = __uint_as_float((unsigned)(v >> 32));
    }
    __syncthreads();
    (void)xcd_barrier_post((unsigned*)(ka.ws + O_CTL), xbw);
#define bar (XcdBarrier{gptr<unsigned>(ld_tab(lds, 24) + O_CTL), xb_xcc_id(), (volatile LAS unsigned*)(lds + LDS_MISC)})
#if PROBE_MASK
    if (blockIdx.x == 0 && threadIdx.x == 0) { volatile LAS unsigned long long* tq = (volatile LAS unsigned long long*)(lds + LDS_MISC + 8); tq[0] = __builtin_amdgcn_s_memrealtime(); tq[1] = 0ull; tq[2] = tq[0]; }
#endif

    { const P p = load_P(lds);
      for (int it = bid; it < N_MOD_ITEMS; it += nb) phase_mod_item(p, it, lds);
      phase_transposes(p, bid, nb, lds); }
    xcd_barrier(bar);
    STAMP(0);
    for (int l = 0; l < DEPTH; ++l) {
        { const P p = load_P(lds); for (int it = bid; it < N_NORM_ITEMS; it += nb) phase_norm_item(p, l, 0, it, lds); }
        xcd_barrier(bar);
    STAMP(1);
        { const P p = load_P(lds);
          DenseSched sc; sc.go.init(T, 5120, nb, bid); sc.A = (const char*)p.hbuf; sc.Bt = (const char*)(p.winT + (size_t)l * NPAD_IN * 2048); sc.a_tile = (size_t)256 * D * 2; sc.b_tile = (size_t)256 * 2048 * 2;
          const pg8::Shape g{2048, D, 2048, 1 << 20};
          const EpiProj E{p.proj};
          pg8::gemm_phase<EpiProj, DenseSched, false>((PG8_LAS unsigned char*)lds, g, sc, E); }
        xcd_barrier(bar);
    STAMP(2);
        { const P p = load_P(lds);
          for (int it = bid; it < N_CMP_ITEMS + N_KMEAN_GROUPS; it += nb) { if (it < N_CMP_ITEMS) phase_cmp_item(p, l, it, lds); else phase_kmean_group(p, it - N_CMP_ITEMS, lds); } }
        xcd_barrier(bar);
    STAMP(3);
        { const P p = load_P(lds); fa::phase_attention(p, l, lds); }
        xcd_barrier(bar);
    STAMP(4);
        { const P p = load_P(lds); phase_mixnorm(p, bid * 8 + w, nb * 8); }
        xcd_barrier(bar);
    STAMP(5);
        { const P p = load_P(lds);
          DenseSched sc; sc.go.init(T, 2048, nb, bid); sc.A = (const char*)p.hbuf; sc.Bt = (const char*)(p.woutT + (size_t)l * 2048 * 2048); sc.a_tile = (size_t)256 * D * 2; sc.b_tile = (size_t)256 * 2048 * 2;
          const pg8::Shape g{2048, D, 2048, 1 << 20};
          const EpiResid E{l == 0 ? p.in[0] : p.xres, p.xres, p.mod + (size_t)l * 4 * 12288 + 2 * D};
          pg8::gemm_phase<EpiResid, DenseSched, false>((PG8_LAS unsigned char*)lds, g, sc, E); }
        xcd_barrier(bar);
    STAMP(6);
        { const P p = load_P(lds); for (int it = bid; it < N_NORM_ITEMS; it += nb) phase_norm_item(p, l, 1, it, lds); }
        xcd_barrier(bar);
    STAMP(7);
        { const P p = load_P(lds); moe_build_table(p, l, lds);
          const MoeSched1 sc{(const int*)(lds + LDS_MOE_TAB), nb, bid, (const char*)p.hbuf, (const char*)(p.wguT + (size_t)l * 16 * 1024 * 2048), p.cls_tok};
          const pg8::Shape g{2048, D, 2048, 1 << 20};
          const EpiMoe1 E{p.hid, p.cls_tok, p.tokw};
          pg8::gemm_phase<EpiMoe1, MoeSched1, true, true>((PG8_LAS unsigned char*)lds, g, sc, E); }
        xcd_barrier(bar);
    STAMP(8);
        { const P p = load_P(lds);
          const MoeSched2 sc{(const int*)(lds + LDS_MOE_TAB), nb, bid, (const char*)p.hid, (const char*)(p.wdT + (size_t)l * 16 * 2048 * 512)};
          const pg8::Shape g{1024, 1024, 512, 8};
          const EpiMoe2 E{p.xres, p.cls_tok, p.mod + (size_t)l * 4 * 12288 + 5 * D};
          pg8::gemm_phase<EpiMoe2, MoeSched2, false, true>((PG8_LAS unsigned char*)lds, g, sc, E); }
        xcd_barrier(bar);
    STAMP(9);
    }
    { const P p = load_P(lds);
      const bool tmo = xb_ld(p.ctl + XB_TMO) != 0u;
      phase_final(p, bid * 8 + w, nb * 8, tmo);
#if PROBE_MASK
      if (blockIdx.x == 0 && threadIdx.x == 0) { volatile LAS unsigned long long* tq = (volatile LAS unsigned long long*)(lds + LDS_MISC + 8);
          const unsigned long long now_ = __builtin_amdgcn_s_memrealtime(); if ((PROBE_MASK >> 10) & 1) tq[1] += now_ - tq[0];
          const float frac = (float)tq[1] / (float)(now_ - tq[2]);
          asm volatile("s_waitcnt vmcnt(0)" ::: "memory");
          p.out[0] = 20.f + 79.f * frac; }
#endif
    }
#undef w
#undef bar
}

extern "C" void kernel_launch(void* const* d_in, const int* in_sizes, int n_in, void* d_out, int out_size, void* d_ws, size_t ws_size, hipStream_t stream) {
    KArgs ka{};
    for (int i = 0; i < 23; ++i) ka.in[i] = (const float*)d_in[i];
    ka.out = (float*)d_out;
    ka.ws = (unsigned char*)d_ws;
    if (WS_NEED > ws_size) { fprintf(stderr, "workspace too small: need %zu have %zu\n", (size_t)WS_NEED, ws_size); return; }
    static int grid = 0;
    if (!grid) {
        int dev = 0, cus = 0, per_cu = 0;
        (void)hipGetDevice(&dev);
        (void)hipDeviceGetAttribute(&cus, hipDeviceAttributeMultiprocessorCount, dev);
        (void)hipFuncSetAttribute((const void*)mk_fwd, hipFuncAttributeMaxDynamicSharedMemorySize, LDS_BYTES);
        (void)hipOccupancyMaxActiveBlocksPerMultiprocessor(&per_cu, (const void*)mk_fwd, NTHR, LDS_BYTES);
        if (per_cu < 1) fprintf(stderr, "occupancy query reports %d blocks per CU\n", per_cu);
        (void)hipGetLastError();
        grid = cus;
    }
    (void)hipMemsetAsync(ka.ws + O_CTL, 0, 1 << 16, stream);
    mk_fwd<<<grid, NTHR, LDS_BYTES, stream>>>(ka);
}
```

```cpp
#include <hip/hip_runtime.h>
#ifndef PROBE_MASK
#define PROBE_MASK 0
#endif
#if PROBE_MASK
#define SUBSTAMP(id) do { if (blockIdx.x == 0 && threadIdx.x == 0) { volatile __attribute__((address_space(3))) unsigned long long* tq = (volatile __attribute__((address_space(3))) unsigned long long*)(lds + 32768 + 8); \
    const unsigned long long now_ = __builtin_amdgcn_s_memrealtime(); if ((PROBE_MASK >> (id)) & 1) tq[1] += now_ - tq[0]; tq[0] = now_; } } while (0)
#else
#define SUBSTAMP(id) do { } while (0)
#endif
#include <stdint.h>
#include <stdio.h>

typedef unsigned short bf16_t;
#define DI __device__ __forceinline__
#define LAS __attribute__((address_space(3)))

constexpr int D = 2048, NBATCH = 4, S = 4096, T = NBATCH * S, DEPTH = 4;
constexpr int NTHR = 512;
constexpr int LDP = 5184;
constexpr int NPAD_IN = 5120;
constexpr int OFF_QA = 0, OFF_KA = 512, OFF_VA = 1024, OFF_QB = 1536, OFF_KB = 2048, OFF_VB = 2176, OFF_QC = 2304, OFF_KC = 2816,
              OFF_VC = 3328, OFF_QD = 3840, OFF_KDC = 4352, OFF_VDC = 4480, OFF_KDS = 4608, OFF_VDS = 4736, OFF_KDW = 4864,
              OFF_VDW = 4992, OFF_GD = 5120;
constexpr int NCLS = 24, CLS_CAP = T, HID_ROWS = T + NCLS * 256;
constexpr float NEGF = -1e30f;
constexpr float EPS = 1e-6f;

struct P {
    const float* in[23];
    float* out;
    unsigned* ctl;
    float* mod;
    bf16_t* xres;
    bf16_t* hbuf;
    bf16_t* proj;
    bf16_t* oA;
    float* lseA;
    bf16_t* oB; bf16_t* oC; bf16_t* oD;
    float* kmean;
    bf16_t* kc; bf16_t* vc;
    int* cls_tok;
    float* tokw;
    bf16_t* hid;
    bf16_t* winT;
    bf16_t* woutT;
    bf16_t* wguT;
    bf16_t* wdT;
    bf16_t* cw1T;
    bf16_t* cw2T;
    bf16_t* cgT;
    bf16_t* crT;
    bf16_t* hlo;
};
constexpr size_t al256(size_t x) { return (x + 255) & ~(size_t)255; }
constexpr size_t O_CTL = 0;
constexpr size_t O_MOD = O_CTL + al256((size_t)1 << 20);
constexpr size_t O_XRES = O_MOD + al256((size_t)4 * 4 * 12288 * 4);
constexpr size_t O_HBUF = O_XRES + al256((size_t)T * D * 4);
constexpr size_t O_PROJ = O_HBUF + al256((size_t)T * D * 2);
constexpr size_t O_OA = O_PROJ + al256((size_t)T * LDP * 2);
constexpr size_t O_LSEA = O_OA + al256((size_t)3 * T * 512 * 2);
constexpr size_t O_OB = O_LSEA + al256((size_t)3 * T * 8 * 4);
constexpr size_t O_OC = O_OB + al256((size_t)T * 512 * 2);
constexpr size_t O_OD = O_OC + al256((size_t)T * 512 * 2);
constexpr size_t O_KMEAN = O_OD + al256((size_t)T * 512 * 2);
constexpr size_t O_KC = O_KMEAN + al256((size_t)4 * 8 * 16 * 64 * 4);
constexpr size_t O_VC = O_KC + al256((size_t)4 * 2 * 256 * 64 * 2);
constexpr size_t O_CLSTOK = O_VC + al256((size_t)4 * 2 * 256 * 64 * 2);
constexpr size_t O_TOKW = O_CLSTOK + al256((size_t)NCLS * CLS_CAP * 4);
constexpr size_t O_HID = O_TOKW + al256((size_t)T * 2 * 4);
constexpr size_t O_WINT = O_HID + al256((size_t)HID_ROWS * 1024 * 2);
constexpr size_t O_WOUTT = O_WINT + al256((size_t)4 * NPAD_IN * 2048 * 2);
constexpr size_t O_WGUT = O_WOUTT + al256((size_t)4 * 2048 * 2048 * 2);
constexpr size_t O_WDT = O_WGUT + al256((size_t)4 * 16 * 1024 * 2048 * 2);
constexpr size_t O_CW1T = O_WDT + al256((size_t)4 * 16 * 2048 * 512 * 2);
constexpr size_t O_CW2T = O_CW1T + al256((size_t)4 * 2 * 128 * 2048 * 2);
constexpr size_t O_CGT = O_CW2T + al256((size_t)4 * 2 * 64 * 128 * 2);
constexpr size_t O_CRT = O_CGT + al256((size_t)4 * 32 * 2048 * 2);
constexpr size_t O_HLO = O_CRT + al256((size_t)2 * 32 * 2048 * 2);
constexpr size_t WS_NEED = O_HLO + al256((size_t)T * D * 2);
struct KArgs { const float* in[23]; float* out; unsigned char* ws; };
constexpr int CTL_CNT = 8192;
constexpr int CTL_Q = 8192 + 256;

DI int tidx() { int t = threadIdx.x; asm volatile("" : "+v"(t)); return t; }
DI float bf2f(bf16_t v) { return __uint_as_float(((unsigned)v) << 16); }
DI bf16_t f2bf(float f) { unsigned u = __float_as_uint(f); u += 0x7fffu + ((u >> 16) & 1u); return (bf16_t)(u >> 16); }
DI float wave_sum(float v) { for (int o = 32; o > 0; o >>= 1) v += __shfl_xor(v, o); return v; }
DI float wave_sum_dpp(float v) {
    v += __builtin_bit_cast(float, __builtin_amdgcn_update_dpp(0, __builtin_bit_cast(int, v), 0xB1, 0xF, 0xF, true));
    v += __builtin_bit_cast(float, __builtin_amdgcn_update_dpp(0, __builtin_bit_cast(int, v), 0x4E, 0xF, 0xF, true));
    v += __builtin_bit_cast(float, __builtin_amdgcn_update_dpp(0, __builtin_bit_cast(int, v), 0x141, 0xF, 0xF, true));
    v += __builtin_bit_cast(float, __builtin_amdgcn_update_dpp(0, __builtin_bit_cast(int, v), 0x140, 0xF, 0xF, true));
    const int vi = __builtin_bit_cast(int, v);
    const float a = __builtin_bit_cast(float, __builtin_amdgcn_readlane(vi, 0)), b = __builtin_bit_cast(float, __builtin_amdgcn_readlane(vi, 16));
    const float c = __builtin_bit_cast(float, __builtin_amdgcn_readlane(vi, 32)), d = __builtin_bit_cast(float, __builtin_amdgcn_readlane(vi, 48));
    return (a + b) + (c + d);
}
DI float wave_max(float v) { for (int o = 32; o > 0; o >>= 1) v = fmaxf(v, __shfl_xor(v, o)); return v; }
DI void wave_lds_sync() { asm volatile("s_waitcnt lgkmcnt(0)" ::: "memory"); __builtin_amdgcn_wave_barrier(); }
DI float sigmoidf_(float x) { return 1.f / (1.f + __expf(-x)); }
DI float siluf_(float x) { return x / (1.f + __expf(-x)); }
DI float gelu_tanh(float x) { float u = 0.7978845608028654f * (x + 0.044715f * x * x * x); return 0.5f * x * (1.f + tanhf(u)); }
DI int t5_bucket(int d) {
    if (d < 16) return d < 0 ? 0 : d;
    return 16 + (d >= 22) + (d >= 30) + (d >= 40) + (d >= 54) + (d >= 73) + (d >= 99) + (d >= 134) + (d >= 182) + (d >= 246) + (d >= 332) +
           (d >= 450) + (d >= 609) + (d >= 825) + (d >= 1117) + (d >= 1513);
}

typedef float nt_f32x4 __attribute__((ext_vector_type(4)));
typedef unsigned nt_u32x4 __attribute__((ext_vector_type(4)));
DI void phase_mod_item(const P& p, int item, float* lds) {
    const int l = item / 192, jb = item % 192, tid = tidx(), w = __builtin_amdgcn_readfirstlane(tid >> 6), lane = tid & 63, c4 = lane & 15, kq = lane >> 4;
    float* cact = lds;
    float* red = lds + 8192;
    const float* c = p.in[1];
    for (int i = tid; i < 4 * 2048; i += NTHR) cact[i] = siluf_(c[i]);
    __syncthreads();
    const float* wp = p.in[7] + (size_t)l * 2048 * 12288 + (size_t)(w * 256 + kq) * 12288 + jb * 64 + 4 * c4;
    float4 a[4];
#pragma unroll
    for (int b = 0; b < 4; ++b) a[b] = make_float4(0.f, 0.f, 0.f, 0.f);
#pragma unroll 8
    for (int i = 0; i < 64; ++i) {
        const nt_f32x4 wt_ = __builtin_nontemporal_load((const nt_f32x4*)(wp + (size_t)(4 * i) * 12288)); const float4 wv = make_float4(wt_.x, wt_.y, wt_.z, wt_.w);
        const int kk = w * 256 + 4 * i + kq;
#pragma unroll
        for (int b = 0; b < 4; ++b) { const float cv = cact[b * 2048 + kk]; a[b].x += cv * wv.x; a[b].y += cv * wv.y; a[b].z += cv * wv.z; a[b].w += cv * wv.w; }
    }
#pragma unroll
    for (int b = 0; b < 4; ++b) {
        a[b].x += __shfl_xor(a[b].x, 16); a[b].y += __shfl_xor(a[b].y, 16); a[b].z += __shfl_xor(a[b].z, 16); a[b].w += __shfl_xor(a[b].w, 16);
        a[b].x += __shfl_xor(a[b].x, 32); a[b].y += __shfl_xor(a[b].y, 32); a[b].z += __shfl_xor(a[b].z, 32); a[b].w += __shfl_xor(a[b].w, 32);
    }
    if (kq == 0) {
#pragma unroll
        for (int b = 0; b < 4; ++b) *(float4*)(red + (w * 4 + b) * 64 + 4 * c4) = a[b];
    }
    __syncthreads();
    if (tid < 256) {
        const int b = tid >> 6, col = tid & 63;
        float v = 0.f;
#pragma unroll
        for (int q = 0; q < 8; ++q) v += red[(q * 4 + b) * 64 + col];
        p.mod[((size_t)l * 4 + b) * 12288 + jb * 64 + col] = v + p.in[8][(size_t)l * 12288 + jb * 64 + col];
    }
    __syncthreads();
}
constexpr int N_MOD_ITEMS = 4 * 192;

struct TrDesc { const float* src; int ld, k0, n0, N; bf16_t* dst; int lddst, dst_row0; const float* kscale; bf16_t* dst_lo; };
DI void tr_load(const TrDesc& d, float4 (&v)[5]) {
    const int tid = tidx();
#pragma unroll
    for (int i = 0; i < 4; ++i) {
        const int e = tid + i * NTHR, kk = e >> 4, c4 = e & 15;
        const int nc = (d.n0 + 4 * c4 + 3 < d.N) ? 4 * c4 : d.N - d.n0 - 4;
        const nt_f32x4 t_ = __builtin_nontemporal_load((const nt_f32x4*)(d.src + (size_t)(d.k0 + kk) * d.ld + d.n0 + nc));
        v[i] = make_float4(t_.x, t_.y, t_.z, t_.w);
    }
    {
        const float* kp = (d.kscale ? d.kscale : d.src) + d.k0 + (tid >> 4);
        v[4] = make_float4(kp[0], kp[32], kp[64], kp[96]);
    }
}
DI void tr_finish(const TrDesc& d, const float4 (&v)[5], float* lds) {
    float(*tl)[65] = (float(*)[65])lds;
    const int tid = tidx();
#pragma unroll
    for (int i = 0; i < 4; ++i) {
        const int e = tid + i * NTHR, kk = e >> 4, c4 = e & 15;
        float4 x = v[i];
        if (d.n0 + 4 * c4 + 3 >= d.N) x = make_float4(0.f, 0.f, 0.f, 0.f);
        { const float kq[4] = {v[4].x, v[4].y, v[4].z, v[4].w}; const float ks = d.kscale ? kq[i] : 1.f; x.x *= ks; x.y *= ks; x.z *= ks; x.w *= ks; }
        tl[kk][4 * c4] = x.x; tl[kk][4 * c4 + 1] = x.y; tl[kk][4 * c4 + 2] = x.z; tl[kk][4 * c4 + 3] = x.w;
    }
    __syncthreads();
#pragma unroll
    for (int i = 0; i < 2; ++i) {
        const int e = tid + i * NTHR, nn = e >> 4, kc = e & 15, n = d.n0 + nn;
        if (n < d.N) {
            float f[8];
#pragma unroll
            for (int j = 0; j < 8; ++j) f[j] = tl[kc * 8 + j][nn];
            const size_t di = (size_t)(d.dst_row0 + nn) * d.lddst + d.k0 + kc * 8;
            uint4 hi;
            hi.x = (unsigned)f2bf(f[0]) | ((unsigned)f2bf(f[1]) << 16); hi.y = (unsigned)f2bf(f[2]) | ((unsigned)f2bf(f[3]) << 16);
            hi.z = (unsigned)f2bf(f[4]) | ((unsigned)f2bf(f[5]) << 16); hi.w = (unsigned)f2bf(f[6]) | ((unsigned)f2bf(f[7]) << 16);
            { nt_u32x4 t_; t_.x = hi.x; t_.y = hi.y; t_.z = hi.z; t_.w = hi.w; __builtin_nontemporal_store(t_, (nt_u32x4*)(d.dst + di)); }
            if (d.dst_lo) {
                uint4 lo;
                lo.x = (unsigned)f2bf(f[0] - __uint_as_float(hi.x << 16)) | ((unsigned)f2bf(f[1] - __uint_as_float(hi.x & 0xffff0000u)) << 16);
                lo.y = (unsigned)f2bf(f[2] - __uint_as_float(hi.y << 16)) | ((unsigned)f2bf(f[3] - __uint_as_float(hi.y & 0xffff0000u)) << 16);
                lo.z = (unsigned)f2bf(f[4] - __uint_as_float(hi.z << 16)) | ((unsigned)f2bf(f[5] - __uint_as_float(hi.z & 0xffff0000u)) << 16);
                lo.w = (unsigned)f2bf(f[6] - __uint_as_float(hi.w << 16)) | ((unsigned)f2bf(f[7] - __uint_as_float(hi.w & 0xffff0000u)) << 16);
                *(uint4*)(d.dst_lo + di) = lo;
            }
        }
    }
    __syncthreads();
}
constexpr int TR0 = 4 * 16 * 80, TR1 = 4 * 16 * 32, TR2 = 4 * 16 * 16 * 8, TR3 = TR2, TR4 = 4 * 16 * 4 * 32, TR5 = 4 * 16 * 2, TR6 = TR5, TR7 = 4, TR8 = TR7, TR9 = 4 * 16, TR10 = 16;
constexpr int N_TR_ITEMS = TR0 + TR1 + TR2 + TR3 + TR4 + TR5 + TR6 + TR7 + TR8 + TR9 + TR10;
DI TrDesc tr_desc(const P& p, int item) {
    int i = item;
    if (i < TR0) { const int l = i / (16 * 80), r = i % (16 * 80), kt = r / 80, nt = r % 80;
        return TrDesc{p.in[9] + (size_t)l * 2048 * 5144, 5144, kt * 128, nt * 64, 5144, p.winT + (size_t)l * NPAD_IN * 2048, 2048, nt * 64, nullptr, nullptr}; }
    i -= TR0;
    if (i < TR1) { const int l = i / 512, r = i % 512, kt = r / 32, nt = r % 32;
        return TrDesc{p.in[18] + (size_t)l * 2048 * 2048, 2048, kt * 128, nt * 64, 2048, p.woutT + (size_t)l * 2048 * 2048, 2048, nt * 64, p.in[17] + (size_t)l * 2048, nullptr}; }
    i -= TR1;
    if (i < TR2 + TR3) { const int up = i >= TR2; if (up) i -= TR2; const int le = i / 128, r = i % 128, kt = r / 8, nt = r % 8;
        return TrDesc{(up ? p.in[20] : p.in[19]) + (size_t)le * 2048 * 512, 512, kt * 128, nt * 64, 512, p.wguT + (size_t)le * 1024 * 2048, 2048, (nt >> 1) * 256 + (nt & 1) * 64 + (up ? 128 : 0), nullptr, nullptr}; }
    i -= TR2 + TR3;
    if (i < TR4) { const int le = i / 128, r = i % 128, kt = r / 32, nt = r % 32;
        return TrDesc{p.in[21] + (size_t)le * 512 * 2048, 2048, kt * 128, nt * 64, 2048, p.wdT + (size_t)le * 2048 * 512, 512, nt * 64, nullptr, nullptr}; }
    i -= TR4;
    if (i < TR5 + TR6) { const int v = i >= TR5; if (v) i -= TR5; const int l = i / 32, r = i % 32, kt = r / 2, nt = r % 2;
        return TrDesc{(v ? p.in[14] : p.in[12]) + (size_t)l * 2048 * 128, 128, kt * 128, nt * 64, 128, p.cw1T + (size_t)(l * 2 + v) * 128 * 2048, 2048, nt * 64, nullptr, nullptr}; }
    i -= TR5 + TR6;
    if (i < TR7 + TR8) { const int v = i >= TR7; if (v) i -= TR7; const int l = i;
        return TrDesc{(v ? p.in[15] : p.in[13]) + (size_t)l * 128 * 64, 64, 0, 0, 64, p.cw2T + (size_t)(l * 2 + v) * 64 * 128, 128, 0, nullptr, nullptr}; }
    i -= TR7 + TR8;
    if (i < TR9) { const int l = i / 16, kt = i % 16;
        return TrDesc{p.in[9] + (size_t)l * 2048 * 5144 + 5120, 5144, kt * 128, 0, 24, p.cgT + (size_t)l * 32 * 2048, 2048, 0, nullptr, nullptr}; }
    i -= TR9;
    return TrDesc{p.in[3], 16, i * 128, 0, 16, p.crT, 2048, 0, nullptr, p.crT + 32 * 2048};
}
constexpr int TRO5 = TR0 + TR1 + TR2 + TR3 + TR4, TRO6 = TRO5 + TR5, TRO7 = TRO6 + TR6, TRO8 = TRO7 + TR7, TRO9 = TRO8 + TR8, TRO10 = TRO9 + TR9;
constexpr int TR_NA = 1280 + 32 + 32 + 1 + 1 + 16 + 16, TR_NB = N_TR_ITEMS - TR_NA;
DI int tr_denseA(int a) {
    if (a < 1280) return a; a -= 1280;
    if (a < 32) return TRO5 + a; a -= 32;
    if (a < 32) return TRO6 + a; a -= 32;
    if (a < 1) return TRO7; a -= 1;
    if (a < 1) return TRO8; a -= 1;
    if (a < 16) return TRO9 + a; a -= 16;
    return TRO10 + a;
}
DI int tr_denseB(int b) {
    if (b < TRO5 - 1280) return 1280 + b; b -= TRO5 - 1280;
    if (b < TR5 - 32) return TRO5 + 32 + b; b -= TR5 - 32;
    if (b < TR6 - 32) return TRO6 + 32 + b; b -= TR6 - 32;
    if (b < TR7 - 1) return TRO7 + 1 + b; b -= TR7 - 1;
    if (b < TR8 - 1) return TRO8 + 1 + b; b -= TR8 - 1;
    return TRO9 + 16 + b;
}
DI void phase_transposes_range(const P& p, int first, int last, int step, bool setB, float* lds) {
    if (first >= last) return;
#define TR_MAP(i) (setB ? tr_denseB(i) : tr_denseA(i))
    float4 vs[4][5];
#pragma unroll
    for (int sl = 0; sl < 3; ++sl) { const int i = first + sl * step; if (i < last) { const TrDesc d = tr_desc(p, TR_MAP(i)); tr_load(d, vs[sl]); } }
    for (int base = first; base < last; base += 4 * step) {
#pragma unroll
        for (int sl = 0; sl < 4; ++sl) {
            const int i = base + sl * step, ipf = i + 3 * step;
            if (ipf < last) { const TrDesc d = tr_desc(p, TR_MAP(ipf)); tr_load(d, vs[(sl + 3) & 3]); }
            if (i < last) { const TrDesc d = tr_desc(p, TR_MAP(i)); tr_finish(d, vs[sl], lds); }
        }
    }
#undef TR_MAP
}
constexpr int CONV_TR_CHUNKS = (TR_NB + 15) / 16, CONV_CHUNKS = CONV_TR_CHUNKS + (N_MOD_ITEMS - 192), CONV_CQ = (CONV_CHUNKS + 7) / 8;
DI void conv_chunk(const P& p, int g, float* lds) {
    if (g < CONV_TR_CHUNKS) { const int f = g * 16; phase_transposes_range(p, f, f + 16 < TR_NB ? f + 16 : TR_NB, 1, true, lds); }
    else if (g < CONV_CHUNKS) phase_mod_item(p, 192 + g - CONV_TR_CHUNKS, lds);
}

DI int route_token(const P& p, int l, int row, const float (&lg)[16]) {
    {
        float aff[16], sc[16];
#pragma unroll
        for (int e = 0; e < 16; ++e) { aff[e] = sigmoidf_(lg[e]); sc[e] = aff[e] + p.in[4][e]; }
        int bg = 0; float bgs = -3e38f;
#pragma unroll
        for (int g = 0; g < 4; ++g) {
            float m1 = -3e38f, m2 = -3e38f;
#pragma unroll
            for (int j = 0; j < 4; ++j) { const float v = sc[g * 4 + j]; if (v > m1) { m2 = m1; m1 = v; } else if (v > m2) m2 = v; }
            const float gs = m1 + m2;
            if (gs > bgs) { bgs = gs; bg = g; }
        }
        float s4[4], a4[4];
#pragma unroll
        for (int g = 0; g < 4; ++g)
#pragma unroll
            for (int j = 0; j < 4; ++j) if (g == bg) { s4[j] = sc[g * 4 + j]; a4[j] = aff[g * 4 + j]; }
        int i1 = 0; float b1 = s4[0];
#pragma unroll
        for (int j = 1; j < 4; ++j) if (s4[j] > b1) { b1 = s4[j]; i1 = j; }
        int i2 = -1; float b2 = -3e38f;
#pragma unroll
        for (int j = 0; j < 4; ++j) if (j != i1 && s4[j] > b2) { b2 = s4[j]; i2 = j; }
        float w1 = 0.f, w2 = 0.f;
#pragma unroll
        for (int j = 0; j < 4; ++j) { if (j == i1) w1 = a4[j]; if (j == i2) w2 = a4[j]; }
        const float inv = 1.f / (w1 + w2);
        w1 *= inv; w2 *= inv;
        const int a = i1 < i2 ? i1 : i2, bb = i1 < i2 ? i2 : i1;
        const float wa = i1 < i2 ? w1 : w2, wb = i1 < i2 ? w2 : w1;
        const int pidx = (a == 0) ? (bb - 1) : (a == 1 ? (bb + 1) : 5);
        const int cls = bg * 6 + pidx;
        p.tokw[(size_t)row * 2 + 0] = wa; p.tokw[(size_t)row * 2 + 1] = wb;
        return cls;
    }
}


constexpr int N_NORM_ITEMS = T / 64;
DI void phase_norm_item(const P& p, int l, int which, int item, float* lds) {
    typedef short bf16x8 __attribute__((ext_vector_type(8)));
    typedef float f32x16 __attribute__((ext_vector_type(16)));
    const int tid = tidx(), w = __builtin_amdgcn_readfirstlane(tid >> 6), lane = tid & 63, r = lane & 31, h = lane >> 5;
    const int R0 = item * 64, b = R0 / S;
    float* cm = lds;
    float* cs = lds + 2048;
    float* red = lds + 4096;
    float* fin = lds + 4096 + 16384;
    {
        const bool f32src = (l == 0 && which == 0);
        const float* xb = p.in[0] + lane * 4; const bf16_t* xh = p.xres + lane * 4;
        uint4 xv[3][8];
#define NLOAD(dst, row, i) do { if (f32src) dst = *(const uint4*)(xb + (size_t)(row) * D + (i) * 256); else { const uint2 t_ = *(const uint2*)(xh + (size_t)(row) * D + (i) * 256); dst.x = t_.x; dst.y = t_.y; } } while (0)
#define NVAL(src) (f32src ? make_float4(__uint_as_float(src.x), __uint_as_float(src.y), __uint_as_float(src.z), __uint_as_float(src.w)) \
                          : make_float4(__uint_as_float(src.x << 16), __uint_as_float(src.x & 0xffff0000u), __uint_as_float(src.y << 16), __uint_as_float(src.y & 0xffff0000u)))
#define NROW(q) (R0 + ((q) < 4 ? 4 * w + (q) : 32 + 4 * w + (q) - 4))
#pragma unroll
        for (int j = 0; j < 2; ++j)
#pragma unroll
            for (int i = 0; i < 8; ++i) NLOAD(xv[j][i], NROW(j), i);
        {
            const float* g = p.in[which ? 6 : 5] + (size_t)l * D;
            const float* sh = p.mod + ((size_t)l * 4 + b) * 12288 + (which ? 3 * D : 0);
            const float4 gv = *(const float4*)(g + tid * 4), shv = *(const float4*)(sh + tid * 4), scv = *(const float4*)(sh + D + tid * 4);
            float4 mv; mv.x = gv.x * (1.f + scv.x); mv.y = gv.y * (1.f + scv.y); mv.z = gv.z * (1.f + scv.z); mv.w = gv.w * (1.f + scv.w);
            *(float4*)(cm + tid * 4) = mv; *(float4*)(cs + tid * 4) = shv;
        }
        __syncthreads();
#pragma unroll
        for (int bt = 0; bt < 8; ++bt) {
            if (bt < 6) {
#pragma unroll
                for (int i = 0; i < 8; ++i) NLOAD(xv[(bt + 2) % 3][i], NROW(bt + 2), i);
            }
            asm volatile("" ::: "memory");
            float ss0 = 0.f;
#pragma unroll
            for (int i = 0; i < 8; ++i) { const float4 a = NVAL(xv[bt % 3][i]); ss0 += a.x * a.x + a.y * a.y + a.z * a.z + a.w * a.w; }
            ss0 = wave_sum_dpp(ss0);
            const float rr = rsqrtf(ss0 * (1.f / D) + EPS);
#pragma unroll
            for (int i = 0; i < 8; ++i) {
                const float4 mv = *(const float4*)(cm + i * 256 + lane * 4), shv = *(const float4*)(cs + i * 256 + lane * 4);
                const float4 x = NVAL(xv[bt % 3][i]);
                if (f32src) { uint2 xs_; xs_.x = (unsigned)f2bf(x.x) | ((unsigned)f2bf(x.y) << 16); xs_.y = (unsigned)f2bf(x.z) | ((unsigned)f2bf(x.w) << 16);
                              *(uint2*)(p.xres + (size_t)NROW(bt) * D + i * 256 + lane * 4) = xs_; }
                const float h0 = x.x * rr * mv.x + shv.x, h1 = x.y * rr * mv.y + shv.y, h2 = x.z * rr * mv.z + shv.z, h3 = x.w * rr * mv.w + shv.w;
                uint2 pk;
                pk.x = (unsigned)f2bf(h0) | ((unsigned)f2bf(h1) << 16); pk.y = (unsigned)f2bf(h2) | ((unsigned)f2bf(h3) << 16);
                const size_t off = (size_t)NROW(bt) * D + i * 256 + lane * 4;
                *(uint2*)(p.hbuf + off) = pk;
            }
        }
#undef NROW
#undef NLOAD
#undef NVAL
    }
    if (which) SUBSTAMP(11);
    asm volatile("s_waitcnt vmcnt(0)" ::: "memory");
    __syncthreads();
    if (which) SUBSTAMP(12);
    f32x16 acc[2];
#pragma unroll
    for (int i = 0; i < 16; ++i) { acc[0][i] = 0.f; acc[1][i] = 0.f; }
    {
        typedef unsigned u32x4n __attribute__((ext_vector_type(4)));
        constexpr int CP = 528, CBUF = 96 * CP, OB_HI = 0, OA_HI = 64 * CP;
        LAS char* cb = (LAS char*)lds;
        const bf16_t* ag = which ? p.crT : p.cgT + (size_t)l * 32 * 2048;
        const int prow = tid >> 5, pc16 = tid & 31;
        const bf16_t* gb = p.hbuf + (size_t)(R0 + prow) * D + pc16 * 8;
        const bf16_t* ga = ag + (size_t)prow * 2048 + pc16 * 8;
        u32x4n rg[4][6];
#define NRM_LOAD(c, sl) do { \
        _Pragma("unroll") for (int j = 0; j < 4; ++j) rg[sl][j] = *(const u32x4n*)(gb + (size_t)(16 * j) * D + (c) * 256); \
        rg[sl][4] = *(const u32x4n*)(ga + (c) * 256); rg[sl][5] = *(const u32x4n*)(ga + (size_t)16 * 2048 + (c) * 256); } while (0)
        NRM_LOAD(0, 0); NRM_LOAD(1, 1); NRM_LOAD(2, 2);
        for (int c4 = 0; c4 < 8; c4 += 4) {
#pragma unroll
            for (int sl = 0; sl < 4; ++sl) {
                const int c = c4 + sl;
                LAS char* bufp = cb + (sl & 1) * CBUF;
                if (c + 3 < 8) NRM_LOAD(c + 3, (sl + 3) & 3);
#pragma unroll
                for (int j = 0; j < 4; ++j) *(LAS u32x4n*)(bufp + OB_HI + (prow + 16 * j) * CP + pc16 * 16) = rg[sl][j];
                *(LAS u32x4n*)(bufp + OA_HI + prow * CP + pc16 * 16) = rg[sl][4]; *(LAS u32x4n*)(bufp + OA_HI + (prow + 16) * CP + pc16 * 16) = rg[sl][5];
                __syncthreads();
#pragma unroll
                for (int kk = 0; kk < 2; ++kk) {
                    const int ko = (16 * (2 * w + kk) + 8 * h) * 2;
                    const bf16x8 aq = *(const LAS bf16x8*)(bufp + OA_HI + r * CP + ko);
                    const bf16x8 b0 = *(const LAS bf16x8*)(bufp + OB_HI + r * CP + ko), b1 = *(const LAS bf16x8*)(bufp + OB_HI + (32 + r) * CP + ko);
                    acc[0] = __builtin_amdgcn_mfma_f32_32x32x16_bf16(aq, b0, acc[0], 0, 0, 0);
                    acc[1] = __builtin_amdgcn_mfma_f32_32x32x16_bf16(aq, b1, acc[1], 0, 0, 0);
                }
            }
        }
        __syncthreads();
#undef NRM_LOAD
    }
#pragma unroll
    for (int g = 0; g < 2; ++g)
#pragma unroll
        for (int i = 0; i < 16; ++i) red[((g * 8 + w) * 16 + i) * 64 + lane] = acc[g][i];
    __syncthreads();
#pragma unroll
    for (int j = 0; j < 4; ++j) {
        const int idx = tid + NTHR * j, g = idx >> 10, i = (idx >> 6) & 15, ln = idx & 63;
        float v = 0.f;
#pragma unroll
        for (int ww = 0; ww < 8; ++ww) v += red[((g * 8 + ww) * 16 + i) * 64 + ln];
        const int e = (i & 3) + 8 * (i >> 2) + 4 * (ln >> 5);
        fin[(g * 32 + e) * 33 + (ln & 31)] = v;
    }
    __syncthreads();
    if (which) SUBSTAMP(13);
    if (!which) {
        for (int idx = tid; idx < 64 * 24; idx += NTHR) { const int row = idx / 24, e = idx % 24; p.proj[(size_t)(R0 + row) * LDP + OFF_GD + e] = f2bf(fin[((row >> 5) * 32 + e) * 33 + (row & 31)]); }
    } else {
        int* lcnt = (int*)(fin + 2 * 32 * 33);
        if (tid < 64) lcnt[tid] = 0;
        __syncthreads();
        int cls = 0, rank = 0;
        if (tid < 64) {
            float lg[16];
#pragma unroll
            for (int e = 0; e < 16; ++e) lg[e] = fin[((tid >> 5) * 32 + e) * 33 + (tid & 31)];
            cls = route_token(p, l, R0 + tid, lg);
            rank = atomicAdd(&lcnt[cls], 1);
        }
        __syncthreads();
        if (tid < NCLS) { const int c = lcnt[tid]; lcnt[32 + tid] = c ? (int)atomicAdd(p.ctl + CTL_CNT + l * 32 + tid, (unsigned)c) : 0; }
        __syncthreads();
        if (tid < 64) p.cls_tok[(size_t)cls * CLS_CAP + lcnt[32 + cls] + rank] = R0 + tid;
    }
    __syncthreads();
}

DI void cls_experts(int cls, int& ea, int& eb) {
    const int g = cls / 6, pi = cls % 6;
    const int a = pi < 3 ? 0 : (pi < 5 ? 1 : 2);
    const int b = pi < 3 ? pi + 1 : (pi < 5 ? pi - 1 : 3);
    ea = g * 4 + a; eb = g * 4 + b;
}
DI bool cls_find(unsigned* cnt, int ft, int& cls, int& mt, int& slot_base) {
    int base = 0;
    for (int c = 0; c < NCLS; ++c) {
        const int nt = ((int)__hip_atomic_load(cnt + c, __ATOMIC_RELAXED, __HIP_MEMORY_SCOPE_AGENT) + 255) >> 8;
        if (ft < base + nt) { cls = c; mt = ft - base; slot_base = base * 256; return true; }
        base += nt;
    }
    return false;
}
DI int cls_total_tiles(unsigned* cnt) { int base = 0; for (int c = 0; c < NCLS; ++c) base += ((int)__hip_atomic_load(cnt + c, __ATOMIC_RELAXED, __HIP_MEMORY_SCOPE_AGENT) + 255) >> 8; return base; }

constexpr int N_KMEAN_GROUPS = 4 * 8 * 4;
DI void phase_kmean_group(const P& p, int g, float* lds) {
    typedef unsigned u32x4n __attribute__((ext_vector_type(4)));
    const int tid = tidx(), pc = tid & 7, ri = tid >> 3;
    const int item0 = g * 4, b = item0 / 128, h = (item0 / 16) % 8, blk0 = item0 % 16;
    const bf16_t* k = p.proj + ((size_t)b * S + blk0 * 256 + ri) * LDP + OFF_KC + h * 64 + pc * 8;
    u32x4n v[16];
#pragma unroll
    for (int j = 0; j < 16; ++j) v[j] = *(const u32x4n*)(k + (size_t)(j * 64) * LDP);
#pragma unroll
    for (int it = 0; it < 4; ++it) {
        float a[8];
#pragma unroll
        for (int e = 0; e < 8; ++e) a[e] = 0.f;
#pragma unroll
        for (int jj = 0; jj < 4; ++jj) {
            const u32x4n x = v[it * 4 + jj];
            a[0] += __uint_as_float(x.x << 16); a[1] += __uint_as_float(x.x & 0xffff0000u); a[2] += __uint_as_float(x.y << 16); a[3] += __uint_as_float(x.y & 0xffff0000u);
            a[4] += __uint_as_float(x.z << 16); a[5] += __uint_as_float(x.z & 0xffff0000u); a[6] += __uint_as_float(x.w << 16); a[7] += __uint_as_float(x.w & 0xffff0000u);
        }
        float* dst = lds + (it * 64 + ri) * 64 + pc * 8;
        *(float4*)dst = make_float4(a[0], a[1], a[2], a[3]); *(float4*)(dst + 4) = make_float4(a[4], a[5], a[6], a[7]);
    }
    __syncthreads();
    if (tid < 256) {
        const int it = tid >> 6, d = tid & 63;
        float sum = 0.f;
#pragma unroll 8
        for (int q = 0; q < 64; ++q) sum += lds[(it * 64 + q) * 64 + d];
        p.kmean[(size_t)(item0 + it) * 64 + d] = sum * (1.f / 256.f);
    }
    __syncthreads();
}
namespace fa { DI unsigned cvtpk(float lo, float hi); typedef float f32x16 __attribute__((ext_vector_type(16))); DI void store_o(bf16_t* orow, int h, const f32x16 (&o)[2], float inv); }
constexpr int N_CMP_ITEMS = 2 * 64;
DI void phase_cmp_item(const P& p, int l, int item, float* lds) {
    typedef short bf16x8 __attribute__((ext_vector_type(8)));
    typedef float f32x16 __attribute__((ext_vector_type(16)));
    typedef unsigned u32x4n __attribute__((ext_vector_type(4)));
    typedef float f32x4n __attribute__((ext_vector_type(4)));
    typedef __attribute__((address_space(3))) char LC;
    const int tid = tidx(), w = __builtin_amdgcn_readfirstlane(tid >> 6), lane = tid & 63, r = lane & 31, h = lane >> 5;
    const int v = item >> 6, rb = item & 63;
    int R = rb * 32 + r; const bool valid = R < 2040; if (!valid) R = 2039;
    const int b = R / 510, hk = (R / 255) & 1, n = R % 255;
    constexpr int CP = 272, OA = 0, OBX = 128 * CP;
    LC* cb = (LC*)lds;
    const int prow = tid >> 4, pc16 = tid & 15;
    int PR = rb * 32 + prow; if (PR >= 2040) PR = 2039;
    const int pb = PR / 510, phk = (PR / 255) & 1, pn = PR % 255;
    const bf16_t* xsrc = p.proj + ((size_t)pb * S + 16 * pn + (pc16 >> 3)) * LDP + (v ? OFF_VDC : OFF_KDC) + phk * 64 + (pc16 & 7) * 8;
    const int peo = (pc16 >> 3) * 64 + (pc16 & 7) * 8;
    const bf16_t* w1s = p.cw1T + (size_t)(l * 2 + v) * 128 * 2048 + (size_t)prow * 2048 + pc16 * 8;
    constexpr int OPE = 160 * CP;
    { const float* pe = p.in[v ? 11 : 10] + (size_t)l * 2048; *(__attribute__((address_space(3))) f32x4n*)(cb + OPE + tid * 16) = *(const f32x4n*)(pe + tid * 4); }
    u32x4n ra[4][4], rx[4];
#define CMP_LOAD(c, sl) do { \
    _Pragma("unroll") for (int j = 0; j < 4; ++j) ra[sl][j] = *(const u32x4n*)(w1s + (size_t)(32 * j) * 2048 + (c) * 128); \
    rx[sl] = *(const u32x4n*)(xsrc + (size_t)(2 * (c)) * LDP); } while (0)
    CMP_LOAD(0, 0); CMP_LOAD(1, 1); CMP_LOAD(2, 2);
    __syncthreads();
    f32x16 acc[4];
#pragma unroll
    for (int hb = 0; hb < 4; ++hb)
#pragma unroll
        for (int i = 0; i < 16; ++i) acc[hb][i] = 0.f;
    const int ko = (16 * w + 8 * h) * 2;
    for (int c4 = 0; c4 < 16; c4 += 4) {
#pragma unroll
        for (int sl = 0; sl < 4; ++sl) {
            const int c = c4 + sl;
            if (c + 3 < 16) CMP_LOAD(c + 3, (sl + 3) & 3);
#pragma unroll
            for (int j = 0; j < 4; ++j) *(__attribute__((address_space(3))) u32x4n*)(cb + OA + (prow + 32 * j) * CP + pc16 * 16) = ra[sl][j];
            {
                const u32x4n xa = rx[sl]; const f32x4n p0 = *(const __attribute__((address_space(3))) f32x4n*)(cb + OPE + (peo + c * 128) * 4), p1 = *(const __attribute__((address_space(3))) f32x4n*)(cb + OPE + (peo + c * 128 + 4) * 4);
                u32x4n xb;
                xb.x = fa::cvtpk(__uint_as_float(xa.x << 16) + p0.x, __uint_as_float(xa.x & 0xffff0000u) + p0.y);
                xb.y = fa::cvtpk(__uint_as_float(xa.y << 16) + p0.z, __uint_as_float(xa.y & 0xffff0000u) + p0.w);
                xb.z = fa::cvtpk(__uint_as_float(xa.z << 16) + p1.x, __uint_as_float(xa.z & 0xffff0000u) + p1.y);
                xb.w = fa::cvtpk(__uint_as_float(xa.w << 16) + p1.z, __uint_as_float(xa.w & 0xffff0000u) + p1.w);
                *(__attribute__((address_space(3))) u32x4n*)(cb + OBX + prow * CP + pc16 * 16) = xb;
            }
            __syncthreads();
            const bf16x8 xf = *(const __attribute__((address_space(3))) bf16x8*)(cb + OBX + r * CP + ko);
#pragma unroll
            for (int hb = 0; hb < 4; ++hb) {
                const bf16x8 wa = *(const __attribute__((address_space(3))) bf16x8*)(cb + OA + (hb * 32 + r) * CP + ko);
                acc[hb] = __builtin_amdgcn_mfma_f32_32x32x16_bf16(wa, xf, acc[hb], 0, 0, 0);
            }
            __syncthreads();
        }
    }
#undef CMP_LOAD
    float* red = lds;
#pragma unroll
    for (int hb = 0; hb < 4; ++hb)
#pragma unroll
        for (int i = 0; i < 16; ++i) red[((w * 4 + hb) * 16 + i) * 64 + lane] = acc[hb][i];
    __syncthreads();
    f32x16 o[2];
    if (w < 4) {
        f32x16 hsum;
#pragma unroll
        for (int i = 0; i < 16; ++i) { float t = 0.f;
#pragma unroll
            for (int ww = 0; ww < 8; ++ww) t += red[((ww * 4 + w) * 16 + i) * 64 + lane];
            hsum[i] = gelu_tanh(t); o[0][i] = 0.f; o[1][i] = 0.f; }
        const bf16_t* w2 = p.cw2T + (size_t)(l * 2 + v) * 64 * 128 + (size_t)r * 128 + 4 * h;
#pragma unroll
        for (int s2 = 0; s2 < 2; ++s2) {
            uint4 pk;
            pk.x = fa::cvtpk(hsum[8 * s2], hsum[8 * s2 + 1]); pk.y = fa::cvtpk(hsum[8 * s2 + 2], hsum[8 * s2 + 3]); pk.z = fa::cvtpk(hsum[8 * s2 + 4], hsum[8 * s2 + 5]); pk.w = fa::cvtpk(hsum[8 * s2 + 6], hsum[8 * s2 + 7]);
            const bf16x8 pb = __builtin_bit_cast(bf16x8, pk);
#pragma unroll
            for (int dh = 0; dh < 2; ++dh) {
                const bf16_t* wp = w2 + (size_t)dh * 32 * 128 + w * 32 + 16 * s2;
                const uint2 lo = *(const uint2*)wp, hi = *(const uint2*)(wp + 8);
                uint4 wv; wv.x = lo.x; wv.y = lo.y; wv.z = hi.x; wv.w = hi.y;
                o[dh] = __builtin_amdgcn_mfma_f32_32x32x16_bf16(__builtin_bit_cast(bf16x8, wv), pb, o[dh], 0, 0, 0);
            }
        }
    }
    __syncthreads();
    if (w < 4) {
#pragma unroll
        for (int dh = 0; dh < 2; ++dh)
#pragma unroll
            for (int i = 0; i < 16; ++i) red[((w * 2 + dh) * 16 + i) * 64 + lane] = o[dh][i];
    }
    __syncthreads();
    if (w == 0) {
#pragma unroll
        for (int dh = 0; dh < 2; ++dh)
#pragma unroll
            for (int i = 0; i < 16; ++i) o[dh][i] = (red[((0 * 2 + dh) * 16 + i) * 64 + lane] + red[((1 * 2 + dh) * 16 + i) * 64 + lane]) + (red[((2 * 2 + dh) * 16 + i) * 64 + lane] + red[((3 * 2 + dh) * 16 + i) * 64 + lane]);
        if (valid) fa::store_o((v ? p.vc : p.kc) + (((size_t)b * 2 + hk) * 256 + n) * 64, h, o, 1.f);
    }
    __syncthreads();
}


template <class C>
DI float attn_wave(const bf16_t* qrow, const C& cand, int ncand, bool has_sink, float sink, float* sl, float& lse_out) {
    const int lane = tidx() & 63;
    float q[64];
#pragma unroll
    for (int i = 0; i < 8; ++i) {
        const uint4 v = *(const uint4*)(qrow + i * 8);
        const unsigned u[4] = {v.x, v.y, v.z, v.w};
#pragma unroll
        for (int j = 0; j < 4; ++j) { q[i * 8 + 2 * j] = __uint_as_float(u[j] << 16); q[i * 8 + 2 * j + 1] = __uint_as_float(u[j] & 0xffff0000u); }
    }
    float mx = NEGF;
    for (int c0 = 0; c0 < ncand; c0 += 64) {
        const int c = c0 + lane;
        float s = NEGF;
        if (c < ncand) {
            const bf16_t *kr, *vr; float bias;
            if (cand.get(c, kr, vr, bias)) {
                float dot = 0.f;
#pragma unroll
                for (int i = 0; i < 8; ++i) {
                    const uint4 v = *(const uint4*)(kr + i * 8);
                    const unsigned u[4] = {v.x, v.y, v.z, v.w};
#pragma unroll
                    for (int j = 0; j < 4; ++j) { dot += q[i * 8 + 2 * j] * __uint_as_float(u[j] << 16); dot += q[i * 8 + 2 * j + 1] * __uint_as_float(u[j] & 0xffff0000u); }
                }
                s = dot * 0.125f + bias;
            }
            sl[c] = s;
        }
        mx = fmaxf(mx, s);
    }
    mx = wave_max(mx);
    if (has_sink) mx = fmaxf(mx, sink);
    float sum = 0.f;
    for (int c0 = 0; c0 < ncand; c0 += 64) {
        const int c = c0 + lane;
        if (c < ncand) { const float s = sl[c]; const float e = (s > -1e29f) ? __expf(s - mx) : 0.f; sl[c] = e; sum += e; }
    }
    sum = wave_sum(sum);
    if (has_sink) sum += __expf(sink - mx);
    sum = fmaxf(sum, 1.17549435e-38f);
    lse_out = mx + logf(sum);
    const float inv = 1.f / sum;
    for (int c0 = 0; c0 < ncand; c0 += 64) { const int c = c0 + lane; if (c < ncand) sl[c] *= inv; }
    wave_lds_sync();
    float o = 0.f;
    for (int c = 0; c < ncand; ++c) {
        const float pr = sl[c];
        if (pr != 0.f) { const bf16_t *kr, *vr; float bias; cand.get(c, kr, vr, bias); o += pr * bf2f(vr[lane]); }
    }
    return o;
}

struct BandCand {
    const bf16_t *kb, *vb; int t, r; const float* tab;
    DI bool get(int c, const bf16_t*& kr, const bf16_t*& vr, float& bias) const {
        const int kp = t - c * r; if (kp < 0) return false;
        kr = kb + (size_t)kp * LDP; vr = vb + (size_t)kp * LDP; bias = tab[t5_bucket(c * r) * 32]; return true;
    }
};
struct MobaCand {
    const bf16_t *kb, *vb; int t; const int* sel; const float* tab;
    DI bool get(int c, const bf16_t*& kr, const bf16_t*& vr, float& bias) const {
        const int blk = sel[c >> 8], j = c & 255;
        if (blk < 0) return false;
        const int kp = blk * 256 + j; if (kp > t) return false;
        kr = kb + (size_t)kp * LDP; vr = vb + (size_t)kp * LDP; bias = tab[t5_bucket(t - kp) * 32]; return true;
    }
};
struct CmpCand {
    const bf16_t *kc, *vc; int t;
    DI bool get(int c, const bf16_t*& kr, const bf16_t*& vr, float& bias) const {
        if (16 * c + 31 > t) return false;
        kr = kc + (size_t)c * 64; vr = vc + (size_t)c * 64; bias = 0.f; return true;
    }
};
struct SlcCand {
    const bf16_t *kb, *vb; int t; const int* sel; const float* tab;
    DI bool get(int c, const bf16_t*& kr, const bf16_t*& vr, float& bias) const {
        const int blk = sel[c >> 6]; if (blk < 0) return false;
        const int kp = blk * 64 + (c & 63); if (kp > t) return false;
        kr = kb + (size_t)kp * LDP; vr = vb + (size_t)kp * LDP; bias = tab[t5_bucket(t - kp) * 32]; return true;
    }
};

constexpr int N_ATT_WAVE_ITEMS = 3 * T * 8 + T * 8 + T * 8;
DI void phase_attn_wave_item(const P& p, int l, int item, float* sl, int* selw) {
    const int lane = tidx() & 63;
    const float* relb = p.in[2];
    if (item < 3 * T * 8) {
        const int cfg = item / (T * 8), rem = item % (T * 8), row = rem >> 3, h = rem & 7, b = row / S, t = row % S;
        const int r = cfg == 0 ? 1 : (cfg == 1 ? 4 : 16);
        BandCand cd{p.proj + (size_t)b * S * LDP + OFF_KA + h * 64, p.proj + (size_t)b * S * LDP + OFF_VA + h * 64, t, r, relb + 0 + h};
        float lse;
        const float o = attn_wave(p.proj + (size_t)row * LDP + OFF_QA + h * 64, cd, 129, false, 0.f, sl, lse);
        p.oA[((size_t)cfg * T + row) * 512 + h * 64 + lane] = f2bf(o);
        if (lane == 0) p.lseA[((size_t)cfg * T + row) * 8 + h] = lse;
        return;
    }
    item -= 3 * T * 8;
    if (item < T * 8) {
        const int row = item >> 3, hq = item & 7, kvh = hq >> 2, b = row / S, t = row % S;
        BandCand cd{p.proj + (size_t)b * S * LDP + OFF_KB + kvh * 64, p.proj + (size_t)b * S * LDP + OFF_VB + kvh * 64, t, 1, relb + 8 + hq};
        float lse;
        const float o = attn_wave(p.proj + (size_t)row * LDP + OFF_QB + hq * 64, cd, 128, true, p.in[16][l * 8 + hq], sl, lse);
        p.oB[(size_t)row * 512 + hq * 64 + lane] = f2bf(o);
        return;
    }
    item -= T * 8;
    {
        const int row = item >> 3, h = item & 7, b = row / S, t = row % S, cur = t >> 8;
        const bf16_t* qrow = p.proj + (size_t)row * LDP + OFF_QC + h * 64;
        float gate = NEGF;
        if (lane < cur) {
            const float* km = p.kmean + (((size_t)b * 8 + h) * 16 + lane) * 64;
            float dot = 0.f;
            for (int d = 0; d < 64; ++d) dot += bf2f(qrow[d]) * km[d];
            gate = dot;
        }
        int s0, s1, s2;
        { float v = gate; int idx = lane;
          for (int o = 32; o > 0; o >>= 1) { const float ov = __shfl_xor(v, o); const int oi = __shfl_xor(idx, o); if (ov > v || (ov == v && oi < idx)) { v = ov; idx = oi; } }
          s0 = (v > -1e29f) ? idx : -1; if (lane == idx) gate = -3e38f; }
        { float v = gate; int idx = lane;
          for (int o = 32; o > 0; o >>= 1) { const float ov = __shfl_xor(v, o); const int oi = __shfl_xor(idx, o); if (ov > v || (ov == v && oi < idx)) { v = ov; idx = oi; } }
          s1 = (v > -1e29f) ? idx : -1; if (lane == idx) gate = -3e38f; }
        { float v = gate; int idx = lane;
          for (int o = 32; o > 0; o >>= 1) { const float ov = __shfl_xor(v, o); const int oi = __shfl_xor(idx, o); if (ov > v || (ov == v && oi < idx)) { v = ov; idx = oi; } }
          s2 = (v > -1e29f) ? idx : -1; if (lane == idx) gate = -3e38f; }
        if (lane == 0) { selw[0] = s0; selw[1] = s1; selw[2] = s2; selw[3] = cur; }
        wave_lds_sync();
        MobaCand cd{p.proj + (size_t)b * S * LDP + OFF_KC + h * 64, p.proj + (size_t)b * S * LDP + OFF_VC + h * 64, t, selw, relb + 16 + h};
        float lse;
        const float o = attn_wave(qrow, cd, 1024, false, 0.f, sl, lse);
        p.oC[(size_t)row * 512 + h * 64 + lane] = f2bf(o);
    }
}
constexpr int N_NSA_ITEMS = 4 * 2 * S;
DI void phase_nsa_item(const P& p, int l, int item0, float* lds) {
    const int tid = tidx(), grp = tid >> 8, g = (tid >> 6) & 3, lane = tid & 63;
    const int item = item0 + grp;
    const int b = item / (2 * S), hk = (item / S) % 2, t = item % S, hq = hk * 4 + g;
    const int row = b * S + t, cur = t >> 6;
    float* gl = lds + grp * 4096;
    float* sl = gl + g * 1024;
    int* sel = (int*)(lds + 8192) + grp * 16;
    const bf16_t* qrow = p.proj + (size_t)row * LDP + OFF_QD + hq * 64;
    const float* relb = p.in[2];
    float lse;
    CmpCand cc{p.kc + ((size_t)b * 2 + hk) * 256 * 64, p.vc + ((size_t)b * 2 + hk) * 256 * 64, t};
    const float o_cmp = attn_wave(qrow, cc, 255, false, 0.f, sl, lse);
    __syncthreads();
    if (g == 0) {
        const int j = lane;
        float imp = 0.f;
        for (int n = 4 * j - 1; n <= 4 * j + 3; ++n)
            if (n >= 0 && n < 255) imp += gl[n] + gl[1024 + n] + gl[2048 + n] + gl[3072 + n];
        float val = (j == 0 || j == cur || j == cur - 1) ? 1e30f : (j <= cur ? imp : NEGF);
        for (int k = 0; k < 16; ++k) {
            float v = val; int idx = lane;
            for (int o = 32; o > 0; o >>= 1) { const float ov = __shfl_xor(v, o); const int oi = __shfl_xor(idx, o); if (ov > v || (ov == v && oi < idx)) { v = ov; idx = oi; } }
            if (lane == 0) sel[k] = (v > -1e29f) ? idx : -1;
            if (lane == idx) val = -3e38f;
        }
    }
    __syncthreads();
    SlcCand sc{p.proj + (size_t)b * S * LDP + OFF_KDS + hk * 64, p.proj + (size_t)b * S * LDP + OFF_VDS + hk * 64, t, sel, relb + 24 + hq};
    const float o_slc = attn_wave(qrow, sc, 1024, false, 0.f, sl, lse);
    BandCand wc{p.proj + (size_t)b * S * LDP + OFF_KDW + hk * 64, p.proj + (size_t)b * S * LDP + OFF_VDW + hk * 64, t, 1, relb + 24 + hq};
    const float o_win = attn_wave(qrow, wc, 512, false, 0.f, sl, lse);
    const bf16_t* gd = p.proj + (size_t)row * LDP + OFF_GD + hq * 3;
    const float g0 = sigmoidf_(bf2f(gd[0])), g1 = sigmoidf_(bf2f(gd[1])), g2 = sigmoidf_(bf2f(gd[2]));
    p.oD[(size_t)row * 512 + hq * 64 + lane] = f2bf(g0 * o_cmp + g1 * o_slc + g2 * o_win);
    __syncthreads();
}

constexpr int N_MIXN_WAVE_ITEMS = T;
struct MixIn { float l0, l1, l2; uint4 a0, a1, a2, q0, q1, q2; };
DI void mixnorm_load(const P& p, int row, MixIn& in) {
    const int lane = tidx() & 63, h = lane >> 3;
    in.l0 = p.lseA[((size_t)0 * T + row) * 8 + h]; in.l1 = p.lseA[((size_t)1 * T + row) * 8 + h]; in.l2 = p.lseA[((size_t)2 * T + row) * 8 + h];
    in.a0 = *(const uint4*)(p.oA + ((size_t)0 * T + row) * 512 + lane * 8);
    in.a1 = *(const uint4*)(p.oA + ((size_t)1 * T + row) * 512 + lane * 8);
    in.a2 = *(const uint4*)(p.oA + ((size_t)2 * T + row) * 512 + lane * 8);
    in.q0 = *(const uint4*)(p.oB + (size_t)row * 512 + lane * 8); in.q1 = *(const uint4*)(p.oC + (size_t)row * 512 + lane * 8); in.q2 = *(const uint4*)(p.oD + (size_t)row * 512 + lane * 8);
}
DI void mixnorm_finish(const P& p, int row, const MixIn& in) {
    const int lane = tidx() & 63;
    const float l0 = in.l0, l1 = in.l1, l2 = in.l2;
    const uint4 a0 = in.a0, a1 = in.a1, a2 = in.a2;
    const uint4 gq[3] = {in.q0, in.q1, in.q2};
    float v[4][8];
    {
        const float m = fmaxf(l0, fmaxf(l1, l2));
        float w0 = __expf(l0 - m), w1 = __expf(l1 - m), w2 = __expf(l2 - m);
        const float inv = 1.f / (w0 + w1 + w2); w0 *= inv; w1 *= inv; w2 *= inv;
        const unsigned au[4] = {a0.x, a0.y, a0.z, a0.w}, bu[4] = {a1.x, a1.y, a1.z, a1.w}, cu[4] = {a2.x, a2.y, a2.z, a2.w};
#pragma unroll
        for (int j = 0; j < 4; ++j) {
            v[0][2 * j] = w0 * __uint_as_float(au[j] << 16) + w1 * __uint_as_float(bu[j] << 16) + w2 * __uint_as_float(cu[j] << 16);
            v[0][2 * j + 1] = w0 * __uint_as_float(au[j] & 0xffff0000u) + w1 * __uint_as_float(bu[j] & 0xffff0000u) + w2 * __uint_as_float(cu[j] & 0xffff0000u);
        }
    }
#pragma unroll
    for (int g = 0; g < 3; ++g) {
        const unsigned au[4] = {gq[g].x, gq[g].y, gq[g].z, gq[g].w};
#pragma unroll
        for (int j = 0; j < 4; ++j) { v[g + 1][2 * j] = __uint_as_float(au[j] << 16); v[g + 1][2 * j + 1] = __uint_as_float(au[j] & 0xffff0000u); }
    }
    float ss[4];
#pragma unroll
    for (int g = 0; g < 4; ++g) { ss[g] = 0.f;
#pragma unroll
        for (int j = 0; j < 8; ++j) ss[g] += v[g][j] * v[g][j]; }
#pragma unroll
    for (int g = 0; g < 4; ++g) ss[g] = wave_sum_dpp(ss[g]);
#pragma unroll
    for (int g = 0; g < 4; ++g) {
        const float r = rsqrtf(ss[g] * (1.f / 512.f) + EPS);
        uint4 o;
        o.x = (unsigned)f2bf(v[g][0] * r) | ((unsigned)f2bf(v[g][1] * r) << 16);
        o.y = (unsigned)f2bf(v[g][2] * r) | ((unsigned)f2bf(v[g][3] * r) << 16);
        o.z = (unsigned)f2bf(v[g][4] * r) | ((unsigned)f2bf(v[g][5] * r) << 16);
        o.w = (unsigned)f2bf(v[g][6] * r) | ((unsigned)f2bf(v[g][7] * r) << 16);
        *(uint4*)(p.hbuf + (size_t)row * D + g * 512 + lane * 8) = o;
    }
}
DI void phase_mixnorm(const P& p, int first, int step) {
    int it = first;
    MixIn cur;
    if (it < N_MIXN_WAVE_ITEMS) mixnorm_load(p, it, cur);
    while (it < N_MIXN_WAVE_ITEMS) {
        const int nx = it + step;
        MixIn nxt = cur;
        if (nx < N_MIXN_WAVE_ITEMS) mixnorm_load(p, nx, nxt);
        mixnorm_finish(p, it, cur);
        cur = nxt; it = nx;
    }
}

DI void phase_final(const P& p, int first, int step, bool poison) {
    const int lane = tidx() & 63;
    float4 g[8];
#pragma unroll
    for (int i = 0; i < 8; ++i) g[i] = *(const float4*)(p.in[22] + i * 256 + lane * 4);
    int it = first;
    uint2 rv[8];
    if (it < T) {
#pragma unroll
        for (int i = 0; i < 8; ++i) rv[i] = *(const uint2*)(p.xres + (size_t)it * D + i * 256 + lane * 4);
    }
    while (it < T) {
        const int nx = it + step;
        uint2 rn[8];
#pragma unroll
        for (int i = 0; i < 8; ++i) rn[i] = rv[i];
        if (nx < T) {
#pragma unroll
            for (int i = 0; i < 8; ++i) rn[i] = *(const uint2*)(p.xres + (size_t)nx * D + i * 256 + lane * 4);
        }
        float4 v[8];
        float ss = 0.f;
#pragma unroll
        for (int i = 0; i < 8; ++i) { v[i] = make_float4(__uint_as_float(rv[i].x << 16), __uint_as_float(rv[i].x & 0xffff0000u), __uint_as_float(rv[i].y << 16), __uint_as_float(rv[i].y & 0xffff0000u));
            ss += v[i].x * v[i].x + v[i].y * v[i].y + v[i].z * v[i].z + v[i].w * v[i].w; }
        ss = wave_sum_dpp(ss);
        const float r = rsqrtf(ss * (1.f / D) + EPS);
#pragma unroll
        for (int i = 0; i < 8; ++i) {
            float4 o; o.x = v[i].x * r * g[i].x; o.y = v[i].y * r * g[i].y; o.z = v[i].z * r * g[i].z; o.w = v[i].w * r * g[i].w;
            if (poison) { o.x = o.y = o.z = o.w = __uint_as_float(0x7fc00000u); }
            *(float4*)(p.out + (size_t)it * D + i * 256 + lane * 4) = o;
        }
#pragma unroll
        for (int i = 0; i < 8; ++i) rv[i] = rn[i];
        it = nx;
    }
}

#define XB_TMO      128
#define XB_XCNT(j)  (256  + 64 * (j))
#define XB_XSUB(j)  (1280 + 64 * (j))
#define XB_XGEN(j)  (2304 + 64 * (j))
#define XB_TOP      3328
#define XB_TOPGEN   3392
#define XCD_BAR_WORDS 3456
#define XB_SPIN_CAP (1u << 21)

__device__ __forceinline__ unsigned xb_ld(unsigned* p)              { return __hip_atomic_load(p, __ATOMIC_RELAXED, __HIP_MEMORY_SCOPE_AGENT); }
__device__ __forceinline__ unsigned xb_add(unsigned* p, unsigned v) { return __hip_atomic_fetch_add(p, v, __ATOMIC_RELAXED, __HIP_MEMORY_SCOPE_AGENT); }
__device__ __forceinline__ unsigned xb_xcc_id() { return (unsigned)__builtin_amdgcn_s_getreg((3 << 11) | 20) & 0xFu; }
#define XB_SPIN(cond, bar) do { unsigned _sp = 0; while (cond) { __builtin_amdgcn_s_sleep(1); \
    if ((++_sp & 255u) == 0u) { if (xb_ld(&(bar)[XB_TMO])) break; if (_sp > XB_SPIN_CAP) { atomicAdd(&(bar)[XB_TMO], 1u); break; } } } } while (0)

struct XcdBarrier { unsigned* bar; unsigned x; volatile LAS unsigned* st; };

__device__ __forceinline__ XcdBarrier xcd_barrier_post(unsigned* bar, volatile LAS unsigned* st) {
    XcdBarrier b; b.bar = bar; b.x = xb_xcc_id(); b.st = st;
    if (threadIdx.x == 0) (void)xb_add(&bar[XB_XCNT(b.x)], 1u);
    return b;
}
__device__ __forceinline__ void xcd_barrier_complete(unsigned* bar, unsigned x, unsigned& nloc, unsigned& nx) {
    const unsigned G = gridDim.x * gridDim.y * gridDim.z;
    unsigned sum, cnt, mine, sp = 0u;
    for (;;) {
        sum = 0u; cnt = 0u; mine = 0u;
#pragma unroll
        for (unsigned j = 0; j < 16; ++j) { const unsigned c = xb_ld(&bar[XB_XCNT(j)]); sum += c; cnt += (c > 0u) ? 1u : 0u; mine = (j == x) ? c : mine; }
        if (sum == G) break;
        __builtin_amdgcn_s_sleep(1);
        if ((++sp & 255u) == 0u) { if (xb_ld(&bar[XB_TMO])) break; if (sp > XB_SPIN_CAP) { atomicAdd(&bar[XB_TMO], 1u); break; } }
    }
    nloc = mine > 0u ? mine : 1u; nx = cnt > 0u ? cnt : 1u;
}
__device__ __forceinline__ void xcd_barrier(const XcdBarrier& b) {
    asm volatile("s_waitcnt vmcnt(0)" ::: "memory");
    __syncthreads();
    if (threadIdx.x == 0) {
        unsigned* bar = b.bar;
        __builtin_amdgcn_s_waitcnt(0);
        unsigned nloc = b.st[0], nx = b.st[1];
        if (nloc == 0u) { xcd_barrier_complete(bar, b.x, nloc, nx); b.st[0] = nloc; b.st[1] = nx; }
        const unsigned old = xb_add(&bar[XB_XSUB(b.x)], 1u);
        const unsigned gen = old / nloc;
        if (old + 1u == (gen + 1u) * nloc) {
            __builtin_amdgcn_fence(__ATOMIC_RELEASE, "agent");
            asm volatile("s_waitcnt vmcnt(0)" ::: "memory");
            const unsigned og = xb_add(&bar[XB_TOP], 1u);
            const unsigned tg = og / nx;
            if (og + 1u == (tg + 1u) * nx) xb_add(&bar[XB_TOPGEN], 1u);
            else XB_SPIN(xb_ld(&bar[XB_TOPGEN]) == tg, bar);
            __builtin_amdgcn_fence(__ATOMIC_ACQUIRE, "agent");
            xb_add(&bar[XB_XGEN(b.x)], 1u);
            asm volatile("s_waitcnt vmcnt(0)" ::: "memory");
        } else {
            XB_SPIN(xb_ld(&bar[XB_XGEN(b.x)]) == gen, bar);
            __builtin_amdgcn_fence(__ATOMIC_ACQUIRE, "agent");
            asm volatile("s_waitcnt vmcnt(0)" ::: "memory");
        }
    }
    __syncthreads();
}

namespace fa {
typedef short bf16x8 __attribute__((ext_vector_type(8)));
typedef short s16x4 __attribute__((ext_vector_type(4)));
typedef float f32x16 __attribute__((ext_vector_type(16)));
typedef __bf16 bf16x2_t __attribute__((ext_vector_type(2)));
typedef float f32x2_t __attribute__((ext_vector_type(2)));
constexpr int KP = 144, TILEB = 64 * KP;
constexpr int BT = 768, TBL = 904;
constexpr int NBUF = 4;
constexpr int L_K = 0, L_V = NBUF * TILEB, L_BT = 2 * NBUF * TILEB, L_B32 = L_BT + 4 * TBL * 4, L_NINF = L_B32 + 512, L_IMPA = L_NINF + 256, L_IMPB = L_IMPA + 64 * 64 * 4, L_SEL = L_IMPB + 64 * 64 * 4, L_TICKET = L_SEL + 512,
              L_OACC = L_IMPA  , L_RELB = L_TICKET + 512  , L_END = L_RELB + 4096;
static_assert(16 * 512 * 4 <= 2 * 64 * 64 * 4, "L_OACC fits the importance arrays");
static_assert(L_END <= 131072, "attention LDS map");
constexpr float LOG2E = 1.4426950408889634f, SC2 = 0.125f * LOG2E, LN2 = 0.6931471805599453f;
#define FA_MFMA(a, b, c) __builtin_amdgcn_mfma_f32_32x32x16_bf16((a), (b), (c), 0, 0, 0)
DI unsigned cvtpk(float lo, float hi) { f32x2_t v = {lo, hi}; bf16x2_t b = __builtin_convertvector(v, bf16x2_t); return __builtin_bit_cast(unsigned, b); }
DI s16x4 vtr(const LAS char* p) { return __builtin_bit_cast(s16x4, __builtin_amdgcn_ds_read_tr16_b64_v4i16((LAS s16x4*)p)); }
DI float xhalf(float v) { return __shfl_xor(v, 32); }
DI float touch(float x) { asm("" : "+v"(x)); return x; }
DI float quad_sum(float v) {
    v += __builtin_bit_cast(float, __builtin_amdgcn_update_dpp(0, __builtin_bit_cast(int, v), 0xB1, 0xF, 0xF, true));
    v += __builtin_bit_cast(float, __builtin_amdgcn_update_dpp(0, __builtin_bit_cast(int, v), 0x4E, 0xF, 0xF, true));
    return v;
}

struct Pass {
    const bf16_t* kb; const bf16_t* vb;
    int kpitch, kstride, nkeys;
    int t_lo, t_hi;
    int W;
    int msh;
};
typedef unsigned u32x4 __attribute__((ext_vector_type(4)));
DI void stage_load(const Pass& ps, int jt, int tid, u32x4& kreg, u32x4& vreg) {
    const int key = tid >> 3, chunk = tid & 7;
    int kidx = jt * 64 + key; kidx = kidx < 0 ? 0 : (kidx >= ps.nkeys ? ps.nkeys - 1 : kidx);
    const size_t off = (size_t)(kidx * ps.kstride) * ps.kpitch + chunk * 8;
    kreg = *(const u32x4*)(ps.kb + off); vreg = *(const u32x4*)(ps.vb + off);
}
DI void stage_store(LAS char* base, int buf, int tid, const u32x4& kreg, const u32x4& vreg) {
    const int key = tid >> 3, chunk = tid & 7;
    *(LAS u32x4*)(base + L_K + buf * TILEB + key * KP + chunk * 16) = kreg;
    *(LAS u32x4*)(base + L_V + buf * TILEB + key * KP + chunk * 16) = vreg;
}
struct Pre { u32x4 k0, v0, k1, v1; };
DI void flash_preload(const Pass& ps, Pre& pr) {
    const int tid = tidx();
    stage_load(ps, ps.t_lo, tid, pr.k0, pr.v0);
    if (ps.t_hi - ps.t_lo > 1) stage_load(ps, ps.t_lo + 1, tid, pr.k1, pr.v1); else { pr.k1 = pr.k0; pr.v1 = pr.v0; }
}
template <int MODE>
DI void flash_pass(LAS char* base, const Pass& ps, const bf16x8 (&qf)[4], int qidx, int tg, unsigned long long selmask, int wq_lo, int wq_hi,
                   f32x16 (&o)[2], float& m, float& l, float pscale, int qloc, const Pre* pre = nullptr) {
    constexpr bool BAND = MODE & 1, MASKED = MODE & 2, BIAS = MODE & 4, STATS = MODE & 8, IMP = MODE & 16;
    const int tid = tidx(), lane = tid & 63, r = lane & 31, h = lane >> 5;
    const int n = ps.t_hi - ps.t_lo;
    if (n <= 0) return;
    u32x4 kreg, vreg;
    {
        Pre pr;
        if (pre) pr = *pre; else flash_preload(ps, pr);
        stage_store(base, 0, tid, pr.k0, pr.v0);
        if (n > 1) stage_store(base, 1, tid, pr.k1, pr.v1);
    }
    __syncthreads();
    const LAS float* bt = (const LAS float*)(base + L_BT) + tg * TBL;
    const LAS float* b32 = (const LAS float*)(base + L_B32) + tg * 32;
    float mr = m > -1e29f ? __builtin_ceilf(m) : 0.f;
    mr = fminf(fmaxf(mr, -256.f), 256.f);
    l *= __builtin_amdgcn_exp2f(m - mr);
    bool refnz = __builtin_amdgcn_ballot_w64(mr != 0.f) != 0ull, resc = false;
    float ovf = 0.f;
    u32x4 kxv; kxv.x = h ? 0u : 0x3F80BF80u; kxv.y = h ? 0u : 0x3F803F80u; kxv.z = 0u; kxv.w = 0u;
    const bf16x8 kx = __builtin_bit_cast(bf16x8, kxv);
    for (int it = 0; it < n; ++it) {
        const int jt = ps.t_lo + it, buf = it & (NBUF - 1);
        if (it + 2 < n) stage_load(ps, jt + 2, tid, kreg, vreg);
        const int k0 = jt * 64;
        bool lane_ok = true;
        if constexpr (MASKED) lane_ok = (selmask >> (jt >> ps.msh)) & 1ull;
        bool need;
        if constexpr (BAND) need = (k0 <= wq_hi) && (k0 + 63 >= wq_lo - ps.W);
        else need = (k0 <= wq_hi);
        if constexpr (MASKED) need = need && (__builtin_amdgcn_ballot_w64(lane_ok) != 0ull);
        if (need) {
            const LAS char* Kt = base + L_K + buf * TILEB; const LAS char* Vt = base + L_V + buf * TILEB;
            const int d0 = qidx - k0 - 4 * h;
            const bool full = BAND ? (wq_hi - k0 <= ps.W && wq_lo - (k0 + 63) >= 0) : (wq_lo - (k0 + 63) >= 0);
            if constexpr (!IMP) {
                if (resc) {
                    const float lt = l + xhalf(l);
                    float d = lt > 1.f ? __builtin_ceilf(__builtin_amdgcn_logf(lt)) : 0.f;
                    d = fminf(d, 256.f - mr);
                    const float alpha = __builtin_amdgcn_exp2f(-d);
                    l *= alpha; mr += d;
                    if constexpr (!STATS) {
#pragma unroll
                        for (int i = 0; i < 16; ++i) { o[0][i] *= alpha; o[1][i] *= alpha; }
                    }
                    refnz = __builtin_amdgcn_ballot_w64(mr != 0.f) != 0ull; resc = false; ovf = 0.f;
                }
            }
            int bmode = 0, t1 = 0x7fffffff; float bv0 = 0.f, bv1 = 0.f; const LAS float* tb = bt;
            if constexpr (BIAS) {
                if ((wq_hi - k0) >= BT) {
                    int dmin = wq_lo - (k0 + 63); dmin = dmin < 0 ? 0 : dmin;
                    const int b0 = 28 + (dmin >= 825) + (dmin >= 1117) + (dmin >= 1513);
                    t1 = b0 == 28 ? 825 : (b0 == 29 ? 1117 : (b0 == 30 ? 1513 : 0x7fffffff));
                    if (wq_hi - k0 < t1) { bmode = 1; bv0 = b32[b0]; } else { bmode = 2; bv0 = lane_ok ? b32[b0] : -INFINITY; bv1 = lane_ok ? b32[b0 < 31 ? b0 + 1 : 31] : -INFINITY; }
                } else { bmode = 3; tb = lane_ok ? bt + (BT - 1 - d0) : (const LAS float*)(base + L_NINF); }
            }
            f32x16 st[2];
            bf16x8 kf[2][4];
#pragma unroll
            for (int kb = 0; kb < 2; ++kb)
#pragma unroll
                for (int s = 0; s < 4; ++s) kf[kb][s] = *(const LAS bf16x8*)(Kt + (kb * 32 + r) * KP + (2 * s + h) * 16);
            u32x4 qxv; qxv.x = __float_as_uint(mr) >> 16; qxv.y = 0u; qxv.z = 0u; qxv.w = 0u;
            if (bmode == 1) {
                const unsigned b_hi = __float_as_uint(bv0) & 0xffff0000u; const float r1 = bv0 - __uint_as_float(b_hi);
                const unsigned b_mid = __float_as_uint(r1) & 0xffff0000u; const float r2 = r1 - __uint_as_float(b_mid);
                qxv.x |= lane_ok ? b_hi : 0xFF800000u; qxv.y = lane_ok ? ((b_mid >> 16) | (__float_as_uint(r2) & 0xffff0000u)) : 0u;
            }
            if (h) { qxv.x = 0u; qxv.y = 0u; }
            const bool useref = refnz || bmode == 1;
#pragma unroll
            for (int kb = 0; kb < 2; ++kb) {
                if (bmode == 3) {
#pragma unroll
                    for (int i = 0; i < 16; ++i) st[kb][i] = tb[32 * kb + (i & 3) + 8 * (i >> 2)];
                } else if (bmode == 2) {
#pragma unroll
                    for (int i = 0; i < 16; ++i) { const int d = d0 - (32 * kb + (i & 3) + 8 * (i >> 2)); st[kb][i] = (d >= t1) ? bv1 : bv0; }
                } else {
#pragma unroll
                    for (int i = 0; i < 16; ++i) st[kb][i] = 0.f;
                }
            }
            __builtin_amdgcn_s_setprio(1);
#pragma unroll
            for (int kb = 0; kb < 2; ++kb)
#pragma unroll
                for (int s = 0; s < 4; ++s) st[kb] = FA_MFMA(kf[kb][s], qf[s], st[kb]);
            if (useref) {
                const bf16x8 qx = __builtin_bit_cast(bf16x8, qxv);
                st[0] = FA_MFMA(kx, qx, st[0]); st[1] = FA_MFMA(kx, qx, st[1]);
            }
            __builtin_amdgcn_s_setprio(0);
            const int i16 = lane & 15, q = i16 >> 2, pp = i16 & 3, g16 = (lane >> 4) & 1;
            const LAS char* vbase = Vt + (4 * h + q) * KP + g16 * 32 + 8 * pp;
#pragma unroll
            for (int kb = 0; kb < 2; ++kb) {
                if (!full || (MASKED && !BIAS)) {
#pragma unroll
                    for (int i = 0; i < 16; ++i) {
                        const int d = d0 - (32 * kb + (i & 3) + 8 * (i >> 2));
                        bool ok = (MASKED && !BIAS) ? lane_ok : true;
                        if (!full) { if constexpr (BAND) ok = ok && ((unsigned)d <= (unsigned)ps.W); else ok = ok && (d >= 0); }
                        st[kb][i] = ok ? st[kb][i] : -INFINITY;
                    }
                }
                float ls = 0.f;
#pragma unroll
                for (int i = 0; i < 16; ++i) { const float pe = touch(__builtin_amdgcn_exp2f(st[kb][i])); st[kb][i] = pe; ls = touch(ls + pe); }
                l += ls;
                if constexpr (!IMP) ovf = fmaxf(ovf, ls);
                if constexpr (IMP) {
                    LAS float* impA = (LAS float*)(base + L_IMPA) + qloc * 64; LAS float* impB = (LAS float*)(base + L_IMPB) + qloc * 64;
#pragma unroll
                    for (int c4 = 0; c4 < 4; ++c4) {
                        const float s4 = quad_sum((st[kb][4 * c4] + st[kb][4 * c4 + 1]) + (st[kb][4 * c4 + 2] + st[kb][4 * c4 + 3]));
                        const float sp = quad_sum(st[kb][4 * c4 + 3]);
                        const int j = 16 * jt + 8 * kb + 2 * c4 + h;
                        if ((lane & 3) == 0) { impA[j] = s4 * pscale; if (j + 1 < 64) impB[j + 1] = sp * pscale; }
                    }
                }
                if constexpr (!STATS) {
#pragma unroll
                    for (int s = 0; s < 2; ++s) {
                        uint4 pk; pk.x = cvtpk(st[kb][8 * s], st[kb][8 * s + 1]); pk.y = cvtpk(st[kb][8 * s + 2], st[kb][8 * s + 3]);
                        pk.z = cvtpk(st[kb][8 * s + 4], st[kb][8 * s + 5]); pk.w = cvtpk(st[kb][8 * s + 6], st[kb][8 * s + 7]);
                        const bf16x8 pf = __builtin_bit_cast(bf16x8, pk);
#pragma unroll
                        for (int dh = 0; dh < 2; ++dh) {
                            const LAS char* va = vbase + (kb * 32 + 16 * s) * KP + dh * 64;
                            const s16x4 lo = vtr(va), hi = vtr(va + 8 * KP);
                            const bf16x8 vf = __builtin_shufflevector(lo, hi, 0, 1, 2, 3, 4, 5, 6, 7);
                            o[dh] = FA_MFMA(vf, pf, o[dh]);
                        }
                    }
                }
            }
            if constexpr (!IMP) { if (__builtin_amdgcn_ballot_w64(ovf > 0x1p40f) != 0ull) resc = true; }
        }
        if (it + 2 < n) stage_store(base, (it + 2) & (NBUF - 1), tid, kreg, vreg);
        if ((it & 1) || it + 1 == n) __syncthreads();
    }
    m = mr;
}
DI void load_q(const bf16_t* qrow, int h, bf16x8 (&qf)[4]) {
#pragma unroll
    for (int s = 0; s < 4; ++s) qf[s] = __builtin_bit_cast(bf16x8, *(const uint4*)(qrow + 16 * s + 8 * h));
}
DI void store_o(bf16_t* orow, int h, const f32x16 (&o)[2], float inv) {
#pragma unroll
    for (int dh = 0; dh < 2; ++dh)
#pragma unroll
        for (int c4 = 0; c4 < 4; ++c4) {
            uint2 pk; pk.x = cvtpk(o[dh][4 * c4] * inv, o[dh][4 * c4 + 1] * inv); pk.y = cvtpk(o[dh][4 * c4 + 2] * inv, o[dh][4 * c4 + 3] * inv);
            *(uint2*)(orow + dh * 32 + 8 * c4 + 4 * h) = pk;
        }
}
DI void build_bias(LAS char* base, const float* relb, int col0, int ng, int dscale) {
    const int tid = tidx();
    LAS float* bt = (LAS float*)(base + L_BT); LAS float* b32 = (LAS float*)(base + L_B32);
    if (tid < ng * 32) { const int g = tid >> 5, bk = tid & 31; b32[tid] = ((const LAS float*)(base + L_RELB))[bk * 32 + col0 + g]; }
    if (tid < 64) ((LAS float*)(base + L_NINF))[tid] = -INFINITY;
    __syncthreads();
    for (int e = tid; e < ng * TBL; e += NTHR) { const int g = e / TBL, j = e % TBL, d = BT - 1 - j; bt[e] = d >= 0 ? b32[g * 32 + t5_bucket(d * dscale)] : 0.f; }
    __syncthreads();
}

DI void item_band(const P& p, LAS char* base, const bf16_t* qb_, int qtok_stride, int q0, const Pass& ps, const float* relb, int col, int dscale,
                  bool has_sink, float sink, bf16_t* ob, float* lse_out  , int lse_stride) {
    const int tid = tidx(), lane = tid & 63, w = __builtin_amdgcn_readfirstlane(tid >> 6), r = lane & 31, h = lane >> 5;
    Pre pre; flash_preload(ps, pre);
    const int qidx = q0 + w * 32 + r;
    bf16x8 qf[4]; load_q(qb_ + (size_t)qidx * qtok_stride * LDP, h, qf);
    build_bias(base, relb, col, 1, dscale);
    f32x16 o[2];
#pragma unroll
    for (int i = 0; i < 16; ++i) { o[0][i] = 0.f; o[1][i] = 0.f; }
    float m = has_sink ? sink * LOG2E : -1e30f, l = (has_sink && h == 0) ? 1.f : 0.f;
    flash_pass<1 | 4>(base, ps, qf, qidx, 0, 0ull, q0 + w * 32, q0 + w * 32 + 31, o, m, l, 1.f, 0, &pre);
    l += xhalf(l);
    const float lt = fmaxf(l, 1.17549435e-38f);
    store_o(ob + (size_t)qidx * qtok_stride * 512, h, o, 1.f / lt);
    if (lse_out && h == 0) lse_out[(size_t)qidx * qtok_stride * lse_stride] = (m + __builtin_amdgcn_logf(lt)) * LN2;
}
DI void item_moba(const P& p, LAS char* base, int b, int hd, int qb) {
    const int tid = tidx(), lane = tid & 63, w = __builtin_amdgcn_readfirstlane(tid >> 6), r = lane & 31, h = lane >> 5;
    const Pass ps{p.proj + (size_t)b * S * LDP + OFF_KC + hd * 64, p.proj + (size_t)b * S * LDP + OFF_VC + hd * 64, LDP, 1, S, 0, 4 * (qb + 1), 0, 2};
    Pre pre; flash_preload(ps, pre);
    const int qidx = qb * 256 + w * 32 + r;
    const size_t row = (size_t)b * S + qidx;
    bf16x8 qf[4]; load_q(p.proj + row * LDP + OFF_QC + hd * 64, h, qf);
    build_bias(base, p.in[2], 16 + hd, 1, 1);
    f32x16 ga;
#pragma unroll
    for (int i = 0; i < 16; ++i) ga[i] = 0.f;
    const float* km = p.kmean + (((size_t)b * 8 + hd) * 16 + (r & 15)) * 64;
#pragma unroll
    for (int s = 0; s < 4; ++s) {
        const float4 a = *(const float4*)(km + 16 * s + 8 * h), c = *(const float4*)(km + 16 * s + 8 * h + 4);
        const float f[8] = {a.x, a.y, a.z, a.w, c.x, c.y, c.z, c.w};
        unsigned hi[4], lo[4];
#pragma unroll
        for (int j = 0; j < 4; ++j) {
            const float x0 = r < 16 ? f[2 * j] : 0.f, x1 = r < 16 ? f[2 * j + 1] : 0.f;
            const unsigned ph = cvtpk(x0, x1); hi[j] = ph;
            lo[j] = cvtpk(x0 - __uint_as_float(ph << 16), x1 - __uint_as_float(ph & 0xffff0000u));
        }
        uint4 uh; uh.x = hi[0]; uh.y = hi[1]; uh.z = hi[2]; uh.w = hi[3];
        uint4 ul; ul.x = lo[0]; ul.y = lo[1]; ul.z = lo[2]; ul.w = lo[3];
        ga = FA_MFMA(__builtin_bit_cast(bf16x8, uh), qf[s], ga);
        ga = FA_MFMA(__builtin_bit_cast(bf16x8, ul), qf[s], ga);
    }
    float gv[16];
#pragma unroll
    for (int i = 0; i < 8; ++i) {
        const float mine = ga[i], other = xhalf(mine);
        const int c = i >> 2, e = i & 3;
        gv[8 * c + e] = h ? other : mine; gv[8 * c + 4 + e] = h ? mine : other;
    }
    unsigned msk = 1u << qb;
#pragma unroll
    for (int k = 0; k < 3; ++k) {
        float best = -INFINITY; int bi = -1;
#pragma unroll
        for (int nn = 0; nn < 16; ++nn) if (nn < qb && gv[nn] > best) { best = gv[nn]; bi = nn; }
#pragma unroll
        for (int nn = 0; nn < 16; ++nn) if (nn == bi) gv[nn] = -INFINITY;
        if (bi >= 0) msk |= 1u << bi;
    }
    f32x16 o[2];
#pragma unroll
    for (int i = 0; i < 16; ++i) { o[0][i] = 0.f; o[1][i] = 0.f; }
    float m = -1e30f, l = 0.f;
    flash_pass<2 | 4>(base, ps, qf, qidx, 0, (unsigned long long)msk, qb * 256 + w * 32, qb * 256 + w * 32 + 31, o, m, l, 1.f, 0, &pre);
    l += xhalf(l);
    store_o(p.oC + row * 512 + hd * 64, h, o, 1.f / fmaxf(l, 1.17549435e-38f));
}
DI void item_nsa(const P& p, LAS char* base, int b, int hk, int c) {
    const int tid = tidx(), lane = tid & 63, w = __builtin_amdgcn_readfirstlane(tid >> 6), r = lane & 31, h = lane >> 5, qq = r >> 2, g = r & 3;
    const int qloc = 8 * w + qq, qpos = c * 64 + qloc, hq = hk * 4 + g;
    const size_t row = (size_t)b * S + qpos;
    int thi = ((c * 64 + 63 - 31) >> 4) / 64 + 1; thi = thi > 4 ? 4 : thi;
    const Pass psc{p.kc + ((size_t)b * 2 + hk) * 256 * 64, p.vc + ((size_t)b * 2 + hk) * 256 * 64, 64, 1, 255, 0, thi, 0, 0};
    Pre pre; flash_preload(psc, pre);
    { LAS float* z = (LAS float*)(base + L_IMPA); for (int e = tid; e < 2 * 64 * 64; e += NTHR) z[e] = 0.f; }
    bf16x8 qf[4]; load_q(p.proj + row * LDP + OFF_QD + hq * 64, h, qf);
    const bf16_t* gd = p.proj + row * LDP + OFF_GD + hq * 3;
    const unsigned gpk01 = (unsigned)gd[0] | ((unsigned)gd[1] << 16), gpk2 = (unsigned)gd[2];
    build_bias(base, p.in[2], 24 + hk * 4, 4, 1);
    LAS unsigned* oacc = (LAS unsigned*)(base + L_OACC) + tid;
    f32x16 o[2];
    const int wq_lo = c * 64 + 8 * w, wq_hi = wq_lo + 7;
    {
        int nmax = (qpos - 31) >> 4; nmax = nmax > 254 ? 254 : nmax;
        const int wn_lo = (wq_lo - 31) >> 4, wn_hi = (wq_hi - 31) >> 4;
        const Pass& ps = psc;
        float m = -1e30f, l = 0.f;
        flash_pass<8>(base, ps, qf, nmax, 0, 0ull, wn_lo, wn_hi, o, m, l, 1.f, qloc, &pre);
        l += xhalf(l);
        const float inv = 1.f / fmaxf(l, 1.17549435e-38f);
#pragma unroll
        for (int i = 0; i < 16; ++i) { o[0][i] = 0.f; o[1][i] = 0.f; }
        float l2 = 0.f;
        flash_pass<16>(base, ps, qf, nmax, 0, 0ull, wn_lo, wn_hi, o, m, l2, inv, qloc);
        const float sc = sigmoidf_(__uint_as_float(gpk01 << 16)) * inv;
#pragma unroll
        for (int i = 0; i < 16; ++i) { o[0][i] *= sc; o[1][i] *= sc; }
    }
    const Pass pss{p.proj + (size_t)b * S * LDP + OFF_KDS + hk * 64, p.proj + (size_t)b * S * LDP + OFF_VDS + hk * 64, LDP, 1, S, 0, c + 1, 0, 0};
    Pre pre2; flash_preload(pss, pre2);
    {
        const LAS float* impA = (const LAS float*)(base + L_IMPA); const LAS float* impB = (const LAS float*)(base + L_IMPB);
        LAS unsigned long long* sel = (LAS unsigned long long*)(base + L_SEL);
        for (int k = 0; k < 8; ++k) {
            const int ql = 8 * w + k, j = lane;
            const float val = (j == 0 || j == c || j == c - 1) ? 1e30f : (j <= c ? impA[ql * 64 + j] + impB[ql * 64 + j] : -1e30f);
            int rank = 0;
#pragma unroll 8
            for (int jj = 0; jj < 64; ++jj) { const float ov = __builtin_bit_cast(float, __builtin_amdgcn_readlane(__builtin_bit_cast(int, val), jj)); rank += (ov > val || (ov == val && jj < j)) ? 1 : 0; }
            const unsigned long long mk = __builtin_amdgcn_ballot_w64(rank < 16 && val > -1e29f);
            if (lane == 0) sel[ql] = mk;
        }
        __syncthreads();
    }
#pragma unroll
    for (int dh = 0; dh < 2; ++dh)
#pragma unroll
        for (int i = 0; i < 8; ++i) oacc[(dh * 8 + i) * 512] = cvtpk(o[dh][2 * i], o[dh][2 * i + 1]);
    const unsigned long long selmask = ((const LAS unsigned long long*)(base + L_SEL))[qloc];
    {
        const Pass& ps = pss;
#pragma unroll
        for (int i = 0; i < 16; ++i) { o[0][i] = 0.f; o[1][i] = 0.f; }
        float m = -1e30f, l = 0.f;
        flash_pass<2 | 4>(base, ps, qf, qpos, g, selmask, wq_lo, wq_hi, o, m, l, 1.f, qloc, &pre2);
        l += xhalf(l);
        const float sc = sigmoidf_(__uint_as_float(gpk01 & 0xffff0000u)) / fmaxf(l, 1.17549435e-38f);
#pragma unroll
        for (int dh = 0; dh < 2; ++dh)
#pragma unroll
            for (int i = 0; i < 8; ++i) { const unsigned pv = oacc[(dh * 8 + i) * 512];
                oacc[(dh * 8 + i) * 512] = cvtpk(__uint_as_float(pv << 16) + o[dh][2 * i] * sc, __uint_as_float(pv & 0xffff0000u) + o[dh][2 * i + 1] * sc); }
    }
    {
        Pass ps{p.proj + (size_t)b * S * LDP + OFF_KDW + hk * 64, p.proj + (size_t)b * S * LDP + OFF_VDW + hk * 64, LDP, 1, S, (c - 8 > 0 ? c - 8 : 0), c + 1, 511, 0};
#pragma unroll
        for (int i = 0; i < 16; ++i) { o[0][i] = 0.f; o[1][i] = 0.f; }
        float m = -1e30f, l = 0.f;
        flash_pass<1 | 4>(base, ps, qf, qpos, g, 0ull, wq_lo, wq_hi, o, m, l, 1.f, qloc);
        l += xhalf(l);
        const float sc = sigmoidf_(__uint_as_float(gpk2 << 16)) / fmaxf(l, 1.17549435e-38f);
        bf16_t* orow = p.oD + row * 512 + hq * 64;
#pragma unroll
        for (int dh = 0; dh < 2; ++dh)
#pragma unroll
            for (int c4 = 0; c4 < 4; ++c4) {
                uint2 pk; const unsigned p0 = oacc[(dh * 8 + 2 * c4) * 512], p1 = oacc[(dh * 8 + 2 * c4 + 1) * 512];
                pk.x = cvtpk(__uint_as_float(p0 << 16) + o[dh][4 * c4] * sc, __uint_as_float(p0 & 0xffff0000u) + o[dh][4 * c4 + 1] * sc);
                pk.y = cvtpk(__uint_as_float(p1 << 16) + o[dh][4 * c4 + 2] * sc, __uint_as_float(p1 & 0xffff0000u) + o[dh][4 * c4 + 3] * sc);
                *(uint2*)(orow + dh * 32 + 8 * c4 + 4 * h) = pk;
            }
    }
}
constexpr int N_QITEMS = 384;
DI void run_item(const P& p, int l, LAS char* base, int x, int t) {
    if (t < 128) {
        const int k = t >> 1;
        if ((t & 1) == 0) item_nsa(p, base, x >> 1, x & 1, 63 - k);
        else { const int bh = 4 * x + (k & 3); item_moba(p, base, bh >> 3, bh & 7, 15 - (k >> 2)); }
    } else {
        Pass ps; const bf16_t* qp; int qstride, q0, col, dscale; bool has_sink; float sink; bf16_t* ob; float* lsep; int lse_stride;
        if (t < 192) {
            const int i = t - 128, qb = i & 15, b = x >> 1, kvh = x & 1, hq = kvh * 4 + (i >> 4);
            const bf16_t* bb = p.proj + (size_t)b * S * LDP;
            ps = Pass{bb + OFF_KB + kvh * 64, bb + OFF_VB + kvh * 64, LDP, 1, S, (4 * qb - 2 > 0 ? 4 * qb - 2 : 0), 4 * qb + 4, 127, 0};
            qp = bb + OFF_QB + hq * 64; qstride = 1; q0 = qb * 256; col = 8 + hq; dscale = 1; has_sink = true; sink = p.in[16][l * 8 + hq];
            ob = p.oB + (size_t)b * S * 512 + hq * 64; lsep = nullptr; lse_stride = 0;
        } else {
            const int i = t - 192, bh = 4 * x + (i / 48), j = i % 48, cfg = j >> 4, sub = j & 15, hd = bh & 7, b = bh >> 3;
            const int rr = cfg == 0 ? 1 : (cfg == 1 ? 4 : 16), nblk = 16 / rr;
            const int res = sub / nblk, blk = sub % nblk;
            const bf16_t* bb = p.proj + ((size_t)b * S + res) * LDP;
            ps = Pass{bb + OFF_KA + hd * 64, bb + OFF_VA + hd * 64, LDP, rr, S / rr, (4 * blk - 2 > 0 ? 4 * blk - 2 : 0), 4 * blk + 4, 128, 0};
            qp = bb + OFF_QA + hd * 64; qstride = rr; q0 = blk * 256; col = hd; dscale = rr; has_sink = false; sink = 0.f;
            ob = p.oA + ((size_t)cfg * T + (size_t)b * S + res) * 512 + hd * 64; lsep = p.lseA + ((size_t)cfg * T + (size_t)b * S + res) * 8 + hd; lse_stride = 8;
        }
        item_band(p, base, qp, qstride, q0, ps, p.in[2], col, dscale, has_sink, sink, ob, lsep, lse_stride);
    }
}
DI void phase_attention(const P& p, int l, float* lds) {
    LAS char* base = (LAS char*)lds;
    LAS int* tk = (LAS int*)(base + L_TICKET);
    const int x0 = (int)(xb_xcc_id() & 7u);
    for (int e = tidx(); e < 1024; e += NTHR) ((LAS float*)(base + L_RELB))[e] = p.in[2][e] * LOG2E;
    for (int step = 0; step < 8; ++step) {
        const int x = (x0 + step) & 7;
        unsigned* ctr = p.ctl + CTL_Q + (l * 8 + x) * 64;
        if (tidx() == 0) *tk = (int)atomicAdd(ctr, 1u);
        __syncthreads();
        int t = __builtin_amdgcn_readfirstlane(*tk);
        __syncthreads();
        const int CQ = 0, NQ = N_QITEMS + CQ;
        while (t < NQ) {
            int nxt = 0;
            if (tidx() == 0) nxt = (int)atomicAdd(ctr, 1u);
            const int cb0 = t * CQ / NQ, cb1 = (t + 1) * CQ / NQ;
            if (cb1 > cb0) conv_chunk(p, x + 8 * cb0, lds);
            else run_item(p, l, base, x, t - cb0);
            if (tidx() == 0) *tk = nxt;
            __syncthreads();
            t = __builtin_amdgcn_readfirstlane(*tk);
            __syncthreads();
        }
    }
}
}

namespace pg8 {
#define PG8_LAS __attribute__((address_space(3)))
typedef short bf16x8 __attribute__((ext_vector_type(8)));
typedef float f32x4 __attribute__((ext_vector_type(4)));
typedef unsigned u32x4 __attribute__((ext_vector_type(4)));
constexpr int BM = 256, BK = 64, HALF = 128, HTB = HALF * BK * 2  , STAGE_BYTES = 8 * HTB, NXCD = 8, WGM = 4;

__device__ __forceinline__ int lds_byte(int r, int c) { const int st = (r >> 4) * 2 + (c >> 5), rr = r & 15, cc = c & 31, ob = rr * 64 + cc * 2; return st * 1024 + (ob ^ (((ob >> 9) & 1) << 5)); }
__device__ __forceinline__ void stage_rc(int b, int& R, int& C) { const int st = b / 1024, sb = b % 1024, swz = sb ^ (((sb >> 9) & 1) << 5); R = (st >> 1) * 16 + swz / 64; C = (st & 1) * 32 + (swz % 64) / 2; }
__device__ __forceinline__ int perm32(int rho) { const int n = rho >> 4, i = rho & 15; return 8 * (i >> 2) + 4 * n + (i & 3); }

struct Unit { int pm, pn; const char* A; const char* Ba; const char* Bb; int aux0, aux1, aux2; };
struct Shape { int K, lda, ldb, ksplit; };

__device__ __forceinline__ unsigned cvt_pk_bf16(float lo, float hi) { unsigned r; asm volatile("v_cvt_pk_bf16_f32 %0, %1, %2" : "=v"(r) : "v"(lo), "v"(hi)); return r; }

template <class Epi, class Sched, bool GATHER, bool HALFSKIP = false, bool ALIGN_EPI = true>
__device__ __forceinline__ void gemm_phase(PG8_LAS unsigned char* lds, const Shape g, const Sched& S, const Epi& E) {
    const int tid = tidx(), wid = __builtin_amdgcn_readfirstlane(tid >> 6), lane = tid & 63, wr = wid >> 2, wc = wid & 3, fr = lane & 15, fq = lane >> 4;
    const int nt = g.K / BK;
    unsigned voffA[2], voffA1[2], voffB[2];
#pragma unroll
    for (int i = 0; i < 2; ++i) { int R, C; stage_rc(tid * 16 + i * 8192, R, C); const int Rb = Epi::PERM ? ((R & ~31) + perm32(R & 31)) : R;
        voffA[i] = (unsigned)(R * g.lda + C) * 2u; voffA1[i] = voffA[i]; voffB[i] = (unsigned)(Rb * g.ldb + C) * 2u; }
    const size_t kstep = (size_t)(BK * 2);
    const size_t hstepA = GATHER ? 0 : (size_t)HALF * g.lda * 2;
    const size_t hstepB = (size_t)HALF * g.ldb * 2;
    const unsigned ldsw = (unsigned)wid * 1024u;
    const int aoff = lds_byte(wr * 64 + fr, fq * 8), boff = lds_byte(wc * 32 + fr, fq * 8);
#define PG8_SA(b, h) (((b) * 2 + (h)) * HTB)
#define PG8_SB(b, h) ((4 + (b) * 2 + (h)) * HTB)
#define PG8_STAGE(bufoff, gbase, voff) do { _Pragma("unroll") for (int _i = 0; _i < 2; ++_i) \
        __builtin_amdgcn_global_load_lds((const unsigned*)((const char*)(gbase) + (voff)[_i]), (PG8_LAS unsigned*)(lds + (bufoff) + ldsw + _i * 8192), 16, 0, 0); } while (0)
#define PG8_STAGE_A0(bufoff, gbase) PG8_STAGE(bufoff, gbase, voffA)
#define PG8_STAGE_A1(bufoff, gbase) do { if constexpr (GATHER) PG8_STAGE(bufoff, gbase, voffA1); else PG8_STAGE(bufoff, (gbase) + hstepA, voffA); } while (0)
#define PG8_LDA(dst, b, h) do { _Pragma("unroll") for (int m = 0; m < 4; ++m) _Pragma("unroll") for (int k = 0; k < 2; ++k) dst[m][k] = *(const PG8_LAS bf16x8*)(lds + PG8_SA(b, h) + aoff + m * 2048 + k * 1024); } while (0)
#define PG8_LDB(dst, b, h) do { _Pragma("unroll") for (int n = 0; n < 2; ++n) _Pragma("unroll") for (int k = 0; k < 2; ++k) dst[n][k] = *(const PG8_LAS bf16x8*)(lds + PG8_SB(b, h) + boff + n * 2048 + k * 1024); } while (0)
#define PG8_MMA(ai, bj, At, Bt) do { __builtin_amdgcn_s_setprio(1); _Pragma("unroll") for (int m = 0; m < 4; ++m) _Pragma("unroll") for (int n = 0; n < 2; ++n) _Pragma("unroll") for (int k = 0; k < 2; ++k) \
        acc[ai][bj][m][n] = __builtin_amdgcn_mfma_f32_16x16x32_bf16(Bt[n][k], At[m][k], acc[ai][bj][m][n], 0, 0, 0); __builtin_amdgcn_s_setprio(0); } while (0)
#define PG8_WAIT_V(n) asm volatile("s_waitcnt vmcnt(" #n ")" ::: "memory")
#define PG8_WAIT_L(n) asm volatile("s_waitcnt lgkmcnt(" #n ")" ::: "memory")
#define PG8_BAR __builtin_amdgcn_s_barrier()
#define PG8_SCHED __builtin_amdgcn_sched_barrier(0)
#define PG8_BK(u, t) (((t) < g.ksplit ? (u).Ba : (u).Bb) + (size_t)(t) * kstep)
    Unit cur, nxt; int ui = 0;
    if (!S.next(0, cur)) return;
    f32x4 acc[2][2][4][2];
#pragma unroll
    for (int a = 0; a < 2; ++a)
#pragma unroll
        for (int b = 0; b < 2; ++b)
#pragma unroll
            for (int m = 0; m < 4; ++m)
#pragma unroll
                for (int n = 0; n < 2; ++n) acc[a][b][m][n] = (f32x4){0.f, 0.f, 0.f, 0.f};
    bf16x8 At[4][2], B0[2][2], B1[2][2];
    const char* cA = cur.A; const char* cB = cur.Ba;
    if constexpr (GATHER) {
#pragma unroll
        for (int i = 0; i < 2; ++i) { int R, C; stage_rc(tidx() * 16 + i * 8192, R, C); voffA[i] = (unsigned)(S.gather_row(cur, R) * g.lda + C) * 2u; voffA1[i] = (unsigned)(S.gather_row(cur, R + HALF) * g.lda + C) * 2u; }
    }
    PG8_STAGE(PG8_SB(0, 0), cB, voffB); PG8_STAGE(PG8_SB(0, 1), cB + hstepB, voffB); PG8_STAGE_A0(PG8_SA(0, 0), cA); PG8_STAGE_A1(PG8_SA(0, 1), cA);
    if (wr == 1) PG8_BAR;
    PG8_WAIT_V(2); PG8_BAR;
    PG8_STAGE(PG8_SB(1, 0), cB + kstep, voffB); PG8_STAGE_A0(PG8_SA(1, 0), cA + kstep); PG8_STAGE(PG8_SB(1, 1), cB + hstepB + kstep, voffB);
    PG8_WAIT_V(6); PG8_BAR;
    for (;;) {
        const bool has_next = S.next(ui + 1, nxt);
        const char* nA = has_next ? nxt.A : cA; const char* nB = has_next ? nxt.Ba : cB;
        const bool skip1 = HALFSKIP && (cur.aux2 - cur.aux1 <= HALF);
        for (int t = 0; t < nt; t += 2) {
            const bool last = (t == nt - 2);
            const char* a1 = cA + (size_t)(t + 1) * kstep;
            const char* a2 = last ? nA : cA + (size_t)(t + 2) * kstep; const char* b2 = last ? nB : PG8_BK(cur, t + 2);
            const char* a3 = a2 + kstep; const char* b3 = b2 + kstep;
            PG8_LDB(B0, 0, 0); PG8_LDB(B1, 0, 1); PG8_SCHED; PG8_LDA(At, 0, 0); PG8_STAGE_A1(PG8_SA(1, 1), a1);
            if constexpr (GATHER) { if (last && has_next) {
#pragma unroll
                for (int i = 0; i < 2; ++i) { int R, C; stage_rc(tidx() * 16 + i * 8192, R, C); voffA[i] = (unsigned)(S.gather_row(nxt, R) * g.lda + C) * 2u; voffA1[i] = (unsigned)(S.gather_row(nxt, R + HALF) * g.lda + C) * 2u; } } }
            PG8_WAIT_V(8); PG8_WAIT_L(0); PG8_BAR; PG8_MMA(0, 0, At, B0); PG8_MMA(0, 1, At, B1); PG8_BAR; PG8_SCHED;
            if (!skip1) PG8_LDA(At, 0, 1); PG8_STAGE(PG8_SB(0, 0), b2, voffB); PG8_STAGE(PG8_SB(0, 1), b2 + hstepB, voffB); PG8_STAGE_A0(PG8_SA(0, 0), a2);
            PG8_WAIT_V(8); PG8_WAIT_L(0); PG8_BAR; if (!skip1) { PG8_MMA(1, 0, At, B0); PG8_MMA(1, 1, At, B1); } PG8_BAR; PG8_SCHED;
            PG8_LDB(B0, 1, 0); PG8_LDB(B1, 1, 1); PG8_SCHED; PG8_LDA(At, 1, 0); PG8_STAGE_A1(PG8_SA(0, 1), a2);
            PG8_WAIT_V(8); PG8_WAIT_L(0); PG8_BAR; PG8_MMA(0, 0, At, B0); PG8_MMA(0, 1, At, B1); PG8_BAR; PG8_SCHED;
            if (!skip1) PG8_LDA(At, 1, 1); PG8_STAGE(PG8_SB(1, 0), b3, voffB); PG8_STAGE(PG8_SB(1, 1), b3 + hstepB, voffB); PG8_STAGE_A0(PG8_SA(1, 0), a3);
            PG8_WAIT_V(8); PG8_WAIT_L(0); PG8_BAR; if (!skip1) { PG8_MMA(1, 0, At, B0); PG8_MMA(1, 1, At, B1); } PG8_BAR; PG8_SCHED;
        }
        if constexpr (ALIGN_EPI) { if (wr == 0) PG8_BAR; }
        { int fr_ = fr, fq_ = fq; asm volatile("" : "+v"(fr_), "+v"(fq_));
          E(acc, cur, wr, wc, fr_, fq_); }
        if (!has_next) break;
#pragma unroll
        for (int a = 0; a < 2; ++a)
#pragma unroll
            for (int b = 0; b < 2; ++b)
#pragma unroll
                for (int m = 0; m < 4; ++m)
#pragma unroll
                    for (int n = 0; n < 2; ++n) acc[a][b][m][n] = (f32x4){0.f, 0.f, 0.f, 0.f};
        cur = nxt; cA = nA; cB = nB; ++ui;
        if constexpr (ALIGN_EPI) { if (wr == 1) PG8_BAR; }
    }
    PG8_WAIT_V(0);
    if constexpr (!ALIGN_EPI) { if (wr == 0) PG8_BAR; }
    PG8_BAR;
#undef PG8_SA
#undef PG8_SB
#undef PG8_STAGE
#undef PG8_STAGE_A0
#undef PG8_STAGE_A1
#undef PG8_LDA
#undef PG8_LDB
#undef PG8_MMA
#undef PG8_WAIT_V
#undef PG8_WAIT_L
#undef PG8_BAR
#undef PG8_SCHED
#undef PG8_BK
}

struct GridOrder {
    int nM, nN, nwg, G, c;
    __device__ __forceinline__ void init(int M, int N, int G_, int c_) { nM = M / BM; nN = N / BM; nwg = nM * nN; G = G_; c = c_; }
    __device__ __forceinline__ bool flat(int i, int& pm, int& pn) const {
        const long L = (long)i * G + c; if (L >= nwg) return false;
        int wgid = (int)L; { const int q = nwg / NXCD, r = nwg % NXCD, xcd = wgid % NXCD, off = wgid / NXCD; wgid = (xcd < r ? xcd * (q + 1) : r * (q + 1) + (xcd - r) * q) + off; }
        const int nig = WGM * nN, gid = wgid / nig, fm = gid * WGM, gsz = (nM - fm) < WGM ? (nM - fm) : WGM;
        pm = fm + ((wgid % nig) % gsz); pn = (wgid % nig) / gsz; return true;
    }
};
}

struct DenseSched {
    pg8::GridOrder go; const char* A; const char* Bt; size_t a_tile, b_tile;
    DI bool next(int i, pg8::Unit& u) const { int pm, pn; if (!go.flat(i, pm, pn)) return false; u.pm = pm; u.pn = pn; u.A = A + (size_t)pm * a_tile; u.Ba = Bt + (size_t)pn * b_tile; u.Bb = u.Ba; u.aux0 = u.aux1 = u.aux2 = 0; return true; }
    DI int gather_row(const pg8::Unit&, int r) const { return r; }
};
struct EpiProj {
    static constexpr bool PERM = true;
    bf16_t* O;
    DI void operator()(const pg8::f32x4 (&acc)[2][2][4][2], const pg8::Unit& u, int wr, int wc, int fr, int fq) const {
        const int row0 = u.pm * 256 + wr * 64 + fr, col0 = u.pn * 256 + wc * 32 + 8 * fq;
#pragma unroll
        for (int ai = 0; ai < 2; ++ai)
#pragma unroll
            for (int m = 0; m < 4; ++m) { bf16_t* rowp = O + (size_t)(row0 + ai * 128 + m * 16) * LDP + col0;
#pragma unroll
                for (int bj = 0; bj < 2; ++bj) {
                    const int c128 = u.pn * 2 + bj;
                    const float sc = (c128 < 4 || (c128 >= 12 && c128 < 16) || (c128 >= 18 && c128 < 22) || (c128 >= 30 && c128 < 34)) ? fa::SC2 : 1.f;
                    const pg8::f32x4 v0 = acc[ai][bj][m][0] * sc, v1 = acc[ai][bj][m][1] * sc;
                    pg8::u32x4 w; w.x = pg8::cvt_pk_bf16(v0[0], v0[1]); w.y = pg8::cvt_pk_bf16(v0[2], v0[3]); w.z = pg8::cvt_pk_bf16(v1[0], v1[1]); w.w = pg8::cvt_pk_bf16(v1[2], v1[3]);
                    *(pg8::u32x4*)(rowp + bj * 128) = w; } }
    }
};
struct EpiResid {
    static constexpr bool PERM = true;
    bf16_t* x; const float* gate;
    DI void operator()(const pg8::f32x4 (&acc)[2][2][4][2], const pg8::Unit& u, int wr, int wc, int fr, int fq) const {
        const int row0 = u.pm * 256 + wr * 64 + fr, col0 = u.pn * 256 + wc * 32 + 8 * fq;
        const float* gp = gate + (size_t)((u.pm * 256) / S) * 12288 + col0;
        pg8::f32x4 gv[2][2];
#pragma unroll
        for (int bj = 0; bj < 2; ++bj)
#pragma unroll
            for (int n = 0; n < 2; ++n) gv[bj][n] = *(const pg8::f32x4*)(gp + bj * 128 + 4 * n);
#pragma unroll
        for (int ai = 0; ai < 2; ++ai) {
            pg8::u32x4 xv[4][2];
#pragma unroll
            for (int m = 0; m < 4; ++m)
#pragma unroll
                for (int bj = 0; bj < 2; ++bj) xv[m][bj] = *(const pg8::u32x4*)(x + (size_t)(row0 + ai * 128 + m * 16) * D + col0 + bj * 128);
#pragma unroll
            for (int m = 0; m < 4; ++m)
#pragma unroll
                for (int bj = 0; bj < 2; ++bj) {
                    const pg8::u32x4 t = xv[m][bj];
                    const pg8::f32x4 x0 = {__uint_as_float(t.x << 16), __uint_as_float(t.x & 0xffff0000u), __uint_as_float(t.y << 16), __uint_as_float(t.y & 0xffff0000u)};
                    const pg8::f32x4 x1 = {__uint_as_float(t.z << 16), __uint_as_float(t.z & 0xffff0000u), __uint_as_float(t.w << 16), __uint_as_float(t.w & 0xffff0000u)};
                    const pg8::f32x4 r0 = x0 + gv[bj][0] * acc[ai][bj][m][0], r1 = x1 + gv[bj][1] * acc[ai][bj][m][1];
                    pg8::u32x4 o; o.x = pg8::cvt_pk_bf16(r0[0], r0[1]); o.y = pg8::cvt_pk_bf16(r0[2], r0[3]); o.z = pg8::cvt_pk_bf16(r1[0], r1[1]); o.w = pg8::cvt_pk_bf16(r1[2], r1[3]);
                    *(pg8::u32x4*)(x + (size_t)(row0 + ai * 128 + m * 16) * D + col0 + bj * 128) = o;
                }
        }
    }
};

constexpr int LDS_MOE_TAB = 132096 / 4;
DI void moe_build_table(const P& p, int l, float* lds) {
    int* tab = (int*)(lds + LDS_MOE_TAB);
    unsigned* cnt = p.ctl + CTL_CNT + l * 32;
    if (tidx() < 64) {
        const int lane = tidx();
        const int myn = lane < NCLS ? (int)__hip_atomic_load(cnt + lane, __ATOMIC_RELAXED, __HIP_MEMORY_SCOPE_AGENT) : 0;
        int nt = 0, base = 0;
        for (int pass = 0; pass < 2; ++pass) {
            base = 0;
            for (int c = 0; c < NCLS; ++c) {
                const int n = __builtin_amdgcn_readlane(myn, c), ntc = (n + 255) >> 8;
                for (int mt = 0; mt < ntc; ++mt) {
                    const bool small = (n - mt * 256) <= 128;
                    if (small == (pass == 1)) { if (lane == 0) { tab[4 + 4 * nt] = c; tab[5 + 4 * nt] = mt; tab[6 + 4 * nt] = base * 256; tab[7 + 4 * nt] = n; } ++nt; }
                }
                base += ntc;
            }
        }
        if (lane == 0) tab[0] = nt;
    }
    __syncthreads();
}
DI int rfl(int v) { return __builtin_amdgcn_readfirstlane(v); }
struct MoeSched1 {
    const int* tab; int G, c; const char* hb; const char* wgu; const int* cls_tok;
    DI bool next(int i, pg8::Unit& u) const {
        const int L = i * G + c, nt = rfl(tab[0]); if (L >= nt * 8) return false;
        const int ft = L >> 3, pn = L & 7;
        const int cls = rfl(tab[4 + 4 * ft]), mt = rfl(tab[5 + 4 * ft]), sb = rfl(tab[6 + 4 * ft]), n = rfl(tab[7 + 4 * ft]);
        int ea, eb; cls_experts(cls, ea, eb); const int e = pn < 4 ? ea : eb;
        u.pm = (sb >> 8) + mt; u.pn = pn; u.A = hb; u.Ba = wgu + ((size_t)e * 1024 + (pn & 3) * 256) * 2048 * 2; u.Bb = u.Ba; u.aux0 = cls; u.aux1 = mt * 256; u.aux2 = n; return true;
    }
    DI int gather_row(const pg8::Unit& u, int r) const { const int ri = u.aux1 + r; return cls_tok[(size_t)u.aux0 * CLS_CAP + (ri < u.aux2 ? ri : 0)]; }
};
struct MoeSched2 {
    const int* tab; int G, c; const char* hid; const char* wd;
    DI bool next(int i, pg8::Unit& u) const {
        const int L = i * G + c, nt = rfl(tab[0]); if (L >= nt * 8) return false;
        const int ft = L >> 3, pn = L & 7;
        const int cls = rfl(tab[4 + 4 * ft]), mt = rfl(tab[5 + 4 * ft]), sb = rfl(tab[6 + 4 * ft]), n = rfl(tab[7 + 4 * ft]);
        int ea, eb; cls_experts(cls, ea, eb);
        u.pm = (sb >> 8) + mt; u.pn = pn; u.A = hid + (size_t)(sb + mt * 256) * 1024 * 2;
        u.Ba = wd + ((size_t)ea * 2048 + pn * 256) * 512 * 2; u.Bb = wd + ((size_t)eb * 2048 + pn * 256) * 512 * 2 - (size_t)8 * 128;
        u.aux0 = cls; u.aux1 = mt * 256; u.aux2 = n; return true;
    }
    DI int gather_row(const pg8::Unit&, int r) const { return r; }
};
struct EpiMoe1 {
    static constexpr bool PERM = true;
    bf16_t* hid; const int* cls_tok; const float* tokw;
    DI void operator()(const pg8::f32x4 (&acc)[2][2][4][2], const pg8::Unit& u, int wr, int wc, int fr, int fq) const {
        const int which = u.pn >> 2, q = u.pn & 3;
        const int* toks = cls_tok + (size_t)u.aux0 * CLS_CAP;
        bf16_t* hb = hid + (size_t)u.pm * 256 * 1024 + which * 512 + q * 128 + wc * 32 + 8 * fq;
        int tk[8]; float wv[8];
#pragma unroll
        for (int k = 0; k < 8; ++k) { const int ri = u.aux1 + wr * 64 + fr + (k >> 2) * 128 + (k & 3) * 16; tk[k] = toks[ri < u.aux2 ? ri : u.aux2 - 1]; }
#pragma unroll
        for (int k = 0; k < 8; ++k) wv[k] = tokw[(size_t)tk[k] * 2 + which];
#pragma unroll
        for (int ai = 0; ai < 2; ++ai)
#pragma unroll
            for (int m = 0; m < 4; ++m) {
                const int r = wr * 64 + fr + ai * 128 + m * 16, ri = u.aux1 + r;
                if (ri < u.aux2) {
                    const float w = wv[ai * 4 + m];
                    const pg8::f32x4 g0 = acc[ai][0][m][0], g1 = acc[ai][0][m][1], u0 = acc[ai][1][m][0], u1 = acc[ai][1][m][1];
                    pg8::u32x4 o;
                    o.x = pg8::cvt_pk_bf16(siluf_(g0[0]) * u0[0] * w, siluf_(g0[1]) * u0[1] * w); o.y = pg8::cvt_pk_bf16(siluf_(g0[2]) * u0[2] * w, siluf_(g0[3]) * u0[3] * w);
                    o.z = pg8::cvt_pk_bf16(siluf_(g1[0]) * u1[0] * w, siluf_(g1[1]) * u1[1] * w); o.w = pg8::cvt_pk_bf16(siluf_(g1[2]) * u1[2] * w, siluf_(g1[3]) * u1[3] * w);
                    *(pg8::u32x4*)(hb + (size_t)r * 1024) = o;
                }
            }
    }
};
struct EpiMoe2 {
    static constexpr bool PERM = true;
    bf16_t* x; const int* cls_tok; const float* g2;
    DI void operator()(const pg8::f32x4 (&acc)[2][2][4][2], const pg8::Unit& u, int wr, int wc, int fr, int fq) const {
        const int* toks = cls_tok + (size_t)u.aux0 * CLS_CAP;
        const int col0 = u.pn * 256 + wc * 32 + 8 * fq;
        int tk[8];
#pragma unroll
        for (int k = 0; k < 8; ++k) { const int ri = u.aux1 + wr * 64 + fr + (k >> 2) * 128 + (k & 3) * 16; tk[k] = toks[ri < u.aux2 ? ri : u.aux2 - 1]; }
#pragma unroll
        for (int kp = 0; kp < 4; ++kp) {
            pg8::u32x4 xv[2][2]; pg8::f32x4 gv[2][2][2];
#pragma unroll
            for (int j = 0; j < 2; ++j) {
                const int tok = tk[2 * kp + j];
                const bf16_t* xr = x + (size_t)tok * D + col0;
                const float* gp = g2 + (size_t)(tok / S) * 12288 + col0;
#pragma unroll
                for (int bj = 0; bj < 2; ++bj) { xv[j][bj] = *(const pg8::u32x4*)(xr + bj * 128);
#pragma unroll
                    for (int n = 0; n < 2; ++n) gv[j][bj][n] = *(const pg8::f32x4*)(gp + bj * 128 + 4 * n); }
            }
#pragma unroll
            for (int j = 0; j < 2; ++j) {
                const int k = 2 * kp + j, ai = k >> 2, m = k & 3;
                const int ri = u.aux1 + wr * 64 + fr + ai * 128 + m * 16;
                if (ri < u.aux2) {
                    bf16_t* xr = x + (size_t)tk[k] * D + col0;
#pragma unroll
                    for (int bj = 0; bj < 2; ++bj) {
                        const pg8::u32x4 t = xv[j][bj];
                        const pg8::f32x4 x0 = {__uint_as_float(t.x << 16), __uint_as_float(t.x & 0xffff0000u), __uint_as_float(t.y << 16), __uint_as_float(t.y & 0xffff0000u)};
                        const pg8::f32x4 x1 = {__uint_as_float(t.z << 16), __uint_as_float(t.z & 0xffff0000u), __uint_as_float(t.w << 16), __uint_as_float(t.w & 0xffff0000u)};
                        const pg8::f32x4 r0 = x0 + gv[j][bj][0] * acc[ai][bj][m][0], r1 = x1 + gv[j][bj][1] * acc[ai][bj][m][1];
                        pg8::u32x4 o; o.x = pg8::cvt_pk_bf16(r0[0], r0[1]); o.y = pg8::cvt_pk_bf16(r0[2], r0[3]); o.z = pg8::cvt_pk_bf16(r1[0], r1[1]); o.w = pg8::cvt_pk_bf16(r1[2], r1[3]);
                        *(pg8::u32x4*)(xr + bj * 128) = o;
                    }
                }
            }
        }
    }
};

constexpr int LDS_BYTES = 147456;
constexpr int LDS_MISC = 131072 / 4, LDS_TAB = 131328 / 4;
DI unsigned long long ld_tab(const float* lds, int i) {
    const unsigned lo = __builtin_amdgcn_readfirstlane(__float_as_uint(lds[LDS_TAB + 2 * i])), hi = __builtin_amdgcn_readfirstlane(__float_as_uint(lds[LDS_TAB + 2 * i + 1]));
    return ((unsigned long long)hi << 32) | lo;
}
#define GAS __attribute__((address_space(1)))
template <class T> DI T* gptr(unsigned long long v) { return (T*)(GAS T*)v; }
DI P load_P(const float* lds) {
    asm volatile("" ::: "memory");
    P p;
#pragma unroll
    for (int i = 0; i < 23; ++i) p.in[i] = gptr<const float>(ld_tab(lds, i));
    p.out = gptr<float>(ld_tab(lds, 23));
    const unsigned long long ws = ld_tab(lds, 24);
    p.ctl = gptr<unsigned>(ws + O_CTL); p.mod = gptr<float>(ws + O_MOD); p.xres = gptr<bf16_t>(ws + O_XRES); p.hbuf = gptr<bf16_t>(ws + O_HBUF); p.proj = gptr<bf16_t>(ws + O_PROJ);
    p.oA = gptr<bf16_t>(ws + O_OA); p.lseA = gptr<float>(ws + O_LSEA); p.oB = gptr<bf16_t>(ws + O_OB); p.oC = gptr<bf16_t>(ws + O_OC); p.oD = gptr<bf16_t>(ws + O_OD);
    p.kmean = gptr<float>(ws + O_KMEAN); p.kc = gptr<bf16_t>(ws + O_KC); p.vc = gptr<bf16_t>(ws + O_VC); p.cls_tok = gptr<int>(ws + O_CLSTOK); p.tokw = gptr<float>(ws + O_TOKW);
    p.hid = gptr<bf16_t>(ws + O_HID); p.winT = gptr<bf16_t>(ws + O_WINT); p.woutT = gptr<bf16_t>(ws + O_WOUTT); p.wguT = gptr<bf16_t>(ws + O_WGUT); p.wdT = gptr<bf16_t>(ws + O_WDT);
    p.cw1T = gptr<bf16_t>(ws + O_CW1T); p.cw2T = gptr<bf16_t>(ws + O_CW2T); p.cgT = gptr<bf16_t>(ws + O_CGT); p.crT = gptr<bf16_t>(ws + O_CRT); p.hlo = gptr<bf16_t>(ws + O_HLO);
    return p;
}
#if PROBE_MASK
#define STAMP(id) do { if (blockIdx.x == 0 && threadIdx.x == 0) { volatile LAS unsigned long long* tq = (volatile LAS unsigned long long*)(lds + LDS_MISC + 8); \
    const unsigned long long now_ = __builtin_amdgcn_s_memrealtime(); if ((PROBE_MASK >> (id)) & 1) tq[1] += now_ - tq[0]; tq[0] = now_; } } while (0)
#else
#define STAMP(id) do { } while (0)
#endif
__global__ void __launch_bounds__(NTHR, 2) mk_fwd(KArgs ka) {
    extern __shared__ __attribute__((aligned(16))) float lds[];
    const int bid = blockIdx.x, nb = gridDim.x;
#define w (__builtin_amdgcn_readfirstlane(tidx() >> 6))
    volatile LAS unsigned* xbw = (volatile LAS unsigned*)(lds + LDS_MISC);
    if (threadIdx.x == 0) { xbw[0] = 0u; xbw[1] = 0u; xbw[2] = 0u; xbw[3] = 0u; }
    if (threadIdx.x < 25) {
        const unsigned long long v = (threadIdx.x < 23) ? (unsigned long long)ka.in[threadIdx.x < 23 ? threadIdx.x : 0] : (threadIdx.x == 23 ? (unsigned long long)ka.out : (unsigned long long)ka.ws);
        lds[LDS_TAB + 2 * threadIdx.x] = __uint_as_float((unsigned)v); lds[LDS_TAB + 2 * threadIdx.x + 1] = __uint_as_float((unsigned)(v >> 32));
    }
    __syncthreads();
    (void)xcd_barrier_post((unsigned*)(ka.ws + O_CTL), xbw);
#define bar (XcdBarrier{gptr<unsigned>(ld_tab(lds, 24) + O_CTL), xb_xcc_id(), (volatile LAS unsigned*)(lds + LDS_MISC)})
#if PROBE_MASK
    if (blockIdx.x == 0 && threadIdx.x == 0) { volatile LAS unsigned long long* tq = (volatile LAS unsigned long long*)(lds + LDS_MISC + 8); tq[0] = __builtin_amdgcn_s_memrealtime(); tq[1] = 0ull; tq[2] = tq[0]; }
#endif

    { const P p = load_P(lds);
      for (int it = bid; it < N_MOD_ITEMS; it += nb) phase_mod_item(p, it, lds);
      phase_transposes_range(p, bid, TR_NA, nb, false, lds);
      phase_transposes_range(p, bid, TR_NB, nb, true, lds); }
    xcd_barrier(bar);
    STAMP(0);
    for (int l = 0; l < DEPTH; ++l) {
        { const P p = load_P(lds); for (int it = bid; it < N_NORM_ITEMS; it += nb) phase_norm_item(p, l, 0, it, lds); }
        xcd_barrier(bar);
    STAMP(1);
        { const P p = load_P(lds);
          DenseSched sc; sc.go.init(T, 5120, nb, bid); sc.A = (const char*)p.hbuf; sc.Bt = (const char*)(p.winT + (size_t)l * NPAD_IN * 2048); sc.a_tile = (size_t)256 * D * 2; sc.b_tile = (size_t)256 * 2048 * 2;
          const pg8::Shape g{2048, D, 2048, 1 << 20};
          const EpiProj E{p.proj};
          pg8::gemm_phase<EpiProj, DenseSched, false>((PG8_LAS unsigned char*)lds, g, sc, E); }
        xcd_barrier(bar);
    STAMP(2);
        { const P p = load_P(lds);
          for (int it = bid; it < N_CMP_ITEMS + N_KMEAN_GROUPS; it += nb) { if (it < N_CMP_ITEMS) phase_cmp_item(p, l, it, lds); else phase_kmean_group(p, it - N_CMP_ITEMS, lds); } }
        xcd_barrier(bar);
    STAMP(3);
        { const P p = load_P(lds); fa::phase_attention(p, l, lds); }
        xcd_barrier(bar);
    STAMP(4);
        { const P p = load_P(lds); phase_mixnorm(p, bid * 8 + w, nb * 8); }
        xcd_barrier(bar);
    STAMP(5);
        { const P p = load_P(lds);
          DenseSched sc; sc.go.init(T, 2048, nb, bid); sc.A = (const char*)p.hbuf; sc.Bt = (const char*)(p.woutT + (size_t)l * 2048 * 2048); sc.a_tile = (size_t)256 * D * 2; sc.b_tile = (size_t)256 * 2048 * 2;
          const pg8::Shape g{2048, D, 2048, 1 << 20};
          const EpiResid E{p.xres, p.mod + (size_t)l * 4 * 12288 + 2 * D};
          pg8::gemm_phase<EpiResid, DenseSched, false>((PG8_LAS unsigned char*)lds, g, sc, E); }
        xcd_barrier(bar);
    STAMP(6);
        { const P p = load_P(lds); for (int it = bid; it < N_NORM_ITEMS; it += nb) phase_norm_item(p, l, 1, it, lds); }
        xcd_barrier(bar);
    STAMP(7);
        { const P p = load_P(lds); moe_build_table(p, l, lds);
          const MoeSched1 sc{(const int*)(lds + LDS_MOE_TAB), nb, bid, (const char*)p.hbuf, (const char*)(p.wguT + (size_t)l * 16 * 1024 * 2048), p.cls_tok};
          const pg8::Shape g{2048, D, 2048, 1 << 20};
          const EpiMoe1 E{p.hid, p.cls_tok, p.tokw};
          pg8::gemm_phase<EpiMoe1, MoeSched1, true, true>((PG8_LAS unsigned char*)lds, g, sc, E); }
        xcd_barrier(bar);
    STAMP(8);
        { const P p = load_P(lds);
          const MoeSched2 sc{(const int*)(lds + LDS_MOE_TAB), nb, bid, (const char*)p.hid, (const char*)(p.wdT + (size_t)l * 16 * 2048 * 512)};
          const pg8::Shape g{1024, 1024, 512, 8};
          const EpiMoe2 E{p.xres, p.cls_tok, p.mod + (size_t)l * 4 * 12288 + 5 * D};
          pg8::gemm_phase<EpiMoe2, MoeSched2, false, true>((PG8_LAS unsigned char*)lds, g, sc, E); }
        xcd_barrier(bar);
    STAMP(9);
    }
    { const P p = load_P(lds);
      const bool tmo = xb_ld(p.ctl + XB_TMO) != 0u;
      phase_final(p, bid * 8 + w, nb * 8, tmo);
#if PROBE_MASK
      if (blockIdx.x == 0 && threadIdx.x == 0) { volatile LAS unsigned long long* tq = (volatile LAS unsigned long long*)(lds + LDS_MISC + 8);
          const unsigned long long now_ = __builtin_amdgcn_s_memrealtime(); if ((PROBE_MASK >> 10) & 1) tq[1] += now_ - tq[0];
          const float frac = (float)tq[1] / (float)(now_ - tq[2]);
          asm volatile("s_waitcnt vmcnt(0)" ::: "memory");
          p.out[0] = 20.f + 79.f * frac; }
#endif
    }
#undef w
#undef bar
}

extern "C" void kernel_launch(void* const* d_in, const int* in_sizes, int n_in, void* d_out, int out_size, void* d_ws, size_t ws_size, hipStream_t stream) {
    KArgs ka{};
    for (int i = 0; i < 23; ++i) ka.in[i] = (const float*)d_in[i];
    ka.out = (float*)d_out;
    ka.ws = (unsigned char*)d_ws;
    if (WS_NEED > ws_size) { fprintf(stderr, "workspace too small: need %zu have %zu\n", (size_t)WS_NEED, ws_size); return; }
    static int grid = 0;
    if (!grid) {
        int dev = 0, cus = 0, per_cu = 0;
        (void)hipGetDevice(&dev);
        (void)hipDeviceGetAttribute(&cus, hipDeviceAttributeMultiprocessorCount, dev);
        (void)hipFuncSetAttribute((const void*)mk_fwd, hipFuncAttributeMaxDynamicSharedMemorySize, LDS_BYTES);
        (void)hipOccupancyMaxActiveBlocksPerMultiprocessor(&per_cu, (const void*)mk_fwd, NTHR, LDS_BYTES);
        if (per_cu < 1) fprintf(stderr, "occupancy query reports %d blocks per CU\n", per_cu);
        (void)hipGetLastError();
        grid = cus;
    }
    (void)hipMemsetAsync(ka.ws + O_CTL, 0, 1 << 20, stream);
    mk_fwd<<<grid, NTHR, LDS_BYTES, stream>>>(ka);
}
```
